# Optimizing an MI355X kernel written in HIP

```python
import jax, jax.numpy as jnp
from jax import lax
import numpy as np

D_MODEL = 1024
BATCH = 2
SEQ = 8192
DEPTH = 4

RET_HEADS = 4
RET_DK = 64
RET_DV = 128
FOX_HEADS = 4
FOX_DH = 64
MEM_HEADS = 4
MEM_DH = 64
MEM_LEN = 256
D_MIX = RET_HEADS * RET_DV + FOX_HEADS * FOX_DH + MEM_HEADS * MEM_DH
RET_CHUNK = 128
Q_BLOCK = 128
D_FF = 2752
N_EXPERTS = 8
TOP_K = 2
ROPE_BASE = 10000.0
EPS = 1e-6
N_DENSE = (DEPTH + 1) // 2
N_MOE = DEPTH // 2
IN_SPLIT = (RET_HEADS * RET_DK, RET_HEADS * RET_DK, RET_HEADS * RET_DV, RET_HEADS * RET_DV,
            FOX_HEADS * FOX_DH, FOX_HEADS * FOX_DH, FOX_HEADS * FOX_DH, FOX_HEADS,
            MEM_HEADS * MEM_DH)
IN_COLS = sum(IN_SPLIT)

kernel_name = "hybrid_retention_fox_memory_moe_trunk"


def rms_norm(x, g):
    xf = x.astype(jnp.float32)
    y = xf * lax.rsqrt(jnp.mean(xf * xf, axis=-1, keepdims=True) + EPS)
    return (y * g.astype(jnp.float32)).astype(x.dtype)


def rope(x, pos):
    half = x.shape[-1] // 2
    inv_freq = ROPE_BASE ** (-jnp.arange(half, dtype=jnp.float32) / half)
    ang = pos[:, None] * inv_freq[None, :]
    cos = jnp.cos(ang)[:, None, :]
    sin = jnp.sin(ang)[:, None, :]
    xf = x.astype(jnp.float32)
    x1, x2 = xf[..., :half], xf[..., half:]
    return jnp.concatenate([x1 * cos - x2 * sin, x2 * cos + x1 * sin], axis=-1).astype(x.dtype)


def retention(q, k, v):
    B, S, H, dk = q.shape
    dv = v.shape[-1]
    C = RET_CHUNK
    N = S // C
    log_g = jnp.log(1.0 - 2.0 ** (-5.0 - jnp.arange(H, dtype=jnp.float32)))

    def chunks(t):
        return t.astype(jnp.float32).reshape(B, N, C, H, t.shape[-1]).transpose(0, 3, 1, 2, 4)

    qc = chunks(q) * (dk ** -0.5)
    kc = chunks(k)
    vc = chunks(v)
    idx = jnp.arange(C, dtype=jnp.float32)
    diff = idx[:, None] - idx[None, :]
    dmat = jnp.where(diff >= 0, jnp.exp(log_g[:, None, None] * jnp.maximum(diff, 0.0)), 0.0)
    scores = jnp.einsum('bhnid,bhnjd->bhnij', qc, kc) * dmat[None, :, None]
    intra = jnp.einsum('bhnij,bhnje->bhnie', scores, vc)
    k_decay = jnp.exp(log_g[:, None] * (C - 1.0 - idx))
    kv = jnp.einsum('bhncd,bhnce->bhnde', kc * k_decay[None, :, None, :, None], vc)
    chunk_decay = jnp.exp(log_g * C)[None, :, None, None]

    def step(state, kv_n):
        return state * chunk_decay + kv_n, state

    _, prev = lax.scan(step, jnp.zeros((B, H, dk, dv), jnp.float32), jnp.moveaxis(kv, 2, 0))
    prev = jnp.moveaxis(prev, 0, 2)
    q_decay = jnp.exp(log_g[:, None] * (idx + 1.0))
    cross = jnp.einsum('bhncd,bhnde->bhnce', qc * q_decay[None, :, None, :, None], prev)
    out = intra + cross
    return out.transpose(0, 2, 3, 1, 4).reshape(B, S, H, dv)


def forgetting_attention(q, k, v, log_f):
    B, S, H, d = q.shape
    NB = S // Q_BLOCK
    scale = d ** -0.5
    c = lax.cumsum(log_f, axis=1).transpose(0, 2, 1)
    qh = q.transpose(0, 2, 1, 3)
    kh = k.transpose(0, 2, 1, 3)
    vh = v.transpose(0, 2, 1, 3)
    q_blocks = qh.reshape(B, H, NB, Q_BLOCK, d).transpose(2, 0, 1, 3, 4)
    c_blocks = c.reshape(B, H, NB, Q_BLOCK).transpose(2, 0, 1, 3)
    k_pos = jnp.arange(S)

    def block(args):
        qb, cb, i = args
        s = jnp.einsum('bhqd,bhkd->bhqk', qb, kh).astype(jnp.float32) * scale
        s = s + (cb[..., :, None] - c[:, :, None, :])
        q_pos = i * Q_BLOCK + jnp.arange(Q_BLOCK)
        s = jnp.where(k_pos[None, :] <= q_pos[:, None], s, -jnp.inf)
        p = jax.nn.softmax(s, axis=-1)
        return jnp.einsum('bhqk,bhkd->bhqd', p.astype(vh.dtype), vh)

    out = lax.map(block, (q_blocks, c_blocks, jnp.arange(NB)))
    return out.transpose(1, 0, 3, 2, 4).reshape(B, S, H, d)


def memory_attention(q, mk, mv):
    d = q.shape[-1]
    s = jnp.einsum('bshd,bmhd->bhsm', q, mk).astype(jnp.float32) * (d ** -0.5)
    p = jax.nn.softmax(s, axis=-1)
    return jnp.einsum('bhsm,bmhd->bshd', p.astype(mv.dtype), mv)


def hybrid_mixer(h, mem, w_in, forget_bias, fox_q_g, fox_k_g, mem_q_g, mem_k_g,
                 mem_norm_g, w_mem_kv, out_norm_g, w_out):
    B, S, _ = h.shape
    M = mem.shape[1]
    pos = jnp.arange(S, dtype=jnp.float32)
    proj = h @ w_in
    cuts = tuple(int(i) for i in np.cumsum(IN_SPLIT)[:-1])
    rq, rk, rv, rg, fq, fk, fv, ff, mq = jnp.split(proj, cuts, axis=-1)

    rq = rope(rq.reshape(B, S, RET_HEADS, RET_DK), pos)
    rk = rope(rk.reshape(B, S, RET_HEADS, RET_DK), pos)
    ret = retention(rq, rk, rv.reshape(B, S, RET_HEADS, RET_DV))

    fq = rms_norm(fq.reshape(B, S, FOX_HEADS, FOX_DH), fox_q_g)
    fk = rms_norm(fk.reshape(B, S, FOX_HEADS, FOX_DH), fox_k_g)
    log_f = jax.nn.log_sigmoid((ff + forget_bias).astype(jnp.float32))
    fox = forgetting_attention(fq, fk, fv.reshape(B, S, FOX_HEADS, FOX_DH), log_f)

    mkv = rms_norm(mem, mem_norm_g) @ w_mem_kv
    mk, mv = jnp.split(mkv, 2, axis=-1)
    mk = rms_norm(mk.reshape(B, M, MEM_HEADS, MEM_DH), mem_k_g)
    mv = mv.reshape(B, M, MEM_HEADS, MEM_DH)
    mq = rms_norm(mq.reshape(B, S, MEM_HEADS, MEM_DH), mem_q_g)
    memo = memory_attention(mq, mk, mv)

    g_ret, g_fox, g_mem = jnp.split(out_norm_g, (RET_HEADS * RET_DV, RET_HEADS * RET_DV + FOX_HEADS * FOX_DH))
    ret_o = rms_norm(ret.astype(h.dtype), g_ret.reshape(RET_HEADS, RET_DV)).reshape(B, S, -1) * jax.nn.silu(rg)
    fox_o = rms_norm(fox, g_fox.reshape(FOX_HEADS, FOX_DH)).reshape(B, S, -1)
    mem_o = rms_norm(memo, g_mem.reshape(MEM_HEADS, MEM_DH)).reshape(B, S, -1)
    y = jnp.concatenate([ret_o, fox_o.astype(ret_o.dtype), mem_o.astype(ret_o.dtype)], axis=-1)
    return (y @ w_out).astype(h.dtype)


def swiglu(h, w_gate, w_up, w_down):
    return (jax.nn.silu(h @ w_gate) * (h @ w_up)) @ w_down


def moe_ffn(h, router_w, wg, wu, wd):
    B, S, D = h.shape
    t = h.reshape(B * S, D)
    logits = (t @ router_w).astype(jnp.float32)
    top_vals, top_idx = lax.top_k(logits, TOP_K)
    gates = jax.nn.softmax(top_vals, axis=-1)
    combine = jnp.sum(jax.nn.one_hot(top_idx, N_EXPERTS, dtype=jnp.float32) * gates[..., None], axis=1)
    y = jnp.zeros((B * S, D), jnp.float32)
    for e in range(N_EXPERTS):
        y = y + combine[:, e:e + 1] * swiglu(t, wg[e], wu[e], wd[e]).astype(jnp.float32)
    return y.astype(h.dtype).reshape(B, S, D)


def setup_inputs(seed: int = 0) -> dict:
    key = jax.random.key(seed)
    ks = jax.random.split(key, 22)
    f32 = jnp.float32

    def w(k, shape, fan_in):
        return jax.random.normal(k, shape, f32) * (fan_in ** -0.5)

    def gain(k, shape):
        return 1.0 + 0.02 * jax.random.normal(k, shape, f32)

    return {
        "x": jax.random.normal(ks[0], (BATCH, SEQ, D_MODEL), f32),
        "mem": jax.random.normal(ks[1], (BATCH, MEM_LEN, D_MODEL), f32),
        "attn_norm_g": gain(ks[2], (DEPTH, D_MODEL)),
        "w_in": w(ks[3], (DEPTH, D_MODEL, IN_COLS), D_MODEL),
        "forget_bias": jax.random.uniform(ks[4], (DEPTH, FOX_HEADS), f32, minval=1.0, maxval=3.0),
        "fox_q_norm_g": gain(ks[5], (DEPTH, FOX_DH)),
        "fox_k_norm_g": gain(ks[6], (DEPTH, FOX_DH)),
        "mem_q_norm_g": gain(ks[7], (DEPTH, MEM_DH)),
        "mem_k_norm_g": gain(ks[8], (DEPTH, MEM_DH)),
        "mem_norm_g": gain(ks[9], (DEPTH, D_MODEL)),
        "w_mem_kv": w(ks[10], (DEPTH, D_MODEL, 2 * MEM_HEADS * MEM_DH), D_MODEL),
        "out_norm_g": gain(ks[11], (DEPTH, D_MIX)),
        "w_out": w(ks[12], (DEPTH, D_MIX, D_MODEL), D_MIX),
        "ffn_norm_g": gain(ks[13], (DEPTH, D_MODEL)),
        "dense_w_gate": w(ks[14], (N_DENSE, D_MODEL, D_FF), D_MODEL),
        "dense_w_up": w(ks[15], (N_DENSE, D_MODEL, D_FF), D_MODEL),
        "dense_w_down": w(ks[16], (N_DENSE, D_FF, D_MODEL), D_FF),
        "router_w": w(ks[17], (N_MOE, D_MODEL, N_EXPERTS), D_MODEL),
        "expert_w_gate": w(ks[18], (N_MOE, N_EXPERTS, D_MODEL, D_FF), D_MODEL),
        "expert_w_up": w(ks[19], (N_MOE, N_EXPERTS, D_MODEL, D_FF), D_MODEL),
        "expert_w_down": w(ks[20], (N_MOE, N_EXPERTS, D_FF, D_MODEL), D_FF),
    }


def reference(x, mem, attn_norm_g, w_in, forget_bias, fox_q_norm_g, fox_k_norm_g, mem_q_norm_g,
              mem_k_norm_g, mem_norm_g, w_mem_kv, out_norm_g, w_out, ffn_norm_g, dense_w_gate,
              dense_w_up, dense_w_down, router_w, expert_w_gate, expert_w_up, expert_w_down):
    for l in range(DEPTH):
        h = rms_norm(x, attn_norm_g[l])
        x = x + hybrid_mixer(h, mem, w_in[l], forget_bias[l], fox_q_norm_g[l], fox_k_norm_g[l],
                             mem_q_norm_g[l], mem_k_norm_g[l], mem_norm_g[l], w_mem_kv[l],
                             out_norm_g[l], w_out[l])
        h = rms_norm(x, ffn_norm_g[l])
        j = l // 2
        if l % 2 == 0:
            x = x + swiglu(h, dense_w_gate[j], dense_w_up[j], dense_w_down[j])
        else:
            x = x + moe_ffn(h, router_w[j], expert_w_gate[j], expert_w_up[j], expert_w_down[j])
    return x
```

```cpp
#include <hip/hip_runtime.h>
#include <hip/hip_bf16.h>
#include <cstdio>
#include <cstdint>
#include <cmath>

constexpr int D_MODEL = 1024, BATCH = 2, SEQ = 8192, DEPTH = 4, M_TOK = BATCH * SEQ;
constexpr int MEM_LEN = 256, M_MEM = BATCH * MEM_LEN;
constexpr int D_FF = 2752, FFP = 2816  , NGU = 2 * FFP  ;
constexpr int N_EXPERTS = 8, IN_COLS = 2564, NIN = 2816  , NINKV = NIN + 512  ;
constexpr float EPS = 1e-6f;
constexpr int NWAVES = 8;

constexpr size_t MiB = 1u << 20;
constexpr size_t WS_CTL = 0, CTL_ZERO_BYTES = 1 * MiB;
constexpr size_t SZ_WIN = (size_t)NINKV * D_MODEL * 2, SZ_WOUT = (size_t)D_MODEL * D_MODEL * 2, SZ_WGU = (size_t)NGU * D_MODEL * 2, SZ_WDN = (size_t)D_MODEL * FFP * 2;
constexpr size_t WS_WIN = 1 * MiB;
constexpr size_t WS_WOUT = WS_WIN + 4 * SZ_WIN;
constexpr size_t WS_WGU = WS_WOUT + 4 * SZ_WOUT;
constexpr size_t WS_WDN = WS_WGU + 2 * SZ_WGU;
constexpr size_t WS_EGU = WS_WDN + 2 * SZ_WDN;
constexpr size_t WS_EDN = WS_EGU + 16 * SZ_WGU;
constexpr size_t WS_HB = WS_EDN + 16 * SZ_WDN;
constexpr size_t WS_LIST = WS_HB + (size_t)(M_TOK + M_MEM) * D_MODEL * 2;
constexpr size_t WS_GATEW = WS_LIST + (size_t)N_EXPERTS * 16384 * 4;
constexpr size_t WS_LOGF = WS_GATEW + (size_t)N_EXPERTS * 16384 * 4;
constexpr size_t WS_CB = WS_LOGF + (size_t)8 * SEQ * 4;
constexpr size_t WS_MK = WS_CB + (size_t)8 * SEQ * 4;
constexpr size_t WS_MV = WS_MK + (size_t)M_MEM * 256 * 2;
constexpr size_t WS_GAINS = WS_MV + (size_t)M_MEM * 256 * 2;
constexpr size_t WS_U = WS_GAINS + 4096;
constexpr size_t WS_RQ = WS_U, WS_RK = WS_RQ + (size_t)M_TOK * 256 * 2, WS_RV = WS_RK + (size_t)M_TOK * 256 * 2, WS_RG = WS_RV + (size_t)M_TOK * 512 * 2;
constexpr size_t WS_FQ = WS_RG + (size_t)M_TOK * 512 * 2, WS_FK = WS_FQ + (size_t)M_TOK * 256 * 2, WS_FV = WS_FK + (size_t)M_TOK * 256 * 2, WS_MQ = WS_FV + (size_t)M_TOK * 256 * 2;
constexpr size_t WS_KVT = WS_MQ + (size_t)M_TOK * 256 * 2;
constexpr size_t WS_PREVT = WS_KVT + (size_t)512 * 128 * 64 * 4;
constexpr size_t WS_Y = WS_PREVT + (size_t)512 * 128 * 64 * 2;
constexpr size_t WS_UEND_MIX = WS_Y + (size_t)M_TOK * D_MODEL * 2;
constexpr int HF_ROWS = 2 * M_TOK + N_EXPERTS * 256;
constexpr size_t WS_HF = WS_U;
constexpr size_t WS_UEND_HF = WS_HF + (size_t)HF_ROWS * FFP * 2;
constexpr size_t WS_YD = (WS_UEND_HF > WS_UEND_MIX ? WS_UEND_HF : WS_UEND_MIX);
constexpr size_t WS_END = WS_YD + (size_t)HF_ROWS * D_MODEL * 2;
constexpr int CW_BAR = 4096;
constexpr int CW_CNT = 8192;

namespace pg8 {
#define PG8_LAS __attribute__((address_space(3)))
typedef unsigned short bf16_t;
typedef short bf16x8 __attribute__((ext_vector_type(8)));
typedef float f32x4 __attribute__((ext_vector_type(4)));
typedef unsigned u32x4 __attribute__((ext_vector_type(4)));
constexpr int BM = 256, BK = 64, HALF = 128, HTB = HALF * BK * 2  , STAGE_BYTES = 8 * HTB, NXCD = 8, WGM = 8;

__host__ __device__ __forceinline__ int lds_byte(int r, int c) { const int st = (r >> 4) * 2 + (c >> 5), rr = r & 15, cc = c & 31, ob = rr * 64 + cc * 2; return st * 1024 + (ob ^ (((ob >> 9) & 1) << 5)); }
__host__ __device__ __forceinline__ void stage_rc(int b, int& R, int& C) { const int st = b / 1024, sb = b % 1024, swz = sb ^ (((sb >> 9) & 1) << 5); R = (st >> 1) * 16 + swz / 64; C = (st & 1) * 32 + (swz % 64) / 2; }
__host__ __device__ __forceinline__ int perm32(int rho) { const int n = rho >> 4, i = rho & 15; return 8 * (i >> 2) + 4 * n + (i & 3); }

struct Unit { int pm, pn, e, lt, cnt; };
struct Gemm { const bf16_t* A; const bf16_t* Bt; int K; size_t bstride; };

__device__ __forceinline__ unsigned cvt_pk_bf16(float lo, float hi) { unsigned r; asm volatile("v_cvt_pk_bf16_f32 %0, %1, %2" : "=v"(r) : "v"(lo), "v"(hi)); return r; }

__device__ __forceinline__ bool static_tile(int i, int G, int c, int nM, int nN, int& pm, int& pn) {
    const int nwg = nM * nN; const long L = (long)i * G + c; if (L >= nwg) return false;
    int wgid = (int)L; { const int q = nwg / NXCD, r = nwg % NXCD, xcd = wgid % NXCD, off = wgid / NXCD; wgid = (xcd < r ? xcd * (q + 1) : r * (q + 1) + (xcd - r) * q) + off; }
    const int nig = WGM * nN, gid = wgid / nig, fm = gid * WGM, gsz = (nM - fm) < WGM ? (nM - fm) : WGM;
    pm = fm + ((wgid % nig) % gsz); pn = (wgid % nig) / gsz; return true;
}

template <class Epi, class Sched, bool ALIGN_EPI, bool SP2, bool GATHER>
__device__ __forceinline__ void gemm_phase(PG8_LAS unsigned char* lds, const Gemm g, const Sched& S, const Epi& E) {
    int tid_ = threadIdx.x; asm volatile("" : "+v"(tid_));
    const int tid = tid_, wid = __builtin_amdgcn_readfirstlane(tid >> 6), lane = tid & 63, wr = wid >> 2, wc = wid & 3, fr = lane & 15, fq = lane >> 4;
    const int K = g.K, nt = K / BK;
    unsigned voffB[2]; unsigned vA[2][2], vN[2][2]; int RA[2], CA[2];
#pragma unroll
    for (int i = 0; i < 2; ++i) { int R, C; stage_rc(tid * 16 + i * 8192, R, C); const int Rb = Epi::PERM ? ((R & ~31) + perm32(R & 31)) : R;
        RA[i] = R; CA[i] = C; voffB[i] = (unsigned)(Rb * K + C) * 2u;
#pragma unroll
        for (int h = 0; h < 2; ++h) { vA[h][i] = (unsigned)((R + h * HALF) * K + C) * 2u; vN[h][i] = vA[h][i]; } }
    const size_t kstep = (size_t)(BK * 2);
    const size_t hstep = (size_t)HALF * K * 2;
    const size_t tstep = 2 * hstep;
    const unsigned ldsw = (unsigned)wid * 1024u;
    const int aoff = lds_byte(wr * 64 + fr, fq * 8), boff = lds_byte(wc * 32 + fr, fq * 8);
#define PG8_SA(b, h) (((b) * 2 + (h)) * HTB)
#define PG8_SB(b, h) ((4 + (b) * 2 + (h)) * HTB)
#define PG8_STAGE(bufoff, gbase, voff) do { _Pragma("unroll") for (int _i = 0; _i < 2; ++_i) \
        __builtin_amdgcn_global_load_lds((const unsigned*)((const char*)(gbase) + (voff)[_i]), (PG8_LAS unsigned*)(lds + (bufoff) + ldsw + _i * 8192), 16, 0, 0); } while (0)
#define PG8_STAGEA(b, h, kptr, vv) PG8_STAGE(PG8_SA(b, h), (GATHER ? (kptr) : (kptr) + (h) * hstep), (vv)[GATHER ? (h) : 0])
#define PG8_LDA(dst, b, h) do { _Pragma("unroll") for (int m = 0; m < 4; ++m) _Pragma("unroll") for (int k = 0; k < 2; ++k) dst[m][k] = *(const PG8_LAS bf16x8*)(lds + PG8_SA(b, h) + aoff + m * 2048 + k * 1024); } while (0)
#define PG8_LDB(dst, b, h) do { _Pragma("unroll") for (int n = 0; n < 2; ++n) _Pragma("unroll") for (int k = 0; k < 2; ++k) dst[n][k] = *(const PG8_LAS bf16x8*)(lds + PG8_SB(b, h) + boff + n * 2048 + k * 1024); } while (0)
#define PG8_MMA(ai, bj, At, Bt) do { __builtin_amdgcn_s_setprio(1); _Pragma("unroll") for (int m = 0; m < 4; ++m) _Pragma("unroll") for (int n = 0; n < 2; ++n) _Pragma("unroll") for (int k = 0; k < 2; ++k) \
        acc[ai][bj][m][n] = __builtin_amdgcn_mfma_f32_16x16x32_bf16(Bt[n][k], At[m][k], acc[ai][bj][m][n], 0, 0, 0); __builtin_amdgcn_s_setprio(0); } while (0)
#define PG8_WAIT_V(n) asm volatile("s_waitcnt vmcnt(" #n ")" ::: "memory")
#define PG8_WAIT_L(n) asm volatile("s_waitcnt lgkmcnt(" #n ")" ::: "memory")
#define PG8_BAR __builtin_amdgcn_s_barrier()
#define PG8_SCHED __builtin_amdgcn_sched_barrier(0)
    Unit cur, nxt; int ui = 0;
    if (!S.next(0, cur)) return;
    f32x4 acc[2][2][4][2];
#pragma unroll
    for (int a = 0; a < 2; ++a)
#pragma unroll
        for (int b = 0; b < 2; ++b)
#pragma unroll
            for (int m = 0; m < 4; ++m)
#pragma unroll
                for (int n = 0; n < 2; ++n) acc[a][b][m][n] = (f32x4){0.f, 0.f, 0.f, 0.f};
    bf16x8 At[4][2], B0[2][2], B1[2][2];
    const char* cA = (const char*)g.A + (GATHER ? (size_t)0 : (size_t)cur.pm * tstep); const char* cB = (const char*)g.Bt + (size_t)cur.e * g.bstride + (size_t)cur.pn * tstep;
    if constexpr (GATHER) {
#pragma unroll
        for (int i = 0; i < 2; ++i)
#pragma unroll
            for (int h = 0; h < 2; ++h) { vA[h][i] = (unsigned)(S.row_token(cur, RA[i] + h * HALF) * K + CA[i]) * 2u; vN[h][i] = vA[h][i]; }
    }
    {
        PG8_STAGE(PG8_SB(0, 0), cB, voffB); PG8_STAGE(PG8_SB(0, 1), cB + hstep, voffB); PG8_STAGEA(0, 0, cA, vA); PG8_STAGEA(0, 1, cA, vA);
        if (wr == 1) PG8_BAR;
        PG8_WAIT_V(2); PG8_BAR;
        PG8_STAGE(PG8_SB(1, 0), cB + kstep, voffB); PG8_STAGEA(1, 0, cA + kstep, vA); PG8_STAGE(PG8_SB(1, 1), cB + hstep + kstep, voffB);
        PG8_WAIT_V(6); PG8_BAR;
    }
    for (;;) {
        const bool has_next = S.next(ui + 1, nxt);
        const char* nA = has_next ? (const char*)g.A + (GATHER ? (size_t)0 : (size_t)nxt.pm * tstep) : cA;
        const char* nB = has_next ? (const char*)g.Bt + (size_t)nxt.e * g.bstride + (size_t)nxt.pn * tstep : cB;
        if constexpr (GATHER) {
            if (has_next) {
#pragma unroll
                for (int i = 0; i < 2; ++i)
#pragma unroll
                    for (int h = 0; h < 2; ++h) vN[h][i] = (unsigned)(S.row_token(nxt, RA[i] + h * HALF) * K + CA[i]) * 2u;
            }
        }
        for (int t = 0; t < nt; t += 2) {
            const bool last = (t == nt - 2);
            const char* a1 = cA + (size_t)(t + 1) * kstep;
            const char* a2 = last ? nA : cA + (size_t)(t + 2) * kstep; const char* b2 = last ? nB : cB + (size_t)(t + 2) * kstep;
            const char* a3 = a2 + kstep; const char* b3 = b2 + kstep;
            unsigned vS[2][2];
#pragma unroll
            for (int i = 0; i < 2; ++i)
#pragma unroll
                for (int h = 0; h < 2; ++h) vS[h][i] = (GATHER && last) ? vN[h][i] : vA[h][i];
            PG8_LDB(B0, 0, 0); PG8_LDB(B1, 0, 1); PG8_SCHED; PG8_LDA(At, 0, 0); PG8_STAGEA(1, 1, a1, vA);
            PG8_WAIT_V(8); PG8_WAIT_L(0); PG8_BAR; PG8_MMA(0, 0, At, B0); PG8_MMA(0, 1, At, B1); PG8_BAR; PG8_SCHED;
            PG8_LDA(At, 0, 1); PG8_STAGE(PG8_SB(0, 0), b2, voffB); PG8_STAGE(PG8_SB(0, 1), b2 + hstep, voffB); PG8_STAGEA(0, 0, a2, vS);
            PG8_WAIT_V(8); PG8_WAIT_L(0); PG8_BAR; PG8_MMA(1, 0, At, B0); PG8_MMA(1, 1, At, B1); PG8_BAR; PG8_SCHED;
            PG8_LDB(B0, 1, 0); PG8_LDB(B1, 1, 1); PG8_SCHED; PG8_LDA(At, 1, 0); PG8_STAGEA(0, 1, a2, vS);
            PG8_WAIT_V(8); PG8_WAIT_L(0); PG8_BAR; PG8_MMA(0, 0, At, B0); PG8_MMA(0, 1, At, B1); PG8_BAR; PG8_SCHED;
            PG8_LDA(At, 1, 1); PG8_STAGE(PG8_SB(1, 0), b3, voffB); PG8_STAGE(PG8_SB(1, 1), b3 + hstep, voffB); PG8_STAGEA(1, 0, a3, vS);
            PG8_WAIT_V(8); PG8_WAIT_L(0); PG8_BAR; PG8_MMA(1, 0, At, B0); PG8_MMA(1, 1, At, B1); PG8_BAR; PG8_SCHED;
        }
        if constexpr (ALIGN_EPI) { if (wr == 0) PG8_BAR; }
        E(acc, cur, wr, wc, fr, fq);
        if (!has_next) break;
#pragma unroll
        for (int a = 0; a < 2; ++a)
#pragma unroll
            for (int b = 0; b < 2; ++b)
#pragma unroll
                for (int m = 0; m < 4; ++m)
#pragma unroll
                    for (int n = 0; n < 2; ++n) acc[a][b][m][n] = (f32x4){0.f, 0.f, 0.f, 0.f};
        cur = nxt; cA = nA; cB = nB; ++ui;
#pragma unroll
        for (int i = 0; i < 2; ++i)
#pragma unroll
            for (int h = 0; h < 2; ++h) vA[h][i] = vN[h][i];
        if constexpr (ALIGN_EPI) { if (wr == 1) PG8_BAR; }
    }
    PG8_WAIT_V(0);
    if constexpr (!ALIGN_EPI) { if (wr == 0) PG8_BAR; }
    PG8_BAR;
#undef PG8_SA
#undef PG8_SB
#undef PG8_STAGE
#undef PG8_STAGEA
#undef PG8_LDA
#undef PG8_LDB
#undef PG8_MMA
#undef PG8_WAIT_V
#undef PG8_WAIT_L
#undef PG8_BAR
#undef PG8_SCHED
}
}
namespace pg8 {
constexpr int LIST_CAP = 16384;

struct TileOrder {
    int nM, nN, G, c, xM0, xN0, xM, xN;
    __device__ __forceinline__ bool next(int i, Unit& u) const {
        int pm, pn; u.e = 0; u.lt = 0; u.cnt = 0;
        if (static_tile(i, G, c, nM, nN, pm, pn)) { u.pm = pm; u.pn = pn; return true; }
        const long L = (long)i * G + c - (long)nM * nN;
        if (L < (long)xM * xN) { u.pm = xM0 + (int)(L % xM); u.pn = xN0 + (int)(L / xM); return true; }
        return false;
    }
    __device__ __forceinline__ int row_token(const Unit& u, int r) const { return u.pm * BM + r; }
};

struct GroupedOrder {
    int G, c, nN, ntiles; const PG8_LAS int* tab; const int* list; bool dense;
    __device__ __forceinline__ void init(int G_, int c_, int nN_, PG8_LAS int* tab_, const unsigned* counts, const int* list_) { G = G_; c = c_; nN = nN_; tab = tab_; list = list_; dense = (counts == nullptr);
        __syncthreads();
        if (threadIdx.x == 0) { int t = 0;
            for (int e = 0; e < N_EXPERTS; ++e) { int n = dense ? (e == 0 ? M_TOK : 0) : (int)__hip_atomic_load(counts + e, __ATOMIC_RELAXED, __HIP_MEMORY_SCOPE_AGENT); n = n > LIST_CAP ? LIST_CAP : n; tab_[16 + e] = n; tab_[e] = t; t += (n + BM - 1) / BM; }
            tab_[N_EXPERTS] = t; }
        __syncthreads();
        ntiles = __builtin_amdgcn_readfirstlane(tab_[N_EXPERTS]); }
    __device__ __forceinline__ bool next(int i, Unit& u) const {
        int pm, pn; if (!static_tile(i, G, c, ntiles, nN, pm, pn)) return false;
        int e = 0;
#pragma unroll
        for (int j = 1; j < N_EXPERTS; ++j) e += (pm >= tab[j]) ? 1 : 0;
        e = __builtin_amdgcn_readfirstlane(e);
        u.pm = pm; u.pn = pn; u.e = e; u.lt = pm - __builtin_amdgcn_readfirstlane(tab[e]); u.cnt = __builtin_amdgcn_readfirstlane(tab[16 + e]); return true;
    }
    __device__ __forceinline__ int row_token(const Unit& u, int r) const { const int pos = u.lt * BM + r; if (dense) return pos; return pos < u.cnt ? list[u.e * LIST_CAP + pos] : 0; }
};

__device__ __forceinline__ float silu_f(float x) { return x / (1.0f + __expf(-x)); }
__device__ __forceinline__ float logsigmoid_f(float z) { const float a = fabsf(z); return fminf(z, 0.f) - log1pf(__expf(-a)); }

struct EpiInProj {
    static constexpr bool PERM = true;
    unsigned char* ws; const float* fbias; const float* gains;
    __device__ __forceinline__ void operator()(const f32x4 (&acc)[2][2][4][2], const Unit& u, int wr, int wc, int fr, int fq) const {
        const int pn = u.pn; const int row0 = u.pm * BM + wr * 64 + fr;
        if (pn <= 1) {
            bf16_t* dst = (bf16_t*)(ws + (pn == 0 ? WS_RQ : WS_RK)); const float sc = pn == 0 ? 0.125f : 1.0f;
            float invf[2][4];
#pragma unroll
            for (int n = 0; n < 2; ++n)
#pragma unroll
                for (int j = 0; j < 4; ++j) invf[n][j] = exp2f(-(float)(8 * fq + 4 * n + j) * (13.287712379549449f / 32.0f));
#pragma unroll
            for (int ai = 0; ai < 2; ++ai)
#pragma unroll
                for (int m = 0; m < 4; ++m) { const int row = row0 + ai * HALF + m * 16; const float pos = (float)(row & (SEQ - 1));
                    float y1[8], y2[8];
#pragma unroll
                    for (int n = 0; n < 2; ++n)
#pragma unroll
                        for (int j = 0; j < 4; ++j) { const float ang = pos * invf[n][j]; double rv = (double)ang * 0.15915494309189535; rv -= floor(rv); const float rf = (float)rv;
                            const float cs = __builtin_amdgcn_cosf(rf), sn = __builtin_amdgcn_sinf(rf); const float x1 = acc[ai][0][m][n][j], x2 = acc[ai][1][m][n][j];
                            y1[n * 4 + j] = (x1 * cs - x2 * sn) * sc; y2[n * 4 + j] = (x2 * cs + x1 * sn) * sc; }
                    bf16_t* rowp = dst + (size_t)row * 256 + 64 * wc + 8 * fq;
                    u32x4 w; w.x = cvt_pk_bf16(y1[0], y1[1]); w.y = cvt_pk_bf16(y1[2], y1[3]); w.z = cvt_pk_bf16(y1[4], y1[5]); w.w = cvt_pk_bf16(y1[6], y1[7]); *(u32x4*)rowp = w;
                    w.x = cvt_pk_bf16(y2[0], y2[1]); w.y = cvt_pk_bf16(y2[2], y2[3]); w.z = cvt_pk_bf16(y2[4], y2[5]); w.w = cvt_pk_bf16(y2[6], y2[7]); *(u32x4*)(rowp + 32) = w; }
        } else if (pn == 6 || pn == 7 || pn == 9 || pn == 11) {
            const size_t doff = pn == 6 ? WS_FQ : pn == 7 ? WS_FK : pn == 9 ? WS_MQ : WS_MK; const int gi = pn == 6 ? 0 : pn == 7 ? 1 : pn == 9 ? 2 : 3;
            bf16_t* dst = (bf16_t*)(ws + doff); const float* gp = gains + gi * 64;
            const float sc = (pn == 6 || pn == 9) ? (0.125f * 1.4426950408889634f) : 1.0f; const int rsub = pn == 11 ? M_TOK : 0;
            f32x4 gv[2][2];
#pragma unroll
            for (int bj = 0; bj < 2; ++bj)
#pragma unroll
                for (int n = 0; n < 2; ++n) gv[bj][n] = *(const f32x4*)(gp + 32 * bj + 8 * fq + 4 * n) * sc;
#pragma unroll
            for (int ai = 0; ai < 2; ++ai)
#pragma unroll
                for (int m = 0; m < 4; ++m) { const int row = row0 + ai * HALF + m * 16 - rsub; float ss = 0.f;
#pragma unroll
                    for (int bj = 0; bj < 2; ++bj)
#pragma unroll
                        for (int n = 0; n < 2; ++n) { const f32x4 x = acc[ai][bj][m][n]; ss += (x[0] * x[0] + x[1] * x[1]) + (x[2] * x[2] + x[3] * x[3]); }
                    ss += __shfl_xor(ss, 16); ss += __shfl_xor(ss, 32);
                    const float rstd = 1.0f / sqrtf(ss * (1.0f / 64.0f) + EPS);
                    bf16_t* rowp = dst + (size_t)row * 256 + 64 * wc + 8 * fq;
#pragma unroll
                    for (int bj = 0; bj < 2; ++bj) { const f32x4 v0 = acc[ai][bj][m][0] * rstd * gv[bj][0], v1 = acc[ai][bj][m][1] * rstd * gv[bj][1];
                        u32x4 w; w.x = cvt_pk_bf16(v0[0], v0[1]); w.y = cvt_pk_bf16(v0[2], v0[3]); w.z = cvt_pk_bf16(v1[0], v1[1]); w.w = cvt_pk_bf16(v1[2], v1[3]); *(u32x4*)(rowp + 32 * bj) = w; } }
        } else if (pn == 10) {
            if (wc == 0 && fq == 0) {
                const f32x4 bv = *(const f32x4*)fbias; float* LOGF = (float*)(ws + WS_LOGF);
#pragma unroll
                for (int ai = 0; ai < 2; ++ai)
#pragma unroll
                    for (int m = 0; m < 4; ++m) { const int row = row0 + ai * HALF + m * 16; const int b = row >> 13, t = row & (SEQ - 1);
#pragma unroll
                        for (int j = 0; j < 4; ++j) LOGF[(size_t)(b * 4 + j) * SEQ + t] = logsigmoid_f(acc[ai][0][m][0][j] + bv[j]); }
            }
        } else {
            size_t doff; int ldc, ct, rsub = 0; bool act = false;
            if (pn <= 3) { doff = WS_RV; ldc = 512; ct = pn - 2; } else if (pn <= 5) { doff = WS_RG; ldc = 512; ct = pn - 4; act = true; } else if (pn == 8) { doff = WS_FV; ldc = 256; ct = 0; } else { doff = WS_MV; ldc = 256; ct = 0; rsub = M_TOK; }
            bf16_t* dst = (bf16_t*)(ws + doff);
#pragma unroll
            for (int ai = 0; ai < 2; ++ai)
#pragma unroll
                for (int m = 0; m < 4; ++m) { const int row = row0 + ai * HALF + m * 16 - rsub; bf16_t* rowp = dst + (size_t)row * ldc + ct * 256 + 32 * wc + 8 * fq;
#pragma unroll
                    for (int bj = 0; bj < 2; ++bj) { f32x4 v0 = acc[ai][bj][m][0], v1 = acc[ai][bj][m][1];
                        if (act) {
#pragma unroll
                            for (int j = 0; j < 4; ++j) { v0[j] = silu_f(v0[j]); v1[j] = silu_f(v1[j]); } }
                        u32x4 w; w.x = cvt_pk_bf16(v0[0], v0[1]); w.y = cvt_pk_bf16(v0[2], v0[3]); w.z = cvt_pk_bf16(v1[0], v1[1]); w.w = cvt_pk_bf16(v1[2], v1[3]); *(u32x4*)(rowp + bj * HALF) = w; } }
        }
    }
};

struct EpiResid {
    static constexpr bool PERM = false;
    const float* src; float* out;
    __device__ __forceinline__ void operator()(const f32x4 (&acc)[2][2][4][2], const Unit& u, int wr, int wc, int fr, int fq) const {
        const int row0 = u.pm * BM + wr * 64 + fr, col0 = u.pn * BM + wc * 32 + 4 * fq;
#pragma unroll
        for (int ai = 0; ai < 2; ++ai)
#pragma unroll
            for (int m = 0; m < 4; ++m) { const size_t off = (size_t)(row0 + ai * HALF + m * 16) * D_MODEL + col0;
#pragma unroll
                for (int bj = 0; bj < 2; ++bj)
#pragma unroll
                    for (int n = 0; n < 2; ++n) { const f32x4 bs = *(const f32x4*)(src + off + bj * HALF + n * 16); *(f32x4*)(out + off + bj * HALF + n * 16) = bs + acc[ai][bj][m][n]; }
                if (m & 1) asm volatile("" ::: "memory"); }
    }
};

struct EpiSwiGLU {
    static constexpr bool PERM = true;
    bf16_t* HF;
    __device__ __forceinline__ void operator()(const f32x4 (&acc)[2][2][4][2], const Unit& u, int wr, int wc, int fr, int fq) const {
        const int row0 = u.pm * BM + wr * 64 + fr, col0 = u.pn * HALF + wc * 32 + 8 * fq;
#pragma unroll
        for (int ai = 0; ai < 2; ++ai)
#pragma unroll
            for (int m = 0; m < 4; ++m) { bf16_t* rowp = HF + (size_t)(row0 + ai * HALF + m * 16) * FFP + col0; float h[8];
#pragma unroll
                for (int n = 0; n < 2; ++n)
#pragma unroll
                    for (int j = 0; j < 4; ++j) h[n * 4 + j] = silu_f(acc[ai][0][m][n][j]) * acc[ai][1][m][n][j];
                u32x4 w; w.x = cvt_pk_bf16(h[0], h[1]); w.y = cvt_pk_bf16(h[2], h[3]); w.z = cvt_pk_bf16(h[4], h[5]); w.w = cvt_pk_bf16(h[6], h[7]); *(u32x4*)rowp = w; }
    }
};

struct EpiDown {
    static constexpr bool PERM = false;
    float* X; bf16_t* YD; bool dense;
    __device__ __forceinline__ void operator()(const f32x4 (&acc)[2][2][4][2], const Unit& u, int wr, int wc, int fr, int fq) const {
        const int col0 = u.pn * BM + wc * 32 + 4 * fq; const int row0 = u.pm * BM + wr * 64 + fr;
        if (dense) {
#pragma unroll
            for (int ai = 0; ai < 2; ++ai)
#pragma unroll
                for (int m = 0; m < 4; ++m) { float* rowp = X + (size_t)(row0 + ai * HALF + m * 16) * D_MODEL + col0;
#pragma unroll
                    for (int bj = 0; bj < 2; ++bj)
#pragma unroll
                        for (int n = 0; n < 2; ++n) { const f32x4 bs = *(const f32x4*)(rowp + bj * HALF + n * 16); *(f32x4*)(rowp + bj * HALF + n * 16) = bs + acc[ai][bj][m][n]; }
                    if (m & 1) asm volatile("" ::: "memory"); }
        } else {
            typedef unsigned u32x2 __attribute__((ext_vector_type(2)));
#pragma unroll
            for (int ai = 0; ai < 2; ++ai)
#pragma unroll
                for (int m = 0; m < 4; ++m) { bf16_t* rowp = YD + (size_t)(row0 + ai * HALF + m * 16) * D_MODEL + col0;
#pragma unroll
                    for (int bj = 0; bj < 2; ++bj)
#pragma unroll
                        for (int n = 0; n < 2; ++n) { const f32x4 v = acc[ai][bj][m][n]; u32x2 w; w.x = cvt_pk_bf16(v[0], v[1]); w.y = cvt_pk_bf16(v[2], v[3]); *(u32x2*)(rowp + bj * HALF + n * 16) = w; } }
        }
    }
};
}
namespace attn_body {
#ifdef T_NOMASK
constexpr bool defined_nomask=true;
#else
constexpr bool defined_nomask=false;
#endif
#ifdef T_NOBIAS
constexpr bool defined_nobias=true;
#else
constexpr bool defined_nobias=false;
#endif
using bf16=__hip_bfloat16;
using bf16x8=__attribute__((ext_vector_type(8)))short;
using s16x4=__attribute__((ext_vector_type(4)))short;
using f32x16=__attribute__((ext_vector_type(16)))float;
using u32x4=__attribute__((ext_vector_type(4)))unsigned;
using f32x4v=__attribute__((ext_vector_type(4)))float;
constexpr int BATCH=2,NHEAD=4,SEQ=8192,D=64,DM=NHEAD*D,KVMEM=256,YP=1024;
constexpr int NW=8,QBLK=32,QB=QBLK*NW,KVBLK=64,NQB=SEQ/QB;
constexpr int ATTN_PITCH=DM, ATTN_UNIT_ROWS=QB;
__device__ __forceinline__ int crow(int r,int hi){return (r&3)+8*(r>>2)+4*hi;}
__device__ __forceinline__ unsigned f2bf_a(float f){ unsigned u=__builtin_bit_cast(unsigned,f); return (u+0x7fffu+((u>>16)&1u))>>16; }
#define SBAR() __builtin_amdgcn_sched_barrier(0)
__device__ __forceinline__ void cmask(f32x16&p0,f32x16&p1,int jb,int qrel,int hi){
  int dd=qrel-(64*jb+4*hi); asm volatile("":"+v"(dd));
  #pragma unroll
  for(int r=0;r<16;++r){const int c=(r&3)+8*(r>>2);
    const unsigned t0=(((unsigned)(dd-c))&0x80000000u)|0x7F800000u, t1=(((unsigned)(dd-c-32))&0x80000000u)|0x7F800000u;
    p0[r]=__builtin_fminf(p0[r],__uint_as_float(t0)); p1[r]=__builtin_fminf(p1[r],__uint_as_float(t1));}
}

constexpr int NSLOT=3, SLOTB=8192;
constexpr int LDS_K=0, LDS_V=NSLOT*SLOTB, LDS_WS=2*NSLOT*SLOTB, LDS_OST=LDS_WS+NW*64*4, LDS_CB=LDS_OST+NW*4096, LDS_CBZ=LDS_CB+SEQ*8, LDS_BYTES=LDS_CBZ+16;
constexpr float C2=0.125f*1.4426950408889634f;
__device__ __forceinline__ void glds16(const void*gsrc,unsigned lds_dst){unsigned keep;
  asm volatile("s_mov_b32 %0, m0\n\ts_mov_b32 m0, %2\n\ts_nop 0\n\tglobal_load_lds_dwordx4 %1, off\n\ts_mov_b32 m0, %0":"=&s"(keep):"v"(gsrc),"s"(lds_dst):"memory");}
__device__ __forceinline__ float max3f(float a,float b,float c){float r;asm("v_max3_f32 %0, %1, %2, %3":"=v"(r):"v"(a),"v"(b),"v"(c));return r;}
__device__ __forceinline__ float max2f(float a,float b){float r;asm("v_max_f32_e32 %0, %1, %2":"=v"(r):"v"(a),"v"(b));return r;}
__device__ __forceinline__ float fadd_s(float a,float b){float r;asm("v_add_f32_e32 %0, %1, %2":"=v"(r):"v"(a),"v"(b));return r;}
__device__ __forceinline__ float fsub_s(float a,float b){float r;asm("v_sub_f32_e32 %0, %1, %2":"=v"(r):"v"(a),"v"(b));return r;}
typedef float f32x2_t __attribute__((ext_vector_type(2))); typedef __bf16 bf16x2_t __attribute__((ext_vector_type(2)));
__device__ __forceinline__ unsigned cvtpk_s(float lo,float hi){f32x2_t v={lo,hi};bf16x2_t b=__builtin_convertvector(v,bf16x2_t);return __builtin_bit_cast(unsigned,b);}
#define WAIT_BAR(N) asm volatile("s_waitcnt vmcnt(" #N ") lgkmcnt(0)\n\ts_barrier":::"memory")

__device__ __forceinline__ void qkt(f32x16&p0,f32x16&p1,const char*Kslot,const bf16x8*qr,const f32x16&c0,const f32x16&c1,int r32,int hi){
  const char*kb=Kslot+hi*1024+r32*16;
  #pragma unroll
  for(int d0=0;d0<4;++d0){
    const bf16x8 b0=*reinterpret_cast<const bf16x8*>(kb+d0*2048);
    const bf16x8 b1=*reinterpret_cast<const bf16x8*>(kb+d0*2048+512);
    if(d0==0){p0=__builtin_amdgcn_mfma_f32_32x32x16_bf16(b0,qr[0],c0,0,0,0);p1=__builtin_amdgcn_mfma_f32_32x32x16_bf16(b1,qr[0],c1,0,0,0);}
    else{p0=__builtin_amdgcn_mfma_f32_32x32x16_bf16(b0,qr[d0],p0,0,0,0);p1=__builtin_amdgcn_mfma_f32_32x32x16_bf16(b1,qr[d0],p1,0,0,0);}}
}
typedef __attribute__((address_space(3))) const char* lds_cptr;
typedef short v4i16_t __attribute__((ext_vector_type(4)));
__device__ __forceinline__ void kload8(bf16x8*kf,lds_cptr kp){
  kf[0]=*(const __attribute__((address_space(3))) bf16x8*)(kp);      kf[1]=*(const __attribute__((address_space(3))) bf16x8*)(kp+512);
  kf[2]=*(const __attribute__((address_space(3))) bf16x8*)(kp+2048); kf[3]=*(const __attribute__((address_space(3))) bf16x8*)(kp+2560);
  kf[4]=*(const __attribute__((address_space(3))) bf16x8*)(kp+4096); kf[5]=*(const __attribute__((address_space(3))) bf16x8*)(kp+4608);
  kf[6]=*(const __attribute__((address_space(3))) bf16x8*)(kp+6144); kf[7]=*(const __attribute__((address_space(3))) bf16x8*)(kp+6656);
}
__device__ __forceinline__ void kload2(bf16x8*kf,lds_cptr kp,int j){ kf[2*j]=*(const __attribute__((address_space(3))) bf16x8*)(kp+j*2048); kf[2*j+1]=*(const __attribute__((address_space(3))) bf16x8*)(kp+j*2048+512); }
__device__ __forceinline__ s16x4 vtr(lds_cptr p){ return __builtin_bit_cast(s16x4,__builtin_amdgcn_ds_read_tr16_b64_v4i16((__attribute__((address_space(3))) v4i16_t*)p)); }
__device__ __forceinline__ float rowmax(const f32x16&p0,const f32x16&p1){
  float a=max3f(p0[0],p0[1],p1[0]),b=max3f(p0[2],p0[3],p1[1]);a=max3f(a,p1[2],p1[3]);
  #pragma unroll
  for(int r=4;r<16;r+=4){a=max3f(a,p0[r],p0[r+1]);b=max3f(b,p0[r+2],p0[r+3]);a=max3f(a,p1[r],p1[r+1]);b=max3f(b,p1[r+2],p1[r+3]);}
  const float m=max2f(a,b);
  auto rr=__builtin_amdgcn_permlane32_swap(__float_as_uint(m),__float_as_uint(m),false,false);
  return max2f(__uint_as_float(rr[0]),__uint_as_float(rr[1]));
}
__device__ __forceinline__ void pv(f32x16*o,int vb,bf16x8 pa0,bf16x8 pa1,bf16x8 pa2,bf16x8 pa3){
  #pragma unroll
  for(int d0=0;d0<2;++d0){s16x4 lo[4],hi[4];
    #pragma unroll
    for(int ks=0;ks<4;++ks){
      asm volatile("ds_read_b64_tr_b16 %0,%1 offset:%c2":"=&v"(lo[ks]):"v"(vb),"i"(d0*4096+ks*1024):"memory");
      asm volatile("ds_read_b64_tr_b16 %0,%1 offset:%c2":"=&v"(hi[ks]):"v"(vb),"i"(d0*4096+ks*1024+512):"memory");}
    asm volatile("s_waitcnt lgkmcnt(0)":::"memory");SBAR();
    #define PK(k) (bf16x8){lo[k][0],lo[k][1],lo[k][2],lo[k][3],hi[k][0],hi[k][1],hi[k][2],hi[k][3]}
    o[d0]=__builtin_amdgcn_mfma_f32_32x32x16_bf16(pa0,PK(0),o[d0],0,0,0);
    o[d0]=__builtin_amdgcn_mfma_f32_32x32x16_bf16(pa1,PK(1),o[d0],0,0,0);
    o[d0]=__builtin_amdgcn_mfma_f32_32x32x16_bf16(pa2,PK(2),o[d0],0,0,0);
    o[d0]=__builtin_amdgcn_mfma_f32_32x32x16_bf16(pa3,PK(3),o[d0],0,0,0);
    #undef PK
  }
}

#ifndef ATTN_STORE16
#define ATTN_STORE16(p,v) (*(u32x4*)(p)=(v))
#endif
template<int THRL,bool FOX> __device__ __forceinline__ void attn_unit(int b,int h,int qb,const bf16*Q,const bf16*__restrict__ K,const bf16*__restrict__ V,bf16*Y,int ycol0,const float*__restrict__ gout,const float*__restrict__ cbg,char*shm){
  int tid_=threadIdx.x; asm volatile("":"+v"(tid_));
  const int tid=tid_,lane=tid&63,r32=lane&31,hi=lane>>5; const int wid=__builtin_amdgcn_readfirstlane(tid>>6);
  const long rowbase=(long)b*SEQ; const long kvbase=FOX?rowbase:(long)b*KVMEM; const int q0=qb*QB;
  const bf16*Qw=Q+(rowbase+q0+wid*QBLK)*DM+h*D;
  const bf16*Kh=K+kvbase*DM+h*D,*Vh=V+kvbase*DM+h*D;
  const unsigned lds0=(unsigned)(uintptr_t)shm;
  float*wsf=(float*)(shm+LDS_WS)+wid*64;
  const bf16*ksrc=Kh+(long)lane*DM+wid*8;
  const bf16*vsrc=Vh+(long)(16*(wid&3)+(lane>>2))*DM+(wid>>2)*32+(lane&3)*8;
  const unsigned kdst=lds0+LDS_K+wid*1024, vdst=lds0+LDS_V+wid*1024;
  #define DMA_K(t,slot) glds16(ksrc+(long)(t)*KVBLK*DM,(unsigned)__builtin_amdgcn_readfirstlane(kdst+(slot)))
  #define DMA_V(t,slot) glds16(vsrc+(long)(t)*KVBLK*DM,(unsigned)__builtin_amdgcn_readfirstlane(vdst+(slot)))
  const int vb0=(int)(lds0+LDS_V)+((lane>>4)&1)*32+(lane&3)*8+(4*hi+((lane&15)>>2))*64;
  const char*Kbase=shm+LDS_K; bf16x8 kf[8];
  const lds_cptr shm3=(lds_cptr)shm; const lds_cptr kp0=shm3+LDS_K+hi*1024+r32*16; const lds_cptr vp0=shm3+LDS_V+((lane>>4)&1)*32+(lane&3)*8+(4*hi+((lane&15)>>2))*64;
  const int NT=FOX?(q0+QB)/KVBLK:KVMEM/KVBLK;
  const int qrel=wid*QBLK+r32;
  typedef __attribute__((address_space(3))) unsigned long long lds_u64;
  float cbq=0.f; unsigned bkbase=0u, bkstep=0u;
  if(FOX){ lds_u64*tb=(lds_u64*)((__attribute__((address_space(3))) char*)shm+LDS_CB); const int ncb=q0+QB;
    for(int i=tid;i<ncb;i+=NW*64){ const float x=-cbg[i]; const unsigned h_=f2bf_a(x); const float r1=x-__uint_as_float(h_<<16); const unsigned m_=f2bf_a(r1); const float r2=r1-__uint_as_float(m_<<16); const unsigned l_=f2bf_a(r2);
      tb[i]=(unsigned long long)(h_|(m_<<16))|((unsigned long long)l_<<32); }
    if(tid==0){ unsigned long long z_=0ull; asm volatile("":"+v"(z_)); tb[SEQ]=z_; tb[SEQ+1]=z_; }
    cbq=cbg[q0+qrel];
    asm volatile("s_waitcnt vmcnt(0) lgkmcnt(0)\n\ts_barrier":::"memory");
    bkbase=hi?(unsigned)(LDS_CBZ):(unsigned)(LDS_CB+r32*8); bkstep=hi?0u:512u; }
  const bf16x8 qone=(bf16x8){(short)0x3F80,(short)0x3F80,(short)0x3F80,(short)0x3F80,(short)0x3F80,(short)0x3F80,(short)0x3F80,(short)0x3F80};
  #define LOADBK(B0,B1,t) do{ const lds_cptr bp_=(lds_cptr)shm+bkbase+(unsigned)(t)*bkstep; const unsigned long long x0_=*(const __attribute__((address_space(3))) unsigned long long*)bp_, x1_=*(const __attribute__((address_space(3))) unsigned long long*)(bp_+(hi?0:256)); \
    B0=__builtin_bit_cast(bf16x8,(u32x4){(unsigned)x0_,(unsigned)(x0_>>32),0u,0u}); B1=__builtin_bit_cast(bf16x8,(u32x4){(unsigned)x1_,(unsigned)(x1_>>32),0u,0u}); }while(0)
  DMA_K(0,0);DMA_V(0,0);DMA_K(1,SLOTB);
  bf16x8 qr[4];
  #pragma unroll
  for(int d0=0;d0<4;++d0)qr[d0]=*reinterpret_cast<const bf16x8*>(&Qw[(long)r32*DM+d0*16+hi*8]);
  typedef __attribute__((address_space(3))) bf16x8 lds_bf8; lds_bf8*qst=(lds_bf8*)((__attribute__((address_space(3))) char*)shm+LDS_OST+wid*4096)+lane;
  if(FOX){
  #pragma unroll
  for(int d0=0;d0<4;++d0)qst[d0*64]=qr[d0]; }
  #define QL(i) (*(qst+(i)*64))
  float mhat=-cbq,l_reg=0.f;f32x16 o[2];o[0]=f32x16{};o[1]=f32x16{};f32x16 negm;
  #pragma unroll
  for(int r=0;r<16;++r)negm[r]=cbq;
  asm volatile("":"+v"(negm));
  #define CMASK(P0,P1,t) do{ if(FOX && !defined_nomask){int jb_=(t)-(NT-4); if(jb_>=0)cmask(P0,P1,jb_,qrel,hi);} }while(0)
  bool resc=false;
  #define START(P0,P1) do{ const float rm=rowmax(P0,P1); resc=false; \
    { const float dl=rm; mhat=fadd_s(mhat,dl); \
      _Pragma("unroll") for(int r=0;r<16;++r){P0[r]=fsub_s(P0[r],dl);P1[r]=fsub_s(P1[r],dl);} \
      _Pragma("unroll") for(int r=0;r<16;++r)negm[r]=-mhat; asm volatile("":"+v"(negm)); } \
    _Pragma("unroll") for(int r=0;r<16;++r)P0[r]=__builtin_amdgcn_exp2f(P0[r]); }while(0)
  #define RESC() do{ if(resc){ asm volatile("s_waitcnt lgkmcnt(0)":::"memory"); \
      _Pragma("unroll") for(int d_=0;d_<2;++d_) _Pragma("unroll") for(int r=0;r<16;++r)o[d_][r]*=wsf[crow(r,hi)]; } }while(0)
  f32x16 pA0,pA1,pB0,pB1;
  int sl_prev=0,sl_cur=0,sl_next=SLOTB;
  #define ROT() do{sl_prev=sl_cur;sl_cur=sl_next;sl_next=(sl_next==(NSLOT-1)*SLOTB)?0:sl_next+SLOTB;}while(0)
  DMA_K(2,2*SLOTB);
  WAIT_BAR(3);
  if(FOX){ bf16x8 bk0_,bk1_; LOADBK(bk0_,bk1_,0); pA0=__builtin_amdgcn_mfma_f32_32x32x16_bf16(bk0_,qone,negm,0,0,0); pA1=__builtin_amdgcn_mfma_f32_32x32x16_bf16(bk1_,qone,negm,0,0,0); qkt(pA0,pA1,Kbase,qr,pA0,pA1,r32,hi); }
  else qkt(pA0,pA1,Kbase,qr,negm,negm,r32,hi);
  asm volatile("s_nop 15\n\ts_nop 7":"+v"(pA0),"+v"(pA1));CMASK(pA0,pA1,0);
  START(pA0,pA1);
  _Pragma("unroll") for(int r=0;r<16;++r)pA1[r]=__builtin_amdgcn_exp2f(pA1[r]);
  WAIT_BAR(0);
  DMA_K(3,0);DMA_V(1,SLOTB);
  ROT();
  kload8(kf,kp0+sl_cur);
  WAIT_BAR(2);
  s16x4 vlo[8],vhi[8]; u32x4 pw0,pw1,pw2,pw3;
  #define PKW(P,B) cvtpk_s(P[B],P[B+1])
  #define PAF(k) __builtin_bit_cast(bf16x8,pw##k)
  #define VFR(i) (bf16x8){vlo[i][0],vlo[i][1],vlo[i][2],vlo[i][3],vhi[i][0],vhi[i][1],vhi[i][2],vhi[i][3]}
  #define PIN(x) asm volatile("":"+v"(x))
  #define MX3(a,b,c) __builtin_fmaxf(__builtin_fmaxf((a),(b)),(c))
  #define GAPA(MF,A0,A1,A2,A3,W0,W1,PW) do{ MF; sacc+=A0; sacc+=A1; sacc+=A2; sacc+=A3; PIN(sacc); W0; W1; PIN(PW); SBAR(); }while(0)
  #define EX(v) __builtin_amdgcn_exp2f(v)
  #define GAPB(MF,X,B) do{ MF; X[B]=EX(X[B]); X[B+1]=EX(X[B+1]); X[B+2]=EX(X[B+2]); X[B+3]=EX(X[B+3]); PIN(X); SBAR(); }while(0)
  #define VRD(i) do{ vlo[i]=vtr(vp_+(((i)>>2)*4096+((i)&3)*1024)); vhi[i]=vtr(vp_+(((i)>>2)*4096+((i)&3)*1024+512)); }while(0)
  #define KRD(G,j) do{ if(G){ kload2(kf,kp0+sl_next,j); SBAR(); } }while(0)
  #define STEP(C0,C1,P0,P1,t,GK,GV,GL) do{ SBAR(); \
    if(FOX){ bf16x8 bk0_,bk1_; LOADBK(bk0_,bk1_,t); C0=__builtin_amdgcn_mfma_f32_32x32x16_bf16(bk0_,qone,negm,0,0,0); C1=__builtin_amdgcn_mfma_f32_32x32x16_bf16(bk1_,qone,negm,0,0,0); SBAR(); } \
    const lds_cptr vp_=vp0+sl_prev; \
    bf16x8 qa_,qb_; if(FOX){qa_=QL(0);}else{qa_=qr[0];} \
    VRD(0); SBAR(); float sacc=(P0[0]+P0[1]); \
    GAPA(C0=__builtin_amdgcn_mfma_f32_32x32x16_bf16(kf[0],qa_,FOX?C0:negm,0,0,0), P0[2],P0[3],P0[4],P0[5],     pw0[0]=PKW(P0,0), pw0[1]=PKW(P0,2), pw0); \
    VRD(4); if(FOX){qb_=QL(1);}else{qb_=qr[1];} SBAR(); GAPA(C1=__builtin_amdgcn_mfma_f32_32x32x16_bf16(kf[1],qa_,FOX?C1:negm,0,0,0), P0[6],P0[7],P0[8],P0[9],     pw0[2]=PKW(P0,4), pw0[3]=PKW(P0,6), pw0); \
    VRD(1); SBAR(); GAPA(C0=__builtin_amdgcn_mfma_f32_32x32x16_bf16(kf[2],qb_,C0,0,0,0),   P0[10],P0[11],P0[12],P0[13], pw1[0]=PKW(P0,8), pw1[1]=PKW(P0,10), pw1); \
    VRD(5); if(FOX){qa_=QL(2);}else{qa_=qr[2];} SBAR(); GAPA(C1=__builtin_amdgcn_mfma_f32_32x32x16_bf16(kf[3],qb_,C1,0,0,0),   P0[14],P0[15],P1[0],P1[1],   pw1[2]=PKW(P0,12),pw1[3]=PKW(P0,14), pw1); \
    VRD(2); SBAR(); GAPA(C0=__builtin_amdgcn_mfma_f32_32x32x16_bf16(kf[4],qa_,C0,0,0,0),   P1[2],P1[3],P1[4],P1[5],     pw2[0]=PKW(P1,0), pw2[1]=PKW(P1,2), pw2); \
    VRD(6); if(FOX){qb_=QL(3);}else{qb_=qr[3];} SBAR(); GAPA(C1=__builtin_amdgcn_mfma_f32_32x32x16_bf16(kf[5],qa_,C1,0,0,0),   P1[6],P1[7],P1[8],P1[9],     pw2[2]=PKW(P1,4), pw2[3]=PKW(P1,6), pw2); \
    VRD(3); SBAR(); GAPA(C0=__builtin_amdgcn_mfma_f32_32x32x16_bf16(kf[6],qb_,C0,0,0,0),   P1[10],P1[11],P1[12],P1[13], pw3[0]=PKW(P1,8), pw3[1]=PKW(P1,10), pw3); \
    VRD(7); SBAR(); GAPA(C1=__builtin_amdgcn_mfma_f32_32x32x16_bf16(kf[7],qb_,C1,0,0,0),   P1[14],P1[15],0.f,0.f,       pw3[2]=PKW(P1,12),pw3[3]=PKW(P1,14), pw3); \
    l_reg+=sacc; \
    if(GK){DMA_K((t)+3,sl_cur);} if(GV){DMA_V((t)+1,sl_next);} \
    CMASK(C0,C1,t); \
    { float a=MX3(C0[0],C0[1],C1[0]),b=MX3(C0[2],C0[3],C1[1]); a=MX3(a,C1[2],C1[3]); \
      _Pragma("unroll") for(int r=4;r<16;r+=4){a=MX3(a,C0[r],C0[r+1]);b=MX3(b,C0[r+2],C0[r+3]);a=MX3(a,C1[r],C1[r+1]);b=MX3(b,C1[r+2],C1[r+3]);} \
      float rm=__builtin_fmaxf(a,b); { auto rr=__builtin_amdgcn_permlane32_swap(__float_as_uint(rm),__float_as_uint(rm),false,false); rm=__builtin_fmaxf(__uint_as_float(rr[0]),__uint_as_float(rr[1])); } \
      resc=false; \
      if(__builtin_expect(__any(rm>(float)THRL),0)){ const float dl=__builtin_fmaxf(rm,0.f); mhat+=dl; \
        _Pragma("unroll") for(int r=0;r<16;++r){C0[r]-=dl;C1[r]-=dl;} \
        _Pragma("unroll") for(int r=0;r<16;++r)negm[r]=-mhat; asm volatile("":"+v"(negm)); \
        const float f=__builtin_amdgcn_exp2f(-dl); l_reg*=f; if(hi==0)wsf[r32]=f; resc=true; } } \
    SBAR(); \
    GAPB(o[0]=__builtin_amdgcn_mfma_f32_32x32x16_bf16(PAF(0),VFR(0),o[0],0,0,0), C0,0); \
    GAPB(o[1]=__builtin_amdgcn_mfma_f32_32x32x16_bf16(PAF(0),VFR(4),o[1],0,0,0), C0,4); \
    KRD(GL,0); GAPB(o[0]=__builtin_amdgcn_mfma_f32_32x32x16_bf16(PAF(1),VFR(1),o[0],0,0,0), C0,8); \
    KRD(GL,1); GAPB(o[1]=__builtin_amdgcn_mfma_f32_32x32x16_bf16(PAF(1),VFR(5),o[1],0,0,0), C0,12); \
    KRD(GL,2); GAPB(o[0]=__builtin_amdgcn_mfma_f32_32x32x16_bf16(PAF(2),VFR(2),o[0],0,0,0), C1,0); \
    KRD(GL,3); GAPB(o[1]=__builtin_amdgcn_mfma_f32_32x32x16_bf16(PAF(2),VFR(6),o[1],0,0,0), C1,4); \
    GAPB(o[0]=__builtin_amdgcn_mfma_f32_32x32x16_bf16(PAF(3),VFR(3),o[0],0,0,0), C1,8); \
    GAPB(o[1]=__builtin_amdgcn_mfma_f32_32x32x16_bf16(PAF(3),VFR(7),o[1],0,0,0), C1,12); \
    }while(0)
  int t=1;
  #undef CMASK
  #define CMASK(P0,P1,t) do{}while(0)
  for(;t+5<NT;t+=2){
    STEP(pB0,pB1,pA0,pA1,t,true,true,true);     WAIT_BAR(2); RESC(); ROT();
    STEP(pA0,pA1,pB0,pB1,t+1,true,true,true);   WAIT_BAR(2); RESC(); ROT();
  }
  #undef CMASK
  #define CMASK(P0,P1,t) do{ if(FOX && !defined_nomask){int jb_=(t)-(NT-4); if(jb_>=0)cmask(P0,P1,jb_,qrel,hi);} }while(0)
  #define ENDW(tt) do{ if((tt)+3<NT){WAIT_BAR(2);} else if((tt)+2<NT){WAIT_BAR(1);} else {WAIT_BAR(0);} }while(0)
  for(;t+1<NT;t+=2){
    STEP(pB0,pB1,pA0,pA1,t,(t+3<NT),(t+1<NT),(t+1<NT));       ENDW(t);   RESC(); ROT();
    STEP(pA0,pA1,pB0,pB1,t+1,(t+4<NT),(t+2<NT),(t+2<NT));     ENDW(t+1); RESC(); ROT();
  }
  STEP(pB0,pB1,pA0,pA1,NT-1,false,false,false); RESC();
  { float sacc=pB0[0]+pB0[1]; _Pragma("unroll") for(int r=2;r<16;++r)sacc+=pB0[r]; _Pragma("unroll") for(int r=0;r<16;++r)sacc+=pB1[r]; l_reg+=sacc;
    pw0=(u32x4){PKW(pB0,0),PKW(pB0,2),PKW(pB0,4),PKW(pB0,6)};pw1=(u32x4){PKW(pB0,8),PKW(pB0,10),PKW(pB0,12),PKW(pB0,14)};pw2=(u32x4){PKW(pB1,0),PKW(pB1,2),PKW(pB1,4),PKW(pB1,6)};pw3=(u32x4){PKW(pB1,8),PKW(pB1,10),PKW(pB1,12),PKW(pB1,14)};
    SBAR(); pv(o,vb0+sl_cur,PAF(0),PAF(1),PAF(2),PAF(3)); }
  #undef PKW
  #undef PAF
  #undef VFR
  #undef PIN
  #undef MX3
  #undef GAPA
  #undef GAPB
  #undef EX
  #undef VRD
  #undef KRD
  #undef STEP
  #undef ENDW
  {auto rr=__builtin_amdgcn_permlane32_swap(__float_as_uint(l_reg),__float_as_uint(l_reg),false,false);l_reg=__uint_as_float(rr[0])+__uint_as_float(rr[1]);}
  if(hi==0)wsf[32+r32]=l_reg;asm volatile("s_waitcnt lgkmcnt(0)":::"memory");
  float rli[16];
  #pragma unroll
  for(int r=0;r<16;++r)rli[r]=__builtin_amdgcn_rcpf(wsf[32+crow(r,hi)]);
  bf16*Yw=Y+(rowbase+q0+wid*QBLK)*YP+ycol0+h*D;
  { bf16*stg=(bf16*)(shm+LDS_OST)+wid*2048;
    #pragma unroll
    for(int r=0;r<16;++r){const int orow=crow(r,hi);
      #pragma unroll
      for(int d0=0;d0<2;++d0)stg[orow*64+d0*32+r32]=__float2bfloat16(o[d0][r]*rli[r]);}
    asm volatile("s_waitcnt lgkmcnt(0)":::"memory");
    const int ch=lane&7; const f32x4v g0=*(const f32x4v*)(gout+h*D+ch*8), g1=*(const f32x4v*)(gout+h*D+ch*8+4);
    #pragma unroll
    for(int i=0;i<4;++i){const int row=i*8+(lane>>3); const u32x4 v=*(const u32x4*)(stg+row*64+ch*8);
      float f[8];
      #pragma unroll
      for(int k=0;k<4;++k){ f[2*k]=__uint_as_float(v[k]<<16); f[2*k+1]=__uint_as_float(v[k]&0xffff0000u); }
      float ss=0.f;
      #pragma unroll
      for(int k=0;k<8;++k)ss+=f[k]*f[k];
      ss+=__shfl_xor(ss,1); ss+=__shfl_xor(ss,2); ss+=__shfl_xor(ss,4);
      const float rstd=1.0f/sqrtf(ss*(1.0f/64.0f)+1e-6f);
      u32x4 w; w.x=cvtpk_s(f[0]*rstd*g0[0],f[1]*rstd*g0[1]); w.y=cvtpk_s(f[2]*rstd*g0[2],f[3]*rstd*g0[3]); w.z=cvtpk_s(f[4]*rstd*g1[0],f[5]*rstd*g1[1]); w.w=cvtpk_s(f[6]*rstd*g1[2],f[7]*rstd*g1[3]);
      ATTN_STORE16(Yw+(long)row*YP+ch*8,w);} }
  asm volatile("s_waitcnt lgkmcnt(0)\n\ts_barrier":::"memory");
  #undef LOADBK
  #undef QL
  #undef DMA_K
  #undef DMA_V
  #undef CMASK
  #undef START
  #undef RESC
  #undef ROT
}
constexpr int ATTN_LDS_BYTES=LDS_BYTES;
struct AttnUnit { int bh; int qb; };
#undef SBAR
#undef WAIT_BAR
}
#define GAS __attribute__((address_space(1)))
#define LAS __attribute__((address_space(3)))
typedef unsigned short bf16;
typedef unsigned v4u __attribute__((ext_vector_type(4)));
typedef float f32x4 __attribute__((ext_vector_type(4)));
typedef short bf16x8 __attribute__((ext_vector_type(8)));
typedef GAS unsigned gu32;
typedef GAS unsigned long long gu64;
#define RLX_AGENT __ATOMIC_RELAXED, __HIP_MEMORY_SCOPE_AGENT
#define LDS_WAIT() asm volatile("s_waitcnt lgkmcnt(0)" ::: "memory")
#define VM_WAIT() asm volatile("s_waitcnt vmcnt(0)" ::: "memory")
__device__ __forceinline__ unsigned long long rt() { return __builtin_amdgcn_s_memrealtime(); }
__device__ __forceinline__ unsigned f2bf(float f) { unsigned u = __builtin_bit_cast(unsigned, f); return (u + 0x7fffu + ((u >> 16) & 1u)) >> 16; }
__device__ __forceinline__ unsigned pk2(float lo, float hi) { return f2bf(lo) | (f2bf(hi) << 16); }

#define XB_TMO      128
#define XB_XCNT(j)  (256  + 64 * (j))
#define XB_XSUB(j)  (1280 + 64 * (j))
#define XB_XGEN(j)  (2304 + 64 * (j))
#define XB_TOP      3328
#define XB_TOPGEN   3392
#define XCD_BAR_WORDS 3456
#define XB_SPIN_CAP (1u << 18)

__device__ __forceinline__ unsigned xb_ld(unsigned* p)              { return __hip_atomic_load(p, __ATOMIC_RELAXED, __HIP_MEMORY_SCOPE_AGENT); }
__device__ __forceinline__ unsigned xb_add(unsigned* p, unsigned v) { return __hip_atomic_fetch_add(p, v, __ATOMIC_RELAXED, __HIP_MEMORY_SCOPE_AGENT); }
__device__ __forceinline__ unsigned xb_xcc_id() { return (unsigned)__builtin_amdgcn_s_getreg((3 << 11) | 20) & 0xFu; }
#define XB_SPIN(cond, bar) do { unsigned _sp = 0; while (cond) { __builtin_amdgcn_s_sleep(1); \
    if ((++_sp & 255u) == 0u) { if (xb_ld(&(bar)[XB_TMO])) break; if (_sp > XB_SPIN_CAP) { atomicAdd(&(bar)[XB_TMO], 1u); break; } } } } while (0)

struct XcdBarrier {
    unsigned* bar; unsigned x;
    volatile LAS unsigned* st;
};

__device__ __forceinline__ XcdBarrier xcd_barrier_post(unsigned* bar, volatile LAS unsigned* st) {
    XcdBarrier b; b.bar = bar; b.x = xb_xcc_id(); b.st = st;
    if (threadIdx.x == 0) (void)xb_add(&bar[XB_XCNT(b.x)], 1u);
    return b;
}
__device__ __forceinline__ void xcd_barrier_complete(unsigned* bar, unsigned x, unsigned& nloc, unsigned& nx) {
    const unsigned G = gridDim.x * gridDim.y * gridDim.z;
    unsigned sum, cnt, mine, sp = 0u;
    for (;;) {
        sum = 0u; cnt = 0u; mine = 0u;
#pragma unroll
        for (unsigned j = 0; j < 16; ++j) { const unsigned c = xb_ld(&bar[XB_XCNT(j)]); sum += c; cnt += (c > 0u) ? 1u : 0u; mine = (j == x) ? c : mine; }
        if (sum == G) break;
        __builtin_amdgcn_s_sleep(1);
        if ((++sp & 255u) == 0u) { if (xb_ld(&bar[XB_TMO])) break; if (sp > XB_SPIN_CAP) { atomicAdd(&bar[XB_TMO], 1u); break; } }
    }
    nloc = mine > 0u ? mine : 1u; nx = cnt > 0u ? cnt : 1u;
}

__device__ __forceinline__ void xcd_barrier(const XcdBarrier& b) {
    asm volatile("s_waitcnt vmcnt(0)" ::: "memory");
    __syncthreads();
    if (threadIdx.x == 0) {
        unsigned* bar = b.bar;
        __builtin_amdgcn_s_waitcnt(0);
        unsigned nloc = b.st[0], nx = b.st[1];
        if (nloc == 0u) { xcd_barrier_complete(bar, b.x, nloc, nx); b.st[0] = nloc; b.st[1] = nx; }
        const unsigned old = xb_add(&bar[XB_XSUB(b.x)], 1u);
        const unsigned gen = old / nloc;
        if (old + 1u == (gen + 1u) * nloc) {
            __builtin_amdgcn_fence(__ATOMIC_RELEASE, "agent");
            asm volatile("s_waitcnt vmcnt(0)" ::: "memory");
            const unsigned og = xb_add(&bar[XB_TOP], 1u);
            const unsigned tg = og / nx;
            if (og + 1u == (tg + 1u) * nx) xb_add(&bar[XB_TOPGEN], 1u);
            else XB_SPIN(xb_ld(&bar[XB_TOPGEN]) == tg, bar);
            __builtin_amdgcn_fence(__ATOMIC_ACQUIRE, "agent");
            xb_add(&bar[XB_XGEN(b.x)], 1u);
            asm volatile("s_waitcnt vmcnt(0)" ::: "memory");
        } else {
            XB_SPIN(xb_ld(&bar[XB_XGEN(b.x)]) == gen, bar);
            __builtin_amdgcn_fence(__ATOMIC_ACQUIRE, "agent");
            asm volatile("s_waitcnt vmcnt(0)" ::: "memory");
        }
    }
    __syncthreads();
}
#ifndef MK_ONE_LAUNCH
#define MK_ONE_LAUNCH 1
#endif
#ifndef DEPTH_RUN
#define DEPTH_RUN DEPTH
#endif
constexpr int PH_PER_LAYER = 9, N_PHASES = 2 + DEPTH_RUN * PH_PER_LAYER;

constexpr int RING_OFF = 0, RING_BYTES = 153600;
constexpr int LDSCTL_OFF = RING_BYTES, GTAB_OFF = LDSCTL_OFF  , MISC_OFF = LDSCTL_OFF + 320;
constexpr int LDS_BYTES = 154624;
static_assert(MISC_OFF + 128 <= LDS_BYTES && attn_body::LDS_BYTES <= RING_BYTES, "LDS map");

struct Frame {
    LAS unsigned char* lds;
    volatile LAS unsigned* MISC;
    gu32* ctl;
    int tid, lane, wave, vcu, G;
};
__device__ __forceinline__ float wave_sum(float v) {
#pragma unroll
    for (int o = 1; o < 64; o <<= 1) v += __shfl_xor(v, o);
    return v;
}

struct WSrc { const float* p; int col; int N; };
__device__ __forceinline__ WSrc wsrc(int kind, int d, const float* w0, const float* w1) {
    WSrc s; s.p = w0; s.col = -1; s.N = 1;
    if (kind == 0) {
        const int pn = d >> 8, c = d & 255, bj = c >> 7, wc = (c >> 5) & 3, dlo = c & 31, hd = 64 * wc + 32 * bj + dlo;
        s.N = IN_COLS;
        if (pn == 0) s.col = hd; else if (pn == 1) s.col = 256 + hd; else if (pn <= 3) s.col = 512 + 256 * (pn - 2) + c; else if (pn <= 5) s.col = 1024 + 256 * (pn - 4) + c;
        else if (pn == 6) s.col = 1536 + hd; else if (pn == 7) s.col = 1792 + hd; else if (pn == 8) s.col = 2048 + c; else if (pn == 9) s.col = 2308 + hd;
        else if (pn == 10) s.col = c < 4 ? 2304 + c : -1;
        else { s.p = w1; s.N = 512; s.col = pn == 11 ? hd : 256 + c; }
    } else if (kind == 1) { s.N = D_MODEL; s.col = d; }
    else if (kind == 2) { const int pn = d >> 8, c = d & 255, f = 128 * pn + (c & 127); s.N = D_FF; s.p = c < 128 ? w0 : w1; s.col = f < D_FF ? f : -1; }
    else { s.N = D_MODEL; s.col = d; }
    return s;
}
__device__ __forceinline__ void tr_item(int kind, const float* w0, const float* w1, int Ksrc, bf16* dst, int Kd, int row0, int k0, LAS float* scr, int lane) {
    const WSrc s = wsrc(kind, row0 + (lane & 31), w0, w1);
#pragma unroll 8
    for (int i = 0; i < 32; ++i) { const int kk = 2 * i + (lane >> 5), k = k0 + kk; float v = 0.f; if (s.col >= 0 && k < Ksrc) v = s.p[(size_t)k * s.N + s.col]; scr[kk * 33 + (lane & 31)] = v; }
    LDS_WAIT(); asm volatile("" ::: "memory");
    const int c = lane & 7;
#pragma unroll
    for (int j = 0; j < 4; ++j) { const int n = (lane >> 3) + 8 * j; const LAS float* q = scr + (8 * c) * 33 + n;
        v4u o; o.x = pk2(q[0 * 33], q[1 * 33]); o.y = pk2(q[2 * 33], q[3 * 33]); o.z = pk2(q[4 * 33], q[5 * 33]); o.w = pk2(q[6 * 33], q[7 * 33]);
        *(GAS v4u*)(dst + (size_t)(row0 + n) * Kd + k0 + 8 * c) = o; }
    LDS_WAIT(); asm volatile("" ::: "memory");
}
struct In { const float *x, *mem, *attn_g, *w_in, *fbias, *fqg, *fkg, *mqg, *mkg, *memg, *wmemkv, *outg, *w_out, *ffn_g, *dwg, *dwu, *dwd, *router, *ewg, *ewu, *ewd; };

__device__ __forceinline__ void p_prologue(Frame& F, const In& I, unsigned char* ws) {
    LAS float* scr = (LAS float*)(F.lds + RING_OFF + F.wave * 16384);
    const int gw = F.vcu * NWAVES + F.wave, NGW = F.G * NWAVES;
    constexpr int I_IN = (D_MODEL / 64) * (NINKV / 32), I_OUT = (D_MODEL / 64) * (D_MODEL / 32), I_GU = (D_MODEL / 64) * (NGU / 32), I_DN = (FFP / 64) * (D_MODEL / 32);
    constexpr int T_IN = 4 * I_IN, T_OUT = 4 * I_OUT, T_GU = 18 * I_GU, T_DN = 18 * I_DN, NITEMS = T_IN + T_OUT + T_GU + T_DN;
    if (F.vcu == 0) for (int i = F.tid; i < 1024; i += NWAVES * 64) { const int l = i >> 8, w = (i >> 6) & 3, d = i & 63; const float* src = w == 0 ? I.fqg : w == 1 ? I.fkg : w == 2 ? I.mqg : I.mkg; ((float*)(ws + WS_GAINS))[i] = src[l * 64 + d]; }
    for (int it = gw; it < NITEMS; it += NGW) {
        int r = it;
        if (r < T_IN) { const int l = r / I_IN, q = r % I_IN, kb = q / (NINKV / 32), nb = q % (NINKV / 32);
            tr_item(0, I.w_in + (size_t)l * D_MODEL * IN_COLS, I.wmemkv + (size_t)l * D_MODEL * 512, D_MODEL, (bf16*)(ws + WS_WIN + l * SZ_WIN), D_MODEL, 32 * nb, 64 * kb, scr, F.lane); continue; }
        r -= T_IN;
        if (r < T_OUT) { const int l = r / I_OUT, q = r % I_OUT, kb = q / (D_MODEL / 32), nb = q % (D_MODEL / 32);
            tr_item(1, I.w_out + (size_t)l * D_MODEL * D_MODEL, nullptr, D_MODEL, (bf16*)(ws + WS_WOUT + l * SZ_WOUT), D_MODEL, 32 * nb, 64 * kb, scr, F.lane); continue; }
        r -= T_OUT;
        if (r < T_GU) { const int mi = r / I_GU, q = r % I_GU, kb = q / (NGU / 32), nb = q % (NGU / 32);
            const float* g = mi < 2 ? I.dwg + (size_t)mi * D_MODEL * D_FF : I.ewg + (size_t)(mi - 2) * D_MODEL * D_FF; const float* u = mi < 2 ? I.dwu + (size_t)mi * D_MODEL * D_FF : I.ewu + (size_t)(mi - 2) * D_MODEL * D_FF;
            bf16* d = mi < 2 ? (bf16*)(ws + WS_WGU + mi * SZ_WGU) : (bf16*)(ws + WS_EGU + (size_t)(mi - 2) * SZ_WGU);
            tr_item(2, g, u, D_MODEL, d, D_MODEL, 32 * nb, 64 * kb, scr, F.lane); continue; }
        r -= T_GU;
        { const int mi = r / I_DN, q = r % I_DN, kb = q / (D_MODEL / 32), nb = q % (D_MODEL / 32);
            const float* w = mi < 2 ? I.dwd + (size_t)mi * D_FF * D_MODEL : I.ewd + (size_t)(mi - 2) * D_FF * D_MODEL;
            bf16* d = mi < 2 ? (bf16*)(ws + WS_WDN + mi * SZ_WDN) : (bf16*)(ws + WS_EDN + (size_t)(mi - 2) * SZ_WDN);
            tr_item(3, w, nullptr, D_FF, d, FFP, 32 * nb, 64 * kb, scr, F.lane); }
    }
}

struct TokRoute { int e1, p1, e2, p2; float g1, g2; int pad0, pad1; };
struct Combine { const bf16* YD; const TokRoute* R; const LAS int* tab; };
__device__ __forceinline__ void combine_row(const Combine& C, int m, int lane, f32x4 (&xv)[4]) {
    const TokRoute r = C.R[m];
    const GAS unsigned long long* y1 = (const GAS unsigned long long*)(C.YD + (size_t)(C.tab[r.e1] * 256 + r.p1) * D_MODEL) + lane;
    const GAS unsigned long long* y2 = (const GAS unsigned long long*)(C.YD + (size_t)(C.tab[r.e2] * 256 + r.p2) * D_MODEL) + lane;
#pragma unroll
    for (int j = 0; j < 4; ++j) { const unsigned long long a = y1[64 * j], b = y2[64 * j];
        f32x4 ya, yb; ya.x = __uint_as_float((unsigned)a << 16); ya.y = __uint_as_float((unsigned)a & 0xffff0000u); ya.z = __uint_as_float((unsigned)(a >> 32) << 16); ya.w = __uint_as_float((unsigned)(a >> 32) & 0xffff0000u);
        yb.x = __uint_as_float((unsigned)b << 16); yb.y = __uint_as_float((unsigned)b & 0xffff0000u); yb.z = __uint_as_float((unsigned)(b >> 32) << 16); yb.w = __uint_as_float((unsigned)(b >> 32) & 0xffff0000u);
        xv[j] = (xv[j] + ya * r.g1) + yb * r.g2; }
}
__device__ __forceinline__ void build_tab(LAS int* tab, const gu32* counts) {
    __syncthreads();
    if (threadIdx.x == 0) { int t = 0; for (int e = 0; e < N_EXPERTS; ++e) { int n = (int)__hip_atomic_load(counts + e, RLX_AGENT); n = n > 16384 ? 16384 : n; tab[e] = t; t += (n + 255) / 256; } tab[N_EXPERTS] = t; }
    __syncthreads();
}
__device__ __forceinline__ void p_norm(Frame& F, const float* x, float* X, const float* g, bf16* HB, const float* mem, const float* memg, const float* router, gu32* counts, int* list, TokRoute* R, const bool comb, const Combine C) {
    const int gw = F.vcu * NWAVES + F.wave, NGW = F.G * NWAVES; f32x4 hv[4];
    LAS float* wr = (LAS float*)(F.lds + RING_OFF);
    if (router) { for (int i = F.tid; i < D_MODEL * N_EXPERTS / 4; i += NWAVES * 64) ((LAS f32x4*)wr)[i] = ((const GAS f32x4*)router)[i]; __syncthreads(); }
    for (int m = gw; m < M_TOK; m += NGW) {
        const GAS f32x4* xr = (const GAS f32x4*)(x + (size_t)m * D_MODEL) + F.lane; const GAS f32x4* gr = (const GAS f32x4*)g + F.lane;
#pragma unroll
        for (int j = 0; j < 4; ++j) hv[j] = xr[64 * j];
        if (comb) { combine_row(C, m, F.lane, hv); GAS f32x4* xo = (GAS f32x4*)(X + (size_t)m * D_MODEL) + F.lane;
#pragma unroll
            for (int j = 0; j < 4; ++j) xo[64 * j] = hv[j]; }
        if (g) {
            float s = 0.f;
#pragma unroll
            for (int j = 0; j < 4; ++j) s += (hv[j].x * hv[j].x + hv[j].y * hv[j].y) + (hv[j].z * hv[j].z + hv[j].w * hv[j].w);
            const float rstd = 1.f / sqrtf(wave_sum(s) * (1.f / D_MODEL) + EPS);
            GAS unsigned long long* o8 = (GAS unsigned long long*)(HB + (size_t)m * D_MODEL) + F.lane;
#pragma unroll
            for (int j = 0; j < 4; ++j) { const f32x4 gg = gr[64 * j]; hv[j] = hv[j] * rstd * gg; o8[64 * j] = (unsigned long long)pk2(hv[j].x, hv[j].y) | ((unsigned long long)pk2(hv[j].z, hv[j].w) << 32); }
        }
        if (router) {
            float lg[N_EXPERTS];
#pragma unroll
            for (int e = 0; e < N_EXPERTS; ++e) lg[e] = 0.f;
#pragma unroll
            for (int j = 0; j < 4; ++j)
#pragma unroll
                for (int q = 0; q < 4; ++q) { const int k = 256 * j + 4 * F.lane + q; const f32x4 w0 = *(const LAS f32x4*)(wr + k * 8), w1 = *(const LAS f32x4*)(wr + k * 8 + 4); const float h = hv[j][q];
                    lg[0] += h * w0.x; lg[1] += h * w0.y; lg[2] += h * w0.z; lg[3] += h * w0.w; lg[4] += h * w1.x; lg[5] += h * w1.y; lg[6] += h * w1.z; lg[7] += h * w1.w; }
#pragma unroll
            for (int e = 0; e < N_EXPERTS; ++e) lg[e] = wave_sum(lg[e]);
            int e1 = 0; float v1 = lg[0];
#pragma unroll
            for (int e = 1; e < N_EXPERTS; ++e) if (lg[e] > v1) { v1 = lg[e]; e1 = e; }
            int e2 = -1; float v2 = -INFINITY;
#pragma unroll
            for (int e = 0; e < N_EXPERTS; ++e) if (e != e1 && lg[e] > v2) { v2 = lg[e]; e2 = e; }
            const float g2 = 1.0f / (1.0f + __expf(v1 - v2)), g1 = 1.0f - g2;
            if (F.lane == 0) {
                unsigned p1 = __hip_atomic_fetch_add(counts + e1, 1u, RLX_AGENT); if (p1 < 16384u) list[e1 * 16384 + p1] = m; else p1 = 16383u;
                unsigned p2 = __hip_atomic_fetch_add(counts + e2, 1u, RLX_AGENT); if (p2 < 16384u) list[e2 * 16384 + p2] = m; else p2 = 16383u;
                TokRoute r; r.e1 = e1; r.p1 = (int)p1; r.e2 = e2; r.p2 = (int)p2; r.g1 = g1; r.g2 = g2; r.pad0 = 0; r.pad1 = 0; R[m] = r;
            }
        }
    }
    if (mem) for (int m = gw; m < M_MEM; m += NGW) {
        const GAS f32x4* xr = (const GAS f32x4*)(mem + (size_t)m * D_MODEL) + F.lane; const GAS f32x4* gr = (const GAS f32x4*)memg + F.lane; float s = 0.f;
#pragma unroll
        for (int j = 0; j < 4; ++j) { hv[j] = xr[64 * j]; s += (hv[j].x * hv[j].x + hv[j].y * hv[j].y) + (hv[j].z * hv[j].z + hv[j].w * hv[j].w); }
        const float rstd = 1.f / sqrtf(wave_sum(s) * (1.f / D_MODEL) + EPS);
        GAS unsigned long long* o8 = (GAS unsigned long long*)(HB + (size_t)(M_TOK + m) * D_MODEL) + F.lane;
#pragma unroll
        for (int j = 0; j < 4; ++j) { const f32x4 gg = gr[64 * j]; hv[j] = hv[j] * rstd * gg; o8[64 * j] = (unsigned long long)pk2(hv[j].x, hv[j].y) | ((unsigned long long)pk2(hv[j].z, hv[j].w) << 32); }
    }
    if (router) __syncthreads();
}

__device__ __forceinline__ void p_cumsum(Frame& F, const float* LOGF, float* CB) {
    if (F.vcu >= 8) return;
    const float* src = LOGF + (size_t)F.vcu * SEQ + F.tid * 16; float* dst = CB + (size_t)F.vcu * SEQ + F.tid * 16;
    float v[16];
#pragma unroll
    for (int j = 0; j < 4; ++j) { const f32x4 t = *(const f32x4*)(src + 4 * j); v[4 * j] = t.x; v[4 * j + 1] = t.y; v[4 * j + 2] = t.z; v[4 * j + 3] = t.w; }
#pragma unroll
    for (int j = 1; j < 16; ++j) v[j] += v[j - 1];
    float incl = v[15];
#pragma unroll
    for (int o = 1; o < 64; o <<= 1) { const float t = __shfl_up(incl, o); if (F.lane >= o) incl += t; }
    LAS float* wt = (LAS float*)(F.lds + RING_OFF);
    if (F.lane == 63) wt[F.wave] = incl;
    __syncthreads();
    float base = incl - v[15];
    for (int w = 0; w < F.wave; ++w) base += wt[w];
#pragma unroll
    for (int j = 0; j < 4; ++j) { f32x4 t; t.x = (v[4 * j] + base) * 1.4426950408889634f; t.y = (v[4 * j + 1] + base) * 1.4426950408889634f; t.z = (v[4 * j + 2] + base) * 1.4426950408889634f; t.w = (v[4 * j + 3] + base) * 1.4426950408889634f; *(f32x4*)(dst + 4 * j) = t; }
    __syncthreads();
}

constexpr int RT_P = 136;
__device__ __forceinline__ float ret_log2g(int h) { return log2f(1.0f - exp2f(-5.0f - (float)h)); }
__device__ __forceinline__ void ret_stage_v(Frame& F, const bf16* RV, int t0, int h, LAS bf16* vT) {
#pragma unroll
    for (int q = 0; q < 4; ++q) { const int p = F.tid + 512 * q, j = p >> 4, ec = p & 15; const v4u raw = *(const GAS v4u*)(RV + (size_t)(t0 + j) * 512 + 128 * h + 8 * ec);
#pragma unroll
        for (int k = 0; k < 4; ++k) { vT[(8 * ec + 2 * k) * RT_P + j] = (bf16)(raw[k] & 0xffffu); vT[(8 * ec + 2 * k + 1) * RT_P + j] = (bf16)(raw[k] >> 16); } }
}
__device__ __forceinline__ void p_ret_kv(Frame& F, const bf16* RK, const bf16* RV, float* KVT) {
    LAS bf16* vT = (LAS bf16*)(F.lds + RING_OFF); LAS bf16* kT = vT + 128 * RT_P;
    const int er = F.lane & 15, g = F.lane >> 4;
    for (int u = F.vcu; u < 512; u += F.G) {
        const int bh = u >> 6, n = u & 63, b = bh >> 2, h = bh & 3, t0 = b * SEQ + n * 128; const float l2g = ret_log2g(h);
        ret_stage_v(F, RV, t0, h, vT);
#pragma unroll
        for (int q = 0; q < 2; ++q) { const int p = F.tid + 512 * q, j = p >> 3, dc = p & 7; const v4u raw = *(const GAS v4u*)(RK + (size_t)(t0 + j) * 256 + 64 * h + 8 * dc); const float dec = exp2f((float)(127 - j) * l2g);
#pragma unroll
            for (int k = 0; k < 4; ++k) { kT[(8 * dc + 2 * k) * RT_P + j] = (bf16)f2bf(__uint_as_float(raw[k] << 16) * dec); kT[(8 * dc + 2 * k + 1) * RT_P + j] = (bf16)f2bf(__uint_as_float(raw[k] & 0xffff0000u) * dec); } }
        __syncthreads();
        f32x4 acc[4];
#pragma unroll
        for (int dt = 0; dt < 4; ++dt) acc[dt] = (f32x4){0.f, 0.f, 0.f, 0.f};
#pragma unroll
        for (int ks = 0; ks < 4; ++ks) { const bf16x8 a = *(const LAS bf16x8*)(vT + (16 * F.wave + er) * RT_P + 32 * ks + 8 * g);
#pragma unroll
            for (int dt = 0; dt < 4; ++dt) { const bf16x8 bb = *(const LAS bf16x8*)(kT + (16 * dt + er) * RT_P + 32 * ks + 8 * g); acc[dt] = __builtin_amdgcn_mfma_f32_16x16x32_bf16(a, bb, acc[dt], 0, 0, 0); } }
        float* out = KVT + (size_t)u * 8192;
#pragma unroll
        for (int dt = 0; dt < 4; ++dt)
#pragma unroll
            for (int r = 0; r < 4; ++r) out[(16 * F.wave + 4 * g + r) * 64 + 16 * dt + er] = acc[dt][r];
        __syncthreads();
    }
}
__device__ __forceinline__ void p_ret_scan(Frame& F, const float* KVT, bf16* PREVT) {
    for (int idx = F.vcu * 512 + F.tid; idx < 8 * 8192; idx += F.G * 512) {
        const int bh = idx >> 13, ed = idx & 8191, h = bh & 3; const float cd = exp2f(128.0f * ret_log2g(h));
        const float* src = KVT + (size_t)bh * 64 * 8192 + ed; bf16* dst = PREVT + (size_t)bh * 64 * 8192 + ed; float st = 0.f;
#pragma unroll 8
        for (int n = 0; n < 64; ++n) { dst[(size_t)n * 8192] = (bf16)f2bf(st); st = st * cd + src[(size_t)n * 8192]; }
    }
}
__device__ __forceinline__ void p_ret_out(Frame& F, const bf16* RQ, const bf16* RK, const bf16* RV, const bf16* RGs, const bf16* PREVT, const float* gret, bf16* Y) {
    LAS bf16* vT = (LAS bf16*)(F.lds + RING_OFF);
    const int lc = F.lane & 15, g = F.lane >> 4, w = F.wave;
    for (int u = F.vcu; u < 512; u += F.G) {
        const int bh = u >> 6, n = u & 63, b = bh >> 2, h = bh & 3, t0 = b * SEQ + n * 128; const float l2g = ret_log2g(h);
        ret_stage_v(F, RV, t0, h, vT);
        bf16x8 qf[2];
#pragma unroll
        for (int ks = 0; ks < 2; ++ks) qf[ks] = *(const GAS bf16x8*)(RQ + (size_t)(t0 + 16 * w + lc) * 256 + 64 * h + 32 * ks + 8 * g);
        f32x4 accC[8], accI[8];
        const bf16* pv = PREVT + (size_t)u * 8192;
#pragma unroll
        for (int et = 0; et < 8; ++et) { accC[et] = (f32x4){0.f, 0.f, 0.f, 0.f}; accI[et] = (f32x4){0.f, 0.f, 0.f, 0.f};
#pragma unroll
            for (int ks = 0; ks < 2; ++ks) { const bf16x8 a = *(const GAS bf16x8*)(pv + (16 * et + lc) * 64 + 32 * ks + 8 * g); accC[et] = __builtin_amdgcn_mfma_f32_16x16x32_bf16(a, qf[ks], accC[et], 0, 0, 0); } }
        __syncthreads();
        const int iloc = 16 * w + lc;
        for (int kp = 0; kp <= (w >> 1); ++kp) {
            unsigned pk[4];
#pragma unroll
            for (int half = 0; half < 2; ++half) { const int jt = 2 * kp + half; f32x4 s = (f32x4){0.f, 0.f, 0.f, 0.f};
                if (jt <= w) {
#pragma unroll
                    for (int ks = 0; ks < 2; ++ks) { const bf16x8 kf = *(const GAS bf16x8*)(RK + (size_t)(t0 + 16 * jt + lc) * 256 + 64 * h + 32 * ks + 8 * g); s = __builtin_amdgcn_mfma_f32_16x16x32_bf16(kf, qf[ks], s, 0, 0, 0); }
#pragma unroll
                    for (int r = 0; r < 4; ++r) { const int jloc = 16 * jt + 4 * g + r; s[r] = (iloc >= jloc) ? s[r] * exp2f((float)(iloc - jloc) * l2g) : 0.f; }
                }
                pk[2 * half] = pg8::cvt_pk_bf16(s[0], s[1]); pk[2 * half + 1] = pg8::cvt_pk_bf16(s[2], s[3]); }
            const bf16x8 pb = __builtin_bit_cast(bf16x8, (v4u){pk[0], pk[1], pk[2], pk[3]});
#pragma unroll
            for (int et = 0; et < 8; ++et) { const LAS bf16* vr = vT + (16 * et + lc) * RT_P + 32 * kp + 4 * g;
                const unsigned long long lo = *(const LAS unsigned long long*)vr, hi = *(const LAS unsigned long long*)(vr + 16);
                const bf16x8 a = __builtin_bit_cast(bf16x8, (v4u){(unsigned)lo, (unsigned)(lo >> 32), (unsigned)hi, (unsigned)(hi >> 32)});
                accI[et] = __builtin_amdgcn_mfma_f32_16x16x32_bf16(a, pb, accI[et], 0, 0, 0); }
        }
        const float qd = exp2f((float)(iloc + 1) * l2g); float ss = 0.f;
#pragma unroll
        for (int et = 0; et < 8; ++et) { accI[et] = accI[et] + accC[et] * qd; ss += (accI[et][0] * accI[et][0] + accI[et][1] * accI[et][1]) + (accI[et][2] * accI[et][2] + accI[et][3] * accI[et][3]); }
        ss += __shfl_xor(ss, 16); ss += __shfl_xor(ss, 32);
        const float rstd = 1.0f / sqrtf(ss * (1.0f / 128.0f) + EPS);
        const size_t rowo = (size_t)(t0 + iloc);
#pragma unroll
        for (int et = 0; et < 8; ++et) { const int e = 16 * et + 4 * g; const f32x4 gg = *(const f32x4*)(gret + 128 * h + e);
            const unsigned long long rgw = *(const GAS unsigned long long*)(RGs + rowo * 512 + 128 * h + e);
            const float r0 = __uint_as_float((unsigned)rgw << 16), r1 = __uint_as_float((unsigned)rgw & 0xffff0000u), r2 = __uint_as_float((unsigned)(rgw >> 32) << 16), r3 = __uint_as_float((unsigned)(rgw >> 32) & 0xffff0000u);
            const unsigned long long o = (unsigned long long)pk2(accI[et][0] * rstd * gg.x * r0, accI[et][1] * rstd * gg.y * r1) | ((unsigned long long)pk2(accI[et][2] * rstd * gg.z * r2, accI[et][3] * rstd * gg.w * r3) << 32);
            *(GAS unsigned long long*)(Y + rowo * D_MODEL + 128 * h + e) = o; }
        __syncthreads();
    }
}
struct Args { const float* in[21]; float* out; unsigned char* ws; int ph_lo, ph_hi; };
typedef const __attribute__((address_space(4))) Args* kargs_t;
#define KARGS() ({ unsigned long long p_ = (unsigned long long)__builtin_amdgcn_kernarg_segment_ptr(); asm volatile("" : "+s"(p_)); (kargs_t)p_; })
__global__ void __launch_bounds__(NWAVES * 64, 2) trunk_fwd(Args args_unused) {
    extern __shared__ __attribute__((aligned(16))) unsigned char lds[];
    Frame F;
    F.lds = (LAS unsigned char*)lds;
    F.MISC = (volatile LAS unsigned*)(F.lds + MISC_OFF);
    F.tid = threadIdx.x; F.lane = F.tid & 63; F.wave = __builtin_amdgcn_readfirstlane(F.tid >> 6);
    F.G = gridDim.x; { const int bx = blockIdx.x; F.vcu = (F.G % 8 == 0) ? (bx % 8) * (F.G / 8) + bx / 8 : bx; }
    F.ctl = nullptr;
    for (int u = F.tid; u < (LDS_BYTES - LDSCTL_OFF) / 4; u += NWAVES * 64) ((LAS unsigned*)(F.lds + LDSCTL_OFF))[u] = 0u;
    __syncthreads();
    int lo, hi; { kargs_t A = KARGS(); lo = A->ph_lo; hi = A->ph_hi; if (hi - lo > 1) (void)xcd_barrier_post((unsigned*)(A->ws + WS_CTL) + CW_BAR, F.MISC + 8); }
#ifndef PH_MASK
#define PH_MASK 0x3ff
#endif
#define PHON(p) (((PH_MASK) >> (p)) & 1)
#define IN(k) (lo <= (k) && (k) < hi)
#define SEAM(k) do { if (IN(k) && IN((k) + 1)) { kargs_t A_ = KARGS(); XcdBarrier b_; b_.bar = (unsigned*)(A_->ws + WS_CTL) + CW_BAR; b_.x = xb_xcc_id(); b_.st = F.MISC + 8; xcd_barrier(b_); } } while (0)
#define WSP(T, off) ((T*)(ws + (off)))
#define LAUNDER_F() do { asm volatile("" : "+v"(F.tid)); F.lane = F.tid & 63; F.wave = __builtin_amdgcn_readfirstlane(F.tid >> 6); } while (0)

    if (PHON(9) && IN(0)) { LAUNDER_F(); kargs_t A = KARGS(); In I; I.w_in = A->in[3]; I.wmemkv = A->in[10]; I.w_out = A->in[12]; I.dwg = A->in[14]; I.dwu = A->in[15]; I.dwd = A->in[16]; I.ewg = A->in[18]; I.ewu = A->in[19]; I.ewd = A->in[20]; I.fqg = A->in[5]; I.fkg = A->in[6]; I.mqg = A->in[7]; I.mkg = A->in[8];
        p_prologue(F, I, A->ws); }
    SEAM(0);

    for (int l = 0; l < DEPTH_RUN; ++l) {
        const int pb = 1 + l * PH_PER_LAYER;
        if (PHON(0) && IN(pb + 0)) { LAUNDER_F(); kargs_t A = KARGS(); unsigned char* ws = A->ws;
            Combine C{WSP(const bf16, WS_YD), WSP(const TokRoute, WS_GATEW), (const LAS int*)(F.lds + GTAB_OFF)};
            const bool comb = (l >= 2) && ((l & 1) == 0);
            if (comb) build_tab((LAS int*)(F.lds + GTAB_OFF), (const gu32*)(ws + WS_CTL) + CW_CNT + 64 * ((l - 1) >> 1));
            p_norm(F, l == 0 ? A->in[0] : (const float*)A->out, A->out, A->in[2] + l * D_MODEL, WSP(bf16, WS_HB), A->in[1], A->in[9] + l * D_MODEL, nullptr, nullptr, nullptr, nullptr, comb, C); }
        SEAM(pb + 0);
        if (PHON(1) && IN(pb + 1)) { LAUNDER_F(); kargs_t A = KARGS(); unsigned char* ws = A->ws;
            pg8::Gemm g{WSP(bf16, WS_HB), (const bf16*)(ws + WS_WIN + l * SZ_WIN), D_MODEL, 0};
            pg8::TileOrder S{M_TOK / 256, NIN / 256, F.G, (int)blockIdx.x, M_TOK / 256, NIN / 256, 2, 2};
            pg8::EpiInProj E{ws, A->in[4] + l * 4, WSP(float, WS_GAINS) + l * 256};
            pg8::gemm_phase<pg8::EpiInProj, pg8::TileOrder, true, true, false>(F.lds + RING_OFF, g, S, E);
        }
        SEAM(pb + 1);
        if (PHON(2) && IN(pb + 2)) { LAUNDER_F(); kargs_t A = KARGS(); unsigned char* ws = A->ws; p_cumsum(F, WSP(float, WS_LOGF), WSP(float, WS_CB)); p_ret_kv(F, WSP(bf16, WS_RK), WSP(bf16, WS_RV), WSP(float, WS_KVT)); }
        SEAM(pb + 2);
        if (PHON(3) && IN(pb + 3)) {
#ifndef NO_SCAN
            { LAUNDER_F(); kargs_t A = KARGS(); unsigned char* ws = A->ws; p_ret_scan(F, WSP(float, WS_KVT), WSP(bf16, WS_PREVT)); }
#endif
            for (int uu = F.vcu; uu < 256; uu += F.G) { const int bh = uu >> 5, qb = uu & 31;
#ifndef NO_FOX
                { LAUNDER_F(); kargs_t A = KARGS(); unsigned char* ws = A->ws;
                attn_body::attn_unit<8, true>(bh >> 2, bh & 3, qb, WSP(const attn_body::bf16, WS_FQ), WSP(const attn_body::bf16, WS_FK), WSP(const attn_body::bf16, WS_FV), WSP(attn_body::bf16, WS_Y), 512, A->in[11] + l * D_MODEL + 512, WSP(float, WS_CB) + (size_t)bh * SEQ, (char*)lds + RING_OFF); }
#endif
#ifndef NO_MEMA
                { LAUNDER_F(); kargs_t A = KARGS(); unsigned char* ws = A->ws;
                attn_body::attn_unit<8, false>(bh >> 2, bh & 3, qb, WSP(const attn_body::bf16, WS_MQ), WSP(const attn_body::bf16, WS_MK), WSP(const attn_body::bf16, WS_MV), WSP(attn_body::bf16, WS_Y), 768, A->in[11] + l * D_MODEL + 768, nullptr, (char*)lds + RING_OFF); }
#endif
            }
        }
        SEAM(pb + 3);
        if (PHON(4) && IN(pb + 4)) { LAUNDER_F(); kargs_t A = KARGS(); unsigned char* ws = A->ws;
            p_ret_out(F, WSP(bf16, WS_RQ), WSP(bf16, WS_RK), WSP(bf16, WS_RV), WSP(bf16, WS_RG), WSP(bf16, WS_PREVT), A->in[11] + l * D_MODEL, WSP(bf16, WS_Y)); }
        SEAM(pb + 4);
        if (PHON(5) && IN(pb + 5)) { LAUNDER_F(); kargs_t A = KARGS(); unsigned char* ws = A->ws;
            pg8::Gemm g{WSP(bf16, WS_Y), (const bf16*)(ws + WS_WOUT + l * SZ_WOUT), D_MODEL, 0};
            pg8::TileOrder S{M_TOK / 256, D_MODEL / 256, F.G, (int)blockIdx.x, 0, 0, 0, 0};
            pg8::EpiResid E{l == 0 ? A->in[0] : (const float*)A->out, A->out};
            pg8::gemm_phase<pg8::EpiResid, pg8::TileOrder, true, true, false>(F.lds + RING_OFF, g, S, E);
        }
        SEAM(pb + 5);
        if (PHON(6) && IN(pb + 6)) { LAUNDER_F(); kargs_t A = KARGS(); unsigned char* ws = A->ws; const int j2 = l >> 1; const bool moe = (l & 1) != 0;
            Combine C0{nullptr, nullptr, nullptr};
            p_norm(F, A->out, A->out, A->in[13] + l * D_MODEL, WSP(bf16, WS_HB), nullptr, nullptr, moe ? A->in[17] + (size_t)j2 * D_MODEL * N_EXPERTS : nullptr, (gu32*)(ws + WS_CTL) + CW_CNT + 64 * j2, WSP(int, WS_LIST), WSP(TokRoute, WS_GATEW), false, C0); }
        SEAM(pb + 6);
        if (PHON(7) && IN(pb + 7)) { LAUNDER_F(); kargs_t A = KARGS(); unsigned char* ws = A->ws; const int j2 = l >> 1; const bool moe = (l & 1) != 0;
            pg8::GroupedOrder S; S.init(F.G, (int)blockIdx.x, NGU / 256, (LAS int*)(F.lds + GTAB_OFF), moe ? (const unsigned*)(ws + WS_CTL) + CW_CNT + 64 * j2 : nullptr, WSP(int, WS_LIST));
            pg8::Gemm g{WSP(bf16, WS_HB), moe ? (const bf16*)(ws + WS_EGU + (size_t)j2 * 8 * SZ_WGU) : (const bf16*)(ws + WS_WGU + (size_t)j2 * SZ_WGU), D_MODEL, moe ? SZ_WGU : 0};
            pg8::EpiSwiGLU E{WSP(bf16, WS_HF)};
            pg8::gemm_phase<pg8::EpiSwiGLU, pg8::GroupedOrder, true, true, true>(F.lds + RING_OFF, g, S, E);
        }
        SEAM(pb + 7);
        if (PHON(8) && IN(pb + 8)) { LAUNDER_F(); kargs_t A = KARGS(); unsigned char* ws = A->ws; const int j2 = l >> 1; const bool moe = (l & 1) != 0;
            pg8::GroupedOrder S; S.init(F.G, (int)blockIdx.x, D_MODEL / 256, (LAS int*)(F.lds + GTAB_OFF), moe ? (const unsigned*)(ws + WS_CTL) + CW_CNT + 64 * j2 : nullptr, WSP(int, WS_LIST));
            pg8::Gemm g{WSP(bf16, WS_HF), moe ? (const bf16*)(ws + WS_EDN + (size_t)j2 * 8 * SZ_WDN) : (const bf16*)(ws + WS_WDN + (size_t)j2 * SZ_WDN), FFP, moe ? SZ_WDN : 0};
            pg8::EpiDown E{A->out, WSP(bf16, WS_YD), !moe};
            pg8::gemm_phase<pg8::EpiDown, pg8::GroupedOrder, true, true, false>(F.lds + RING_OFF, g, S, E);
        }
        SEAM(pb + 8);
    }
    if (IN(N_PHASES - 1)) { LAUNDER_F(); kargs_t A = KARGS(); unsigned char* ws = A->ws;
        Combine C{WSP(const bf16, WS_YD), WSP(const TokRoute, WS_GATEW), (const LAS int*)(F.lds + GTAB_OFF)};
        build_tab((LAS int*)(F.lds + GTAB_OFF), (const gu32*)(ws + WS_CTL) + CW_CNT + 64 * ((DEPTH_RUN - 1) >> 1));
        p_norm(F, A->out, A->out, nullptr, nullptr, nullptr, nullptr, nullptr, nullptr, nullptr, nullptr, true, C); }
#undef IN
#undef SEAM
#undef WSP
}

extern "C" void kernel_launch(void* const* d_in, const int* in_sizes, int n_in, void* d_out, int out_size, void* d_ws, size_t ws_size, hipStream_t stream) {
    static int grid = 0;
    if (grid == 0) {
        if (n_in != 21 || in_sizes[0] != M_TOK * D_MODEL || out_size != M_TOK * D_MODEL || ws_size < WS_END) {
            fprintf(stderr, "kernel_launch: built for 21 inputs, x/out of %d floats, >= %zu bytes of workspace; got n_in %d, in0 %d, out %d, ws %zu; nothing launched\n", M_TOK * D_MODEL, (size_t)WS_END, n_in, n_in > 0 ? in_sizes[0] : -1, out_size, ws_size); grid = -1; return; }
        int dev = 0, cus = 0, per_cu = 0;
        if (hipGetDevice(&dev) != hipSuccess || hipDeviceGetAttribute(&cus, hipDeviceAttributeMultiprocessorCount, dev) != hipSuccess) { fprintf(stderr, "kernel_launch: device query failed\n"); grid = -1; return; }
        if (hipFuncSetAttribute((const void*)trunk_fwd, hipFuncAttributeMaxDynamicSharedMemorySize, LDS_BYTES) != hipSuccess) { fprintf(stderr, "kernel_launch: hipFuncSetAttribute failed\n"); grid = -1; return; }
        if (hipOccupancyMaxActiveBlocksPerMultiprocessor(&per_cu, (const void*)trunk_fwd, NWAVES * 64, LDS_BYTES) != hipSuccess || per_cu < 1)
            fprintf(stderr, "kernel_launch: note: occupancy query reports %d workgroups per CU\n", per_cu);
        (void)hipGetLastError();
        grid = cus;
        if (grid > 256) grid = 256;
    }
    if (grid < 0) return;
    if (hipMemsetAsync((char*)d_ws + WS_CTL, 0, CTL_ZERO_BYTES, stream) != hipSuccess) { fprintf(stderr, "kernel_launch: hipMemsetAsync failed\n"); return; }
    Args a{};
    for (int i = 0; i < 21; ++i) a.in[i] = (const float*)d_in[i];
    a.out = (float*)d_out; a.ws = (unsigned char*)d_ws;
#if MK_ONE_LAUNCH
    a.ph_lo = 0; a.ph_hi = N_PHASES;
    hipLaunchKernelGGL(trunk_fwd, dim3(grid), dim3(NWAVES * 64), LDS_BYTES, stream, a);
#else
    for (int p = 0; p < N_PHASES; ++p) { a.ph_lo = p; a.ph_hi = p + 1; hipLaunchKernelGGL(trunk_fwd, dim3(grid), dim3(NWAVES * 64), LDS_BYTES, stream, a); }
#endif
    const hipError_t le = hipPeekAtLastError();
    if (le != hipSuccess) fprintf(stderr, "kernel_launch: launch failed: %s\n", hipGetErrorName(le));
}
```

```cpp
#include <hip/hip_runtime.h>
#include <hip/hip_bf16.h>
#include <cstdio>
#include <cstdint>
#include <cmath>

constexpr int D_MODEL = 1024, BATCH = 2, SEQ = 8192, DEPTH = 4, M_TOK = BATCH * SEQ;
constexpr int MEM_LEN = 256, M_MEM = BATCH * MEM_LEN;
constexpr int D_FF = 2752, FFP = 2816  , NGU = 2 * FFP  ;
constexpr int N_EXPERTS = 8, IN_COLS = 2564, NIN = 2816  , NINKV = NIN + 512  ;
constexpr float EPS = 1e-6f;
constexpr int NWAVES = 8;

constexpr size_t MiB = 1u << 20;
constexpr size_t WS_CTL = 0, CTL_ZERO_BYTES = 1 * MiB;
#ifndef FP8_GU
#define FP8_GU 0
#endif
#ifndef FP8_DN
#define FP8_DN 1
#endif
constexpr int FES_GU = FP8_GU ? 1 : 2, FES_DN = FP8_DN ? 1 : 2;
#ifndef FP8_MOE_GU
#define FP8_MOE_GU 1
#endif
static_assert(FP8_GU == 0, "dense fp8 gate|up: not wired");
constexpr float SW_GU = 64.0f;
constexpr int FES_EGU = FP8_MOE_GU ? 1 : 2;
constexpr float SW_DN = 64.0f;
constexpr float SA_HB = 8.0f, SA_HF = 4.0f;
constexpr size_t SZ_WIN = (size_t)NINKV * D_MODEL * 2, SZ_WOUT = (size_t)D_MODEL * D_MODEL * 2, SZ_WGU = (size_t)NGU * D_MODEL * FES_GU, SZ_WDN = (size_t)D_MODEL * FFP * FES_DN;
constexpr size_t WS_WIN = 1 * MiB;
constexpr size_t WS_WOUT = WS_WIN + 4 * SZ_WIN;
constexpr size_t WS_WGU = WS_WOUT + 4 * SZ_WOUT;
constexpr size_t WS_WDN = WS_WGU + 2 * SZ_WGU;
constexpr size_t WS_EGU = WS_WDN + 2 * SZ_WDN;
constexpr size_t SZ_EGU = (size_t)NGU * D_MODEL * FES_EGU;
constexpr size_t WS_EDN = WS_EGU + 16 * SZ_EGU;
constexpr size_t WS_XB = WS_EDN + 16 * SZ_WDN;
constexpr size_t WS_X8 = WS_XB + (size_t)M_TOK * D_MODEL * 2;
constexpr size_t WS_MEMN = WS_X8 + (size_t)M_TOK * D_MODEL;
constexpr size_t WS_SSA = WS_MEMN + (size_t)4 * M_MEM * D_MODEL * 2;
constexpr size_t WS_SSF = WS_SSA + (size_t)M_TOK * 4 * 4;
constexpr size_t WS_LIST = WS_SSF + (size_t)M_TOK * 4 * 4;
constexpr size_t WS_GATEW = WS_LIST + (size_t)N_EXPERTS * 16384 * 4;
constexpr size_t WS_RSS = WS_GATEW + (size_t)N_EXPERTS * 16384 * 4;
constexpr size_t WS_LOGF = WS_RSS + (size_t)N_EXPERTS * 16384 * 4;
constexpr size_t WS_CB = WS_LOGF + (size_t)8 * SEQ * 4;
constexpr size_t WS_MK = WS_CB + (size_t)8 * SEQ * 4;
constexpr size_t WS_MV = WS_MK + (size_t)M_MEM * 256 * 2;
constexpr size_t WS_INVGU = WS_MV + (size_t)M_MEM * 256 * 2;
constexpr size_t WS_INVDN = WS_INVGU + (size_t)18 * NGU * 4;
constexpr size_t WS_GAINS = WS_INVDN + (size_t)18 * D_MODEL * 4;
constexpr size_t WS_U = WS_GAINS + 4096;
constexpr size_t WS_RQ = WS_U, WS_RK = WS_RQ + (size_t)M_TOK * 256 * 2, WS_RV = WS_RK + (size_t)M_TOK * 256 * 2, WS_RG = WS_RV + (size_t)M_TOK * 512 * 2;
constexpr size_t WS_FQ = WS_RG + (size_t)M_TOK * 512 * 2, WS_FK = WS_FQ + (size_t)M_TOK * 256 * 2, WS_FV = WS_FK + (size_t)M_TOK * 256 * 2, WS_MQ = WS_FV + (size_t)M_TOK * 256 * 2;
constexpr size_t WS_KVT = WS_MQ + (size_t)M_TOK * 256 * 2;
constexpr size_t WS_PREVT = WS_KVT + (size_t)512 * 128 * 64 * 4;
constexpr size_t WS_Y = WS_PREVT + (size_t)512 * 128 * 64 * 2;
constexpr size_t WS_UEND_MIX = WS_Y + (size_t)M_TOK * D_MODEL * 2;
constexpr int HF_ROWS = 2 * M_TOK + N_EXPERTS * 256;
constexpr size_t WS_HF = WS_U;
constexpr size_t WS_UEND_HF = WS_HF + (size_t)HF_ROWS * FFP * FES_DN;
constexpr size_t WS_YD = (WS_UEND_HF > WS_UEND_MIX ? WS_UEND_HF : WS_UEND_MIX);
constexpr size_t WS_END = WS_YD + (size_t)HF_ROWS * D_MODEL * 2;
constexpr int CW_BAR = 4096;
constexpr int CW_CMAX_GU = 16384, CW_CMAX_DN = CW_CMAX_GU + 18 * NGU;
static_assert((size_t)(CW_CMAX_DN + 18 * D_MODEL) * 4 <= CTL_ZERO_BYTES, "CTL words inside the memset region");
constexpr int CW_MEMQ = 12288;
constexpr int CW_CNT = 8192;

namespace pg8 {
#define PG8_LAS __attribute__((address_space(3)))
typedef unsigned short bf16_t;
typedef short bf16x8 __attribute__((ext_vector_type(8)));
typedef float f32x4 __attribute__((ext_vector_type(4)));
typedef unsigned u32x4 __attribute__((ext_vector_type(4)));
typedef short bf16x16 __attribute__((ext_vector_type(16)));
constexpr int BM = 256, BK = 64, HALF = 128, HTB = HALF * BK * 2  , STAGE_BYTES = 8 * HTB, NXCD = 8, WGM = 8;

__host__ __device__ __forceinline__ int lds_byte(int r, int c) { const int st = (r >> 4) * 2 + (c >> 5), rr = r & 15, cc = c & 31, ob = rr * 64 + cc * 2; return st * 1024 + (ob ^ (((ob >> 9) & 1) << 5)); }
__host__ __device__ __forceinline__ void stage_rc(int b, int& R, int& C) { const int st = b / 1024, sb = b % 1024, swz = sb ^ (((sb >> 9) & 1) << 5); R = (st >> 1) * 16 + swz / 64; C = (st & 1) * 32 + (swz % 64) / 2; }
__host__ __device__ __forceinline__ int perm32(int rho) { const int n = rho >> 4, i = rho & 15; return 8 * (i >> 2) + 4 * n + (i & 3); }

struct Unit { int pm, pn, e, lt, cnt; };
struct Gemm { const void* A; const void* Bt; int KB; size_t bstride; const void* A2; int pm2; };
typedef int i32x8 __attribute__((ext_vector_type(8)));

__device__ __forceinline__ unsigned cvt_pk_bf16(float lo, float hi) { unsigned r; asm volatile("v_cvt_pk_bf16_f32 %0, %1, %2" : "=v"(r) : "v"(lo), "v"(hi)); return r; }

__device__ __forceinline__ bool static_tile(int i, int G, int c, int nM, int nN, int& pm, int& pn) {
    const int nwg = nM * nN; const long L = (long)i * G + c; if (L >= nwg) return false;
    int wgid = (int)L; { const int q = nwg / NXCD, r = nwg % NXCD, xcd = wgid % NXCD, off = wgid / NXCD; wgid = (xcd < r ? xcd * (q + 1) : r * (q + 1) + (xcd - r) * q) + off; }
    const int nig = WGM * nN, gid = wgid / nig, fm = gid * WGM, gsz = (nM - fm) < WGM ? (nM - fm) : WGM;
    pm = fm + ((wgid % nig) % gsz); pn = (wgid % nig) / gsz; return true;
}

template <class Epi, class Sched, bool ALIGN_EPI, bool SP2, bool GATHER, bool FP8>
__device__ __forceinline__ unsigned long long gemm_phase(PG8_LAS unsigned char* lds, const Gemm g, const Sched& S, const Epi& E) {
    unsigned long long tepi_ = 0ull;
    int tid_ = threadIdx.x; asm volatile("" : "+v"(tid_));
    const int tid = tid_, wid = __builtin_amdgcn_readfirstlane(tid >> 6), lane = tid & 63, wr = wid >> 2, wc = wid & 3, fr = lane & 15, fq = lane >> 4;
    const int K = g.KB / 2  , nt = g.KB / (BK * 2);
    unsigned voffB[2]; unsigned vA[2][2], vN[2][2]; int RA[2], CA[2];
#pragma unroll
    for (int i = 0; i < 2; ++i) { int R, C; stage_rc(tid * 16 + i * 8192, R, C); const int Rb = Epi::PERM ? ((R & ~31) + perm32(R & 31)) : R;
        RA[i] = R; CA[i] = C; voffB[i] = (unsigned)(Rb * K + C) * 2u;
#pragma unroll
        for (int h = 0; h < 2; ++h) { vA[h][i] = (unsigned)((R + h * HALF) * K + C) * 2u; vN[h][i] = vA[h][i]; } }
    const size_t kstep = (size_t)(BK * 2);
    const size_t hstep = (size_t)HALF * K * 2;
    const size_t tstep = 2 * hstep;
    const unsigned ldsw = (unsigned)wid * 1024u;
    const int aoff = lds_byte(wr * 64 + fr, fq * 8), boff = lds_byte(wc * 32 + fr, fq * 8);
#define PG8_SA(b, h) (((b) * 2 + (h)) * HTB)
#define PG8_SB(b, h) ((4 + (b) * 2 + (h)) * HTB)
#define PG8_STAGE(bufoff, gbase, voff) do { _Pragma("unroll") for (int _i = 0; _i < 2; ++_i) \
        __builtin_amdgcn_global_load_lds((const unsigned*)((const char*)(gbase) + (voff)[_i]), (PG8_LAS unsigned*)(lds + (bufoff) + ldsw + _i * 8192), 16, 0, 0); } while (0)
#define PG8_STAGEA(b, h, kptr, vv) PG8_STAGE(PG8_SA(b, h), (GATHER ? (kptr) : (kptr) + (h) * hstep), (vv)[GATHER ? (h) : 0])
#define PG8_LDA(dst, b, h) do { _Pragma("unroll") for (int m = 0; m < 4; ++m) _Pragma("unroll") for (int k = 0; k < 2; ++k) dst[m][k] = *(const PG8_LAS bf16x8*)(lds + PG8_SA(b, h) + aoff + m * 2048 + k * 1024); } while (0)
#define PG8_LDB(dst, b, h) do { _Pragma("unroll") for (int n = 0; n < 2; ++n) _Pragma("unroll") for (int k = 0; k < 2; ++k) dst[n][k] = *(const PG8_LAS bf16x8*)(lds + PG8_SB(b, h) + boff + n * 2048 + k * 1024); } while (0)
#define PG8_CAT(x) __builtin_bit_cast(i32x8, (bf16x16){x[0][0], x[0][1], x[0][2], x[0][3], x[0][4], x[0][5], x[0][6], x[0][7], x[1][0], x[1][1], x[1][2], x[1][3], x[1][4], x[1][5], x[1][6], x[1][7]})
#define PG8_MMA(ai, bj, At, Bt) do { __builtin_amdgcn_s_setprio(1); _Pragma("unroll") for (int m = 0; m < 4; ++m) _Pragma("unroll") for (int n = 0; n < 2; ++n) { \
        if constexpr (FP8) { const i32x8 a8_ = PG8_CAT(Bt[n]), b8_ = PG8_CAT(At[m]);   \
            asm volatile("v_mfma_scale_f32_16x16x128_f8f6f4 %0, %1, %2, %0, %3, %3 op_sel_hi:[0,0,0]" : "+v"(acc[ai][bj][m][n]) : "v"(a8_), "v"(b8_), "v"(sc1_)); } \
        else { _Pragma("unroll") for (int k = 0; k < 2; ++k) acc[ai][bj][m][n] = __builtin_amdgcn_mfma_f32_16x16x32_bf16(Bt[n][k], At[m][k], acc[ai][bj][m][n], 0, 0, 0); } } \
        __builtin_amdgcn_s_setprio(0); } while (0)
#define PG8_WAIT_V(n) asm volatile("s_waitcnt vmcnt(" #n ")" ::: "memory")
#define PG8_WAIT_L(n) asm volatile("s_waitcnt lgkmcnt(" #n ")" ::: "memory")
#define PG8_BAR __builtin_amdgcn_s_barrier()
#define PG8_SCHED __builtin_amdgcn_sched_barrier(0)
    Unit cur, nxt; int ui = 0;
    if (!S.next(0, cur)) return 0ull;
    typename Epi::Pre pre;
    f32x4 acc[2][2][4][2];
#pragma unroll
    for (int a = 0; a < 2; ++a)
#pragma unroll
        for (int b = 0; b < 2; ++b)
#pragma unroll
            for (int m = 0; m < 4; ++m)
#pragma unroll
                for (int n = 0; n < 2; ++n) acc[a][b][m][n] = (f32x4){0.f, 0.f, 0.f, 0.f};
    bf16x8 At[4][2], B0[2][2], B1[2][2];
    int sc1_ = 0x7F7F7F7F; asm volatile("" : "+v"(sc1_));
#define PG8_ATILE(pm_) (GATHER ? (const char*)g.A : ((pm_) >= g.pm2 ? (const char*)g.A2 + (size_t)((pm_) - g.pm2) * tstep : (const char*)g.A + (size_t)(pm_) * tstep))
    const char* cA = PG8_ATILE(cur.pm); const char* cB = (const char*)g.Bt + (size_t)cur.e * g.bstride + (size_t)cur.pn * tstep;
    if constexpr (GATHER) {
#pragma unroll
        for (int i = 0; i < 2; ++i)
#pragma unroll
            for (int h = 0; h < 2; ++h) { vA[h][i] = (unsigned)(S.row_token(cur, RA[i] + h * HALF) * K + CA[i]) * 2u; vN[h][i] = vA[h][i]; }
    }
    {
        PG8_STAGE(PG8_SB(0, 0), cB, voffB); PG8_STAGE(PG8_SB(0, 1), cB + hstep, voffB); PG8_STAGEA(0, 0, cA, vA); PG8_STAGEA(0, 1, cA, vA);
        if (wr == 1) PG8_BAR;
        PG8_WAIT_V(2); PG8_BAR;
        PG8_STAGE(PG8_SB(1, 0), cB + kstep, voffB); PG8_STAGEA(1, 0, cA + kstep, vA); PG8_STAGE(PG8_SB(1, 1), cB + hstep + kstep, voffB);
        PG8_WAIT_V(6); PG8_BAR;
    }
    for (;;) {
        const bool has_next = S.next(ui + 1, nxt);
        const char* nA = has_next ? PG8_ATILE(nxt.pm) : cA;
        const char* nB = has_next ? (const char*)g.Bt + (size_t)nxt.e * g.bstride + (size_t)nxt.pn * tstep : cB;
        if constexpr (GATHER) {
            if (has_next) {
#pragma unroll
                for (int i = 0; i < 2; ++i)
#pragma unroll
                    for (int h = 0; h < 2; ++h) vN[h][i] = (unsigned)(S.row_token(nxt, RA[i] + h * HALF) * K + CA[i]) * 2u;
            }
        }
#pragma nounroll
        for (int t = 0; t < nt; t += 2) {
            const bool last = (t == nt - 2);
            if (last) pre = E.prefetch(cur, wr, wc, fr, fq);
            const char* a1 = cA + (size_t)(t + 1) * kstep;
            const char* a2 = last ? nA : cA + (size_t)(t + 2) * kstep; const char* b2 = last ? nB : cB + (size_t)(t + 2) * kstep;
            const char* a3 = a2 + kstep; const char* b3 = b2 + kstep;
            unsigned vS[2][2];
#pragma unroll
            for (int i = 0; i < 2; ++i)
#pragma unroll
                for (int h = 0; h < 2; ++h) vS[h][i] = (GATHER && last) ? vN[h][i] : vA[h][i];
            PG8_LDB(B0, 0, 0); PG8_LDB(B1, 0, 1); PG8_SCHED; PG8_LDA(At, 0, 0); PG8_STAGEA(1, 1, a1, vA);
            PG8_WAIT_V(8); PG8_WAIT_L(0); PG8_BAR; PG8_MMA(0, 0, At, B0); PG8_MMA(0, 1, At, B1); PG8_BAR; PG8_SCHED;
            PG8_LDA(At, 0, 1); PG8_STAGE(PG8_SB(0, 0), b2, voffB); PG8_STAGE(PG8_SB(0, 1), b2 + hstep, voffB); PG8_STAGEA(0, 0, a2, vS);
            PG8_WAIT_V(8); PG8_WAIT_L(0); PG8_BAR; PG8_MMA(1, 0, At, B0); PG8_MMA(1, 1, At, B1); PG8_BAR; PG8_SCHED;
            PG8_LDB(B0, 1, 0); PG8_LDB(B1, 1, 1); PG8_SCHED; PG8_LDA(At, 1, 0); PG8_STAGEA(0, 1, a2, vS);
            PG8_WAIT_V(8); PG8_WAIT_L(0); PG8_BAR; PG8_MMA(0, 0, At, B0); PG8_MMA(0, 1, At, B1); PG8_BAR; PG8_SCHED;
            PG8_LDA(At, 1, 1); PG8_STAGE(PG8_SB(1, 0), b3, voffB); PG8_STAGE(PG8_SB(1, 1), b3 + hstep, voffB); PG8_STAGEA(1, 0, a3, vS);
            PG8_WAIT_V(8); PG8_WAIT_L(0); PG8_BAR; PG8_MMA(1, 0, At, B0); PG8_MMA(1, 1, At, B1); PG8_BAR; PG8_SCHED;
        }
        if constexpr (ALIGN_EPI) { if (wr == 0) PG8_BAR; }
        if constexpr (FP8) asm volatile("s_nop 15\n\ts_nop 7" ::: "memory");
#ifdef PROBE_EPI
        const unsigned long long te0_ = __builtin_amdgcn_s_memrealtime();
#endif
        E(acc, cur, wr, wc, fr, fq, pre);
#ifdef PROBE_EPI
        tepi_ += __builtin_amdgcn_s_memrealtime() - te0_;
#endif
        if (!has_next) break;
#pragma unroll
        for (int a = 0; a < 2; ++a)
#pragma unroll
            for (int b = 0; b < 2; ++b)
#pragma unroll
                for (int m = 0; m < 4; ++m)
#pragma unroll
                    for (int n = 0; n < 2; ++n) acc[a][b][m][n] = (f32x4){0.f, 0.f, 0.f, 0.f};
        cur = nxt; cA = nA; cB = nB; ++ui;
#pragma unroll
        for (int i = 0; i < 2; ++i)
#pragma unroll
            for (int h = 0; h < 2; ++h) vA[h][i] = vN[h][i];
        if constexpr (ALIGN_EPI) { if (wr == 1) PG8_BAR; }
    }
    PG8_WAIT_V(0);
    if constexpr (!ALIGN_EPI) { if (wr == 0) PG8_BAR; }
    PG8_BAR;
    return tepi_;
#undef PG8_SA
#undef PG8_SB
#undef PG8_STAGE
#undef PG8_STAGEA
#undef PG8_LDA
#undef PG8_LDB
#undef PG8_MMA
#undef PG8_ATILE
#undef PG8_CAT
#undef PG8_WAIT_V
#undef PG8_WAIT_L
#undef PG8_BAR
#undef PG8_SCHED
}
}
namespace pg8 {
constexpr int LIST_CAP = 16384;

struct TileOrder {
    int nM, nN, G, c, xM0, xN0, xM, xN;
    __device__ __forceinline__ bool next(int i, Unit& u) const {
        int pm, pn; u.e = 0; u.lt = 0; u.cnt = 0;
        if (static_tile(i, G, c, nM, nN, pm, pn)) { u.pm = pm; u.pn = pn; return true; }
        const long L = (long)i * G + c - (long)nM * nN;
        if (L < (long)xM * xN) { u.pm = xM0 + (int)(L % xM); u.pn = xN0 + (int)(L / xM); return true; }
        return false;
    }
    __device__ __forceinline__ int row_token(const Unit& u, int r) const { return u.pm * BM + r; }    __device__ __forceinline__ int row_token_raw(const Unit& u, int r) const { return u.pm * BM + r; }
    __device__ __forceinline__ int row_token_fix(const Unit&, int, int raw) const { return raw; }
};

struct GroupedOrder {
    int G, c, nN, ntiles; const PG8_LAS int* tab; const int* list; bool dense;
    __device__ __forceinline__ void init(int G_, int c_, int nN_, PG8_LAS int* tab_, const unsigned* counts, const int* list_) { G = G_; c = c_; nN = nN_; tab = tab_; list = list_; dense = (counts == nullptr);
        __syncthreads();
        if (threadIdx.x == 0) { int t = 0;
            for (int e = 0; e < N_EXPERTS; ++e) { int n = dense ? (e == 0 ? M_TOK : 0) : (int)__hip_atomic_load(counts + e, __ATOMIC_RELAXED, __HIP_MEMORY_SCOPE_AGENT); n = n > LIST_CAP ? LIST_CAP : n; tab_[16 + e] = n; tab_[e] = t; t += (n + BM - 1) / BM; }
            tab_[N_EXPERTS] = t; }
        __syncthreads();
        ntiles = __builtin_amdgcn_readfirstlane(tab_[N_EXPERTS]); }
    __device__ __forceinline__ bool next(int i, Unit& u) const {
        int pm, pn; if (!static_tile(i, G, c, ntiles, nN, pm, pn)) return false;
        int e = 0;
#pragma unroll
        for (int j = 1; j < N_EXPERTS; ++j) e += (pm >= tab[j]) ? 1 : 0;
        e = __builtin_amdgcn_readfirstlane(e);
        u.pm = pm; u.pn = pn; u.e = e; u.lt = pm - __builtin_amdgcn_readfirstlane(tab[e]); u.cnt = __builtin_amdgcn_readfirstlane(tab[16 + e]); return true;
    }
    __device__ __forceinline__ int row_token(const Unit& u, int r) const { const int pos = u.lt * BM + r; if (dense) return pos; return pos < u.cnt ? list[u.e * LIST_CAP + pos] : 0; }    __device__ __forceinline__ int row_token_raw(const Unit& u, int r) const { const int pos = u.lt * BM + r; if (dense) return pos; return list[u.e * LIST_CAP + (pos < u.cnt ? pos : 0)]; }
    __device__ __forceinline__ int row_token_fix(const Unit& u, int r, int raw) const { const int pos = u.lt * BM + r; return (dense || pos < u.cnt) ? raw : 0; }
};

__device__ __forceinline__ float silu_f(float x) { return x * __builtin_amdgcn_rcpf(1.0f + __builtin_amdgcn_exp2f(x * -1.4426950408889634f)); }
__device__ __forceinline__ float logsigmoid_f(float z) { const float a = fabsf(z); return fminf(z, 0.f) - 0.6931471805599453f * __builtin_amdgcn_logf(1.0f + __builtin_amdgcn_exp2f(a * -1.4426950408889634f)); }

struct EpiInProj {
    static constexpr bool PERM = true;
    unsigned char* ws; const float* fbias; const float* gains; const float* SSA;
    struct Pre {};
    __device__ __forceinline__ Pre prefetch(const Unit&, int, int, int, int) const { return Pre{}; }
    __device__ __forceinline__ void operator()(const f32x4 (&acc)[2][2][4][2], const Unit& u, int wr, int wc, int fr, int fq, const Pre&) const {
        const int pn = u.pn; const int row0 = u.pm * BM + wr * 64 + fr;
        float rs[2][4];
#pragma unroll
        for (int ai = 0; ai < 2; ++ai)
#pragma unroll
            for (int m = 0; m < 4; ++m) { rs[ai][m] = 1.0f; if (u.pm < M_TOK / BM) { const f32x4 p = *(const f32x4*)(SSA + (size_t)(row0 + ai * HALF + m * 16) * 4); rs[ai][m] = __builtin_amdgcn_rsqf(((p[0] + p[1]) + (p[2] + p[3])) * (1.0f / D_MODEL) + EPS); } }
        if (pn <= 1) {
            bf16_t* dst = (bf16_t*)(ws + (pn == 0 ? WS_RQ : WS_RK)); const float sc = pn == 0 ? 0.125f : 1.0f;
            float invf[2][4];
#pragma unroll
            for (int n = 0; n < 2; ++n)
#pragma unroll
                for (int j = 0; j < 4; ++j) invf[n][j] = exp2f(-(float)(8 * fq + 4 * n + j) * (13.287712379549449f / 32.0f)) * 0.15915494309189535f;
#pragma unroll
            for (int ai = 0; ai < 2; ++ai)
#pragma unroll
                for (int m = 0; m < 4; ++m) { const int row = row0 + ai * HALF + m * 16; const float pos = (float)(row & (SEQ - 1));
                    float y1[8], y2[8];
#pragma unroll
                    for (int n = 0; n < 2; ++n)
#pragma unroll
                        for (int j = 0; j < 4; ++j) { const float pr = pos * invf[n][j]; const float rf = __builtin_amdgcn_fractf(pr) + __builtin_fmaf(pos, invf[n][j], -pr);
                            const float cs = __builtin_amdgcn_cosf(rf), sn = __builtin_amdgcn_sinf(rf); const float x1 = acc[ai][0][m][n][j] * rs[ai][m], x2 = acc[ai][1][m][n][j] * rs[ai][m];
                            y1[n * 4 + j] = (x1 * cs - x2 * sn) * sc; y2[n * 4 + j] = (x2 * cs + x1 * sn) * sc; }
                    bf16_t* rowp = dst + (size_t)row * 256 + 64 * wc + 8 * fq;
                    u32x4 w; w.x = cvt_pk_bf16(y1[0], y1[1]); w.y = cvt_pk_bf16(y1[2], y1[3]); w.z = cvt_pk_bf16(y1[4], y1[5]); w.w = cvt_pk_bf16(y1[6], y1[7]); *(u32x4*)rowp = w;
                    w.x = cvt_pk_bf16(y2[0], y2[1]); w.y = cvt_pk_bf16(y2[2], y2[3]); w.z = cvt_pk_bf16(y2[4], y2[5]); w.w = cvt_pk_bf16(y2[6], y2[7]); *(u32x4*)(rowp + 32) = w; }
        } else if (pn == 6 || pn == 7 || pn == 9 || pn == 11) {
            const size_t doff = pn == 6 ? WS_FQ : pn == 7 ? WS_FK : pn == 9 ? WS_MQ : WS_MK; const int gi = pn == 6 ? 0 : pn == 7 ? 1 : pn == 9 ? 2 : 3;
            bf16_t* dst = (bf16_t*)(ws + doff); const float* gp = gains + gi * 64;
            const float sc = (pn == 6 || pn == 9) ? (0.125f * 1.4426950408889634f) : 1.0f; const int rsub = pn == 11 ? M_TOK : 0;
            f32x4 gv[2][2];
#pragma unroll
            for (int bj = 0; bj < 2; ++bj)
#pragma unroll
                for (int n = 0; n < 2; ++n) gv[bj][n] = *(const f32x4*)(gp + 32 * bj + 8 * fq + 4 * n) * sc;
#pragma unroll
            for (int ai = 0; ai < 2; ++ai)
#pragma unroll
                for (int m = 0; m < 4; ++m) { const int row = row0 + ai * HALF + m * 16 - rsub; float ss = 0.f;
#pragma unroll
                    for (int bj = 0; bj < 2; ++bj)
#pragma unroll
                        for (int n = 0; n < 2; ++n) { const f32x4 x = acc[ai][bj][m][n] * rs[ai][m]; ss += (x[0] * x[0] + x[1] * x[1]) + (x[2] * x[2] + x[3] * x[3]); }
                    ss += __shfl_xor(ss, 16); ss += __shfl_xor(ss, 32);
                    const float rstd = rs[ai][m] * __builtin_amdgcn_rsqf(ss * (1.0f / 64.0f) + EPS);
                    bf16_t* rowp = dst + (size_t)row * 256 + 64 * wc + 8 * fq;
#pragma unroll
                    for (int bj = 0; bj < 2; ++bj) { const f32x4 v0 = acc[ai][bj][m][0] * rstd * gv[bj][0], v1 = acc[ai][bj][m][1] * rstd * gv[bj][1];
                        u32x4 w; w.x = cvt_pk_bf16(v0[0], v0[1]); w.y = cvt_pk_bf16(v0[2], v0[3]); w.z = cvt_pk_bf16(v1[0], v1[1]); w.w = cvt_pk_bf16(v1[2], v1[3]); *(u32x4*)(rowp + 32 * bj) = w; } }
        } else if (pn == 10) {
            if (wc == 0 && fq == 0) {
                const f32x4 bv = *(const f32x4*)fbias; float* LOGF = (float*)(ws + WS_LOGF);
#pragma unroll
                for (int ai = 0; ai < 2; ++ai)
#pragma unroll
                    for (int m = 0; m < 4; ++m) { const int row = row0 + ai * HALF + m * 16; const int b = row >> 13, t = row & (SEQ - 1);
#pragma unroll
                        for (int j = 0; j < 4; ++j) LOGF[(size_t)(b * 4 + j) * SEQ + t] = logsigmoid_f(acc[ai][0][m][0][j] * rs[ai][m] + bv[j]); }
            }
        } else {
            size_t doff; int ldc, ct, rsub = 0; bool act = false;
            if (pn <= 3) { doff = WS_RV; ldc = 512; ct = pn - 2; } else if (pn <= 5) { doff = WS_RG; ldc = 512; ct = pn - 4; act = true; } else if (pn == 8) { doff = WS_FV; ldc = 256; ct = 0; } else { doff = WS_MV; ldc = 256; ct = 0; rsub = M_TOK; }
            bf16_t* dst = (bf16_t*)(ws + doff);
#pragma unroll
            for (int ai = 0; ai < 2; ++ai)
#pragma unroll
                for (int m = 0; m < 4; ++m) { const int row = row0 + ai * HALF + m * 16 - rsub; bf16_t* rowp = dst + (size_t)row * ldc + ct * 256 + 32 * wc + 8 * fq;
#pragma unroll
                    for (int bj = 0; bj < 2; ++bj) { f32x4 v0 = acc[ai][bj][m][0] * rs[ai][m], v1 = acc[ai][bj][m][1] * rs[ai][m];
                        if (act) {
#pragma unroll
                            for (int j = 0; j < 4; ++j) { v0[j] = silu_f(v0[j]); v1[j] = silu_f(v1[j]); } }
                        u32x4 w; w.x = cvt_pk_bf16(v0[0], v0[1]); w.y = cvt_pk_bf16(v0[2], v0[3]); w.z = cvt_pk_bf16(v1[0], v1[1]); w.w = cvt_pk_bf16(v1[2], v1[3]); *(u32x4*)(rowp + bj * HALF) = w; } }
        }
    }
};

__device__ __forceinline__ float bf_lo(unsigned w) { return __uint_as_float(w << 16); }
__device__ __forceinline__ float bf_hi(unsigned w) { return __uint_as_float(w & 0xffff0000u); }
__device__ __forceinline__ unsigned pk4_fp8(float a, float b, float c, float d) {
    a = __builtin_amdgcn_fmed3f(a, -448.f, 448.f); b = __builtin_amdgcn_fmed3f(b, -448.f, 448.f); c = __builtin_amdgcn_fmed3f(c, -448.f, 448.f); d = __builtin_amdgcn_fmed3f(d, -448.f, 448.f);
    int p = __builtin_amdgcn_cvt_pk_fp8_f32(a, b, 0, false); p = __builtin_amdgcn_cvt_pk_fp8_f32(c, d, p, true); return (unsigned)p; }

struct EpiDown {
    static constexpr bool PERM = true;
    bf16_t* XB; float* SS; bf16_t* YD; unsigned xl_off; bool moe; float dsc;
    struct Pre {};
    __device__ __forceinline__ Pre prefetch(const Unit&, int, int, int, int) const { return Pre{}; }
    __device__ __forceinline__ void operator()(const f32x4 (&acc)[2][2][4][2], const Unit& u, int wr, int wc, int fr, int fq, const Pre&) const {
        const int row0 = u.pm * BM + wr * 64 + fr, col0 = u.pn * BM + wc * 32 + 8 * fq;
        if (moe) {
#pragma unroll
            for (int ai = 0; ai < 2; ++ai)
#pragma unroll
                for (int m = 0; m < 4; ++m) { bf16_t* rowp = YD + (size_t)(row0 + ai * HALF + m * 16) * D_MODEL + col0;
#pragma unroll
                    for (int bj = 0; bj < 2; ++bj) { const f32x4 v0 = acc[ai][bj][m][0] * dsc, v1 = acc[ai][bj][m][1] * dsc;
                        u32x4 w; w.x = cvt_pk_bf16(v0[0], v0[1]); w.y = cvt_pk_bf16(v0[2], v0[3]); w.z = cvt_pk_bf16(v1[0], v1[1]); w.w = cvt_pk_bf16(v1[2], v1[3]); *(u32x4*)(rowp + bj * HALF) = w; } }
        } else {
#pragma unroll
        for (int ai = 0; ai < 2; ++ai)
#pragma unroll
            for (int m = 0; m < 4; ++m) { bf16_t* rowp = XB + (size_t)(row0 + ai * HALF + m * 16) * D_MODEL + col0; float ss = 0.f;
#pragma unroll
                for (int bj = 0; bj < 2; ++bj) { const u32x4 xb = *(const u32x4*)(rowp + bj * HALF); f32x4 v0 = acc[ai][bj][m][0] * dsc, v1 = acc[ai][bj][m][1] * dsc;
                    v0[0] += bf_lo(xb.x); v0[1] += bf_hi(xb.x); v0[2] += bf_lo(xb.y); v0[3] += bf_hi(xb.y); v1[0] += bf_lo(xb.z); v1[1] += bf_hi(xb.z); v1[2] += bf_lo(xb.w); v1[3] += bf_hi(xb.w);
                    ss += ((v0[0] * v0[0] + v0[1] * v0[1]) + (v0[2] * v0[2] + v0[3] * v0[3])) + ((v1[0] * v1[0] + v1[1] * v1[1]) + (v1[2] * v1[2] + v1[3] * v1[3]));
                    u32x4 w; w.x = cvt_pk_bf16(v0[0], v0[1]); w.y = cvt_pk_bf16(v0[2], v0[3]); w.z = cvt_pk_bf16(v1[0], v1[1]); w.w = cvt_pk_bf16(v1[2], v1[3]); *(u32x4*)(rowp + bj * HALF) = w; }
                ss += __shfl_xor(ss, 16); ss += __shfl_xor(ss, 32);
                if (fq == 0) ((PG8_LAS float*)(size_t)xl_off)[(ai * HALF + wr * 64 + m * 16 + fr) * 4 + wc] = ss;
                if (m & 1) asm volatile("" ::: "memory"); }
#ifndef T_NOEXCH
        asm volatile("s_waitcnt lgkmcnt(0)" ::: "memory"); __builtin_amdgcn_s_barrier(); asm volatile("" ::: "memory");
        { const int t = threadIdx.x; if (t < BM) { const f32x4 p = *(const PG8_LAS f32x4*)((PG8_LAS float*)(size_t)xl_off + t * 4); SS[(size_t)(u.pm * BM + t) * 4 + u.pn] = (p[0] + p[1]) + (p[2] + p[3]); } }
        asm volatile("s_waitcnt lgkmcnt(0)" ::: "memory"); __builtin_amdgcn_s_barrier(); asm volatile("" ::: "memory");
#endif
        }
    }
};

template <bool A8> struct EpiSwiGLU {
    static constexpr bool PERM = true;
    unsigned char* HF; const float* SSF; const float* RSS; bool dense;
    struct Pre {};
    __device__ __forceinline__ Pre prefetch(const Unit&, int, int, int, int) const { return Pre{}; }
    __device__ __forceinline__ void operator()(const f32x4 (&acc)[2][2][4][2], const Unit& u, int wr, int wc, int fr, int fq, const Pre&) const {
        const int row0 = u.pm * BM + wr * 64 + fr, col0 = u.pn * HALF + wc * 32 + 8 * fq;
        float rs[2][4];
        if constexpr (A8) {
#pragma unroll
            for (int ai = 0; ai < 2; ++ai)
#pragma unroll
                for (int m = 0; m < 4; ++m) rs[ai][m] = 1.0f / (SA_HB * SW_GU);
        } else if (dense) {
#pragma unroll
            for (int ai = 0; ai < 2; ++ai)
#pragma unroll
                for (int m = 0; m < 4; ++m) { const f32x4 p = *(const f32x4*)(SSF + (size_t)(row0 + ai * HALF + m * 16) * 4); rs[ai][m] = __builtin_amdgcn_rsqf(((p[0] + p[1]) + (p[2] + p[3])) * (1.0f / D_MODEL) + EPS); }
        } else {
#pragma unroll
            for (int ai = 0; ai < 2; ++ai)
#pragma unroll
                for (int m = 0; m < 4; ++m) { const int pos = u.lt * BM + ai * HALF + wr * 64 + m * 16 + fr; rs[ai][m] = RSS[u.e * LIST_CAP + (pos < u.cnt ? pos : 0)]; }
        }
#pragma unroll
        for (int ai = 0; ai < 2; ++ai)
#pragma unroll
            for (int m = 0; m < 4; ++m) { const float r = rs[ai][m]; float h[8];
#pragma unroll
                for (int n = 0; n < 2; ++n)
#pragma unroll
                    for (int j = 0; j < 4; ++j) h[n * 4 + j] = silu_f(acc[ai][0][m][n][j] * r) * (acc[ai][1][m][n][j] * r) * (FP8_DN ? SA_HF : 1.0f);
                const size_t ro = (size_t)(row0 + ai * HALF + m * 16) * FFP + col0;
                if constexpr (FP8_DN) { typedef unsigned u32x2 __attribute__((ext_vector_type(2))); u32x2 w; w.x = pk4_fp8(h[0], h[1], h[2], h[3]); w.y = pk4_fp8(h[4], h[5], h[6], h[7]); *(u32x2*)(HF + ro) = w; }
                else { u32x4 w; w.x = cvt_pk_bf16(h[0], h[1]); w.y = cvt_pk_bf16(h[2], h[3]); w.z = cvt_pk_bf16(h[4], h[5]); w.w = cvt_pk_bf16(h[6], h[7]); *(u32x4*)((bf16_t*)HF + ro) = w; } }
    }
};
}
namespace attn_body {
#ifdef T_NOMASK
constexpr bool defined_nomask=true;
#else
constexpr bool defined_nomask=false;
#endif
#ifdef T_NOBIAS
constexpr bool defined_nobias=true;
#else
constexpr bool defined_nobias=false;
#endif
using bf16=__hip_bfloat16;
using bf16x8=__attribute__((ext_vector_type(8)))short;
using s16x4=__attribute__((ext_vector_type(4)))short;
using f32x16=__attribute__((ext_vector_type(16)))float;
using u32x4=__attribute__((ext_vector_type(4)))unsigned;
using f32x4v=__attribute__((ext_vector_type(4)))float;
constexpr int BATCH=2,NHEAD=4,SEQ=8192,D=64,DM=NHEAD*D,KVMEM=256,YP=1024;
constexpr int NW=8,QBLK=32,QB=QBLK*NW,KVBLK=64,NQB=SEQ/QB;
constexpr int ATTN_PITCH=DM, ATTN_UNIT_ROWS=QB;
__device__ __forceinline__ int crow(int r,int hi){return (r&3)+8*(r>>2)+4*hi;}
__device__ __forceinline__ unsigned f2bf_a(float f){ unsigned u=__builtin_bit_cast(unsigned,f); return (u+0x7fffu+((u>>16)&1u))>>16; }
#define SBAR() __builtin_amdgcn_sched_barrier(0)
__device__ __forceinline__ void cmask(f32x16&p0,f32x16&p1,int jb,int qrel,int hi){
  int dd=qrel-(64*jb+4*hi); asm volatile("":"+v"(dd));
  #pragma unroll
  for(int r=0;r<16;++r){const int c=(r&3)+8*(r>>2);
    const unsigned t0=(((unsigned)(dd-c))&0x80000000u)|0x7F800000u, t1=(((unsigned)(dd-c-32))&0x80000000u)|0x7F800000u;
    p0[r]=__builtin_fminf(p0[r],__uint_as_float(t0)); p1[r]=__builtin_fminf(p1[r],__uint_as_float(t1));}
}

constexpr int NSLOT=3, SLOTB=8192;
constexpr int LDS_K=0, LDS_V=NSLOT*SLOTB, LDS_WS=2*NSLOT*SLOTB, LDS_OST=LDS_WS+NW*64*4, LDS_CB=LDS_OST+NW*4096, LDS_CBZ=LDS_CB+SEQ*8, LDS_BYTES=LDS_CBZ+16;
constexpr float C2=0.125f*1.4426950408889634f;
__device__ __forceinline__ void glds16(const void*gsrc,unsigned lds_dst){unsigned keep;
  asm volatile("s_mov_b32 %0, m0\n\ts_mov_b32 m0, %2\n\ts_nop 0\n\tglobal_load_lds_dwordx4 %1, off\n\ts_mov_b32 m0, %0":"=&s"(keep):"v"(gsrc),"s"(lds_dst):"memory");}
__device__ __forceinline__ float max3f(float a,float b,float c){float r;asm("v_max3_f32 %0, %1, %2, %3":"=v"(r):"v"(a),"v"(b),"v"(c));return r;}
__device__ __forceinline__ float max2f(float a,float b){float r;asm("v_max_f32_e32 %0, %1, %2":"=v"(r):"v"(a),"v"(b));return r;}
__device__ __forceinline__ float fadd_s(float a,float b){float r;asm("v_add_f32_e32 %0, %1, %2":"=v"(r):"v"(a),"v"(b));return r;}
__device__ __forceinline__ float fsub_s(float a,float b){float r;asm("v_sub_f32_e32 %0, %1, %2":"=v"(r):"v"(a),"v"(b));return r;}
typedef float f32x2_t __attribute__((ext_vector_type(2))); typedef __bf16 bf16x2_t __attribute__((ext_vector_type(2)));
__device__ __forceinline__ unsigned cvtpk_s(float lo,float hi){f32x2_t v={lo,hi};bf16x2_t b=__builtin_convertvector(v,bf16x2_t);return __builtin_bit_cast(unsigned,b);}
#define WAIT_BAR(N) asm volatile("s_waitcnt vmcnt(" #N ") lgkmcnt(0)\n\ts_barrier":::"memory")

__device__ __forceinline__ void qkt(f32x16&p0,f32x16&p1,const char*Kslot,const bf16x8*qr,const f32x16&c0,const f32x16&c1,int r32,int hi){
  const char*kb=Kslot+hi*1024+r32*16;
  #pragma unroll
  for(int d0=0;d0<4;++d0){
    const bf16x8 b0=*reinterpret_cast<const bf16x8*>(kb+d0*2048);
    const bf16x8 b1=*reinterpret_cast<const bf16x8*>(kb+d0*2048+512);
    if(d0==0){p0=__builtin_amdgcn_mfma_f32_32x32x16_bf16(b0,qr[0],c0,0,0,0);p1=__builtin_amdgcn_mfma_f32_32x32x16_bf16(b1,qr[0],c1,0,0,0);}
    else{p0=__builtin_amdgcn_mfma_f32_32x32x16_bf16(b0,qr[d0],p0,0,0,0);p1=__builtin_amdgcn_mfma_f32_32x32x16_bf16(b1,qr[d0],p1,0,0,0);}}
}
typedef __attribute__((address_space(3))) const char* lds_cptr;
typedef short v4i16_t __attribute__((ext_vector_type(4)));
__device__ __forceinline__ void kload8(bf16x8*kf,lds_cptr kp){
  kf[0]=*(const __attribute__((address_space(3))) bf16x8*)(kp);      kf[1]=*(const __attribute__((address_space(3))) bf16x8*)(kp+512);
  kf[2]=*(const __attribute__((address_space(3))) bf16x8*)(kp+2048); kf[3]=*(const __attribute__((address_space(3))) bf16x8*)(kp+2560);
  kf[4]=*(const __attribute__((address_space(3))) bf16x8*)(kp+4096); kf[5]=*(const __attribute__((address_space(3))) bf16x8*)(kp+4608);
  kf[6]=*(const __attribute__((address_space(3))) bf16x8*)(kp+6144); kf[7]=*(const __attribute__((address_space(3))) bf16x8*)(kp+6656);
}
__device__ __forceinline__ void kload2(bf16x8*kf,lds_cptr kp,int j){ kf[2*j]=*(const __attribute__((address_space(3))) bf16x8*)(kp+j*2048); kf[2*j+1]=*(const __attribute__((address_space(3))) bf16x8*)(kp+j*2048+512); }
__device__ __forceinline__ s16x4 vtr(lds_cptr p){ return __builtin_bit_cast(s16x4,__builtin_amdgcn_ds_read_tr16_b64_v4i16((__attribute__((address_space(3))) v4i16_t*)p)); }
__device__ __forceinline__ float rowmax(const f32x16&p0,const f32x16&p1){
  float a=max3f(p0[0],p0[1],p1[0]),b=max3f(p0[2],p0[3],p1[1]);a=max3f(a,p1[2],p1[3]);
  #pragma unroll
  for(int r=4;r<16;r+=4){a=max3f(a,p0[r],p0[r+1]);b=max3f(b,p0[r+2],p0[r+3]);a=max3f(a,p1[r],p1[r+1]);b=max3f(b,p1[r+2],p1[r+3]);}
  const float m=max2f(a,b);
  auto rr=__builtin_amdgcn_permlane32_swap(__float_as_uint(m),__float_as_uint(m),false,false);
  return max2f(__uint_as_float(rr[0]),__uint_as_float(rr[1]));
}
__device__ __forceinline__ void pv(f32x16*o,int vb,bf16x8 pa0,bf16x8 pa1,bf16x8 pa2,bf16x8 pa3){
  #pragma unroll
  for(int d0=0;d0<2;++d0){s16x4 lo[4],hi[4];
    #pragma unroll
    for(int ks=0;ks<4;++ks){
      asm volatile("ds_read_b64_tr_b16 %0,%1 offset:%c2":"=&v"(lo[ks]):"v"(vb),"i"(d0*4096+ks*1024):"memory");
      asm volatile("ds_read_b64_tr_b16 %0,%1 offset:%c2":"=&v"(hi[ks]):"v"(vb),"i"(d0*4096+ks*1024+512):"memory");}
    asm volatile("s_waitcnt lgkmcnt(0)":::"memory");SBAR();
    #define PK(k) (bf16x8){lo[k][0],lo[k][1],lo[k][2],lo[k][3],hi[k][0],hi[k][1],hi[k][2],hi[k][3]}
    o[d0]=__builtin_amdgcn_mfma_f32_32x32x16_bf16(pa0,PK(0),o[d0],0,0,0);
    o[d0]=__builtin_amdgcn_mfma_f32_32x32x16_bf16(pa1,PK(1),o[d0],0,0,0);
    o[d0]=__builtin_amdgcn_mfma_f32_32x32x16_bf16(pa2,PK(2),o[d0],0,0,0);
    o[d0]=__builtin_amdgcn_mfma_f32_32x32x16_bf16(pa3,PK(3),o[d0],0,0,0);
    #undef PK
  }
}

#ifndef ATTN_STORE16
#define ATTN_STORE16(p,v) (*(u32x4*)(p)=(v))
#endif
template<int THRL,bool FOX> __device__ __forceinline__ void attn_unit(int b,int h,int qb,const bf16*Q,const bf16*__restrict__ K,const bf16*__restrict__ V,bf16*Y,int ycol0,const float*__restrict__ gout,const float*__restrict__ cbg,const float*__restrict__ gqk,char*shm){
  int tid_=threadIdx.x; asm volatile("":"+v"(tid_));
  const int tid=tid_,lane=tid&63,r32=lane&31,hi=lane>>5; const int wid=__builtin_amdgcn_readfirstlane(tid>>6);
  const long rowbase=(long)b*SEQ; const long kvbase=FOX?rowbase:(long)b*KVMEM; const int q0=qb*QB;
  const bf16*Qw=Q+(rowbase+q0+wid*QBLK)*DM+h*D;
  int t0=0;
  if(FOX){ float gq=fabsf(gqk[lane]),gk=fabsf(gqk[64+lane]);
    #pragma unroll
    for(int o=1;o<64;o<<=1){ gq=fmaxf(gq,__shfl_xor(gq,o)); gk=fmaxf(gk,__shfl_xor(gk,o)); }
    const float margin=2.04f*(8.0f*1.4426950408889634f)*gq*gk+40.0f; const float thr=cbg[q0]+margin; const int ntf=(q0+QB)/KVBLK-4; int cnt=0;
    for(int tt=lane;tt<ntf;tt+=64) cnt+=(cbg[64*tt+63]>=thr)?1:0;
    #pragma unroll
    for(int o=1;o<64;o<<=1) cnt+=__shfl_xor(cnt,o);
    t0=__builtin_amdgcn_readfirstlane(cnt)&~1; }
  const bf16*Kh=K+(kvbase+64*t0)*DM+h*D,*Vh=V+(kvbase+64*t0)*DM+h*D;
  const unsigned lds0=(unsigned)(uintptr_t)shm;
  float*wsf=(float*)(shm+LDS_WS)+wid*64;
  const bf16*ksrc=Kh+(long)lane*DM+wid*8;
  const bf16*vsrc=Vh+(long)(16*(wid&3)+(lane>>2))*DM+(wid>>2)*32+(lane&3)*8;
  const unsigned kdst=lds0+LDS_K+wid*1024, vdst=lds0+LDS_V+wid*1024;
  #define DMA_K(t,slot) glds16(ksrc+(long)(t)*KVBLK*DM,(unsigned)__builtin_amdgcn_readfirstlane(kdst+(slot)))
  #define DMA_V(t,slot) glds16(vsrc+(long)(t)*KVBLK*DM,(unsigned)__builtin_amdgcn_readfirstlane(vdst+(slot)))
  const int vb0=(int)(lds0+LDS_V)+((lane>>4)&1)*32+(lane&3)*8+(4*hi+((lane&15)>>2))*64;
  const char*Kbase=shm+LDS_K; bf16x8 kf[8];
  const lds_cptr shm3=(lds_cptr)shm; const lds_cptr kp0=shm3+LDS_K+hi*1024+r32*16; const lds_cptr vp0=shm3+LDS_V+((lane>>4)&1)*32+(lane&3)*8+(4*hi+((lane&15)>>2))*64;
  const int NT=FOX?(q0+QB)/KVBLK-t0:KVMEM/KVBLK;
  const int qrel=wid*QBLK+r32;
  typedef __attribute__((address_space(3))) unsigned long long lds_u64;
  float cbq=0.f; unsigned bkbase=0u, bkstep=0u;
  if(FOX){ lds_u64*tb=(lds_u64*)((__attribute__((address_space(3))) char*)shm+LDS_CB); const int ncb=q0+QB-64*t0; const float*cbt=cbg+64*t0;
    for(int i=tid;i<ncb;i+=NW*64){ const float x=-cbt[i]; const unsigned h_=f2bf_a(x); const float r1=x-__uint_as_float(h_<<16); const unsigned m_=f2bf_a(r1); const float r2=r1-__uint_as_float(m_<<16); const unsigned l_=f2bf_a(r2);
      tb[i]=(unsigned long long)(h_|(m_<<16))|((unsigned long long)l_<<32); }
    if(tid==0){ unsigned long long z_=0ull; asm volatile("":"+v"(z_)); tb[SEQ]=z_; tb[SEQ+1]=z_; }
    cbq=cbg[q0+qrel];
    asm volatile("s_waitcnt vmcnt(0) lgkmcnt(0)\n\ts_barrier":::"memory");
    bkbase=hi?(unsigned)(LDS_CBZ):(unsigned)(LDS_CB+r32*8); bkstep=hi?0u:512u; }
  const bf16x8 qone=(bf16x8){(short)0x3F80,(short)0x3F80,(short)0x3F80,(short)0x3F80,(short)0x3F80,(short)0x3F80,(short)0x3F80,(short)0x3F80};
  #define LOADBK(B0,B1,t) do{ const lds_cptr bp_=(lds_cptr)shm+bkbase+(unsigned)(t)*bkstep; const unsigned long long x0_=*(const __attribute__((address_space(3))) unsigned long long*)bp_, x1_=*(const __attribute__((address_space(3))) unsigned long long*)(bp_+(hi?0:256)); \
    B0=__builtin_bit_cast(bf16x8,(u32x4){(unsigned)x0_,(unsigned)(x0_>>32),0u,0u}); B1=__builtin_bit_cast(bf16x8,(u32x4){(unsigned)x1_,(unsigned)(x1_>>32),0u,0u}); }while(0)
  DMA_K(0,0);DMA_V(0,0);DMA_K(1,SLOTB);
  bf16x8 qr[4];
  #pragma unroll
  for(int d0=0;d0<4;++d0)qr[d0]=*reinterpret_cast<const bf16x8*>(&Qw[(long)r32*DM+d0*16+hi*8]);
  typedef __attribute__((address_space(3))) bf16x8 lds_bf8; lds_bf8*qst=(lds_bf8*)((__attribute__((address_space(3))) char*)shm+LDS_OST+wid*4096)+lane;
  if(FOX){
  #pragma unroll
  for(int d0=0;d0<4;++d0)qst[d0*64]=qr[d0]; }
  #define QL(i) (*(qst+(i)*64))
  float mhat=-cbq,l_reg=0.f;f32x16 o[2];o[0]=f32x16{};o[1]=f32x16{};f32x16 negm;
  #pragma unroll
  for(int r=0;r<16;++r)negm[r]=cbq;
  asm volatile("":"+v"(negm));
  #define CMASK(P0,P1,t) do{ if(FOX && !defined_nomask){int jb_=(t)-(NT-4); if(jb_>=0)cmask(P0,P1,jb_,qrel,hi);} }while(0)
  bool resc=false;
  #define START(P0,P1) do{ const float rm=rowmax(P0,P1); resc=false; \
    { const float dl=rm; mhat=fadd_s(mhat,dl); \
      _Pragma("unroll") for(int r=0;r<16;++r){P0[r]=fsub_s(P0[r],dl);P1[r]=fsub_s(P1[r],dl);} \
      _Pragma("unroll") for(int r=0;r<16;++r)negm[r]=-mhat; asm volatile("":"+v"(negm)); } \
    _Pragma("unroll") for(int r=0;r<16;++r)P0[r]=__builtin_amdgcn_exp2f(P0[r]); }while(0)
  #define RESC() do{ if(resc){ asm volatile("s_waitcnt lgkmcnt(0)":::"memory"); \
      _Pragma("unroll") for(int d_=0;d_<2;++d_) _Pragma("unroll") for(int r=0;r<16;++r)o[d_][r]*=wsf[crow(r,hi)]; } }while(0)
  f32x16 pA0,pA1,pB0,pB1;
  int sl_prev=0,sl_cur=0,sl_next=SLOTB;
  #define ROT() do{sl_prev=sl_cur;sl_cur=sl_next;sl_next=(sl_next==(NSLOT-1)*SLOTB)?0:sl_next+SLOTB;}while(0)
  DMA_K(2,2*SLOTB);
  WAIT_BAR(3);
  if(FOX){ bf16x8 bk0_,bk1_; LOADBK(bk0_,bk1_,0); pA0=__builtin_amdgcn_mfma_f32_32x32x16_bf16(bk0_,qone,negm,0,0,0); pA1=__builtin_amdgcn_mfma_f32_32x32x16_bf16(bk1_,qone,negm,0,0,0); qkt(pA0,pA1,Kbase,qr,pA0,pA1,r32,hi); }
  else qkt(pA0,pA1,Kbase,qr,negm,negm,r32,hi);
  asm volatile("s_nop 15\n\ts_nop 7":"+v"(pA0),"+v"(pA1));CMASK(pA0,pA1,0);
  START(pA0,pA1);
  _Pragma("unroll") for(int r=0;r<16;++r)pA1[r]=__builtin_amdgcn_exp2f(pA1[r]);
  WAIT_BAR(0);
  DMA_K(3,0);DMA_V(1,SLOTB);
  ROT();
  kload8(kf,kp0+sl_cur);
  WAIT_BAR(2);
  s16x4 vlo[8],vhi[8]; u32x4 pw0,pw1,pw2,pw3;
  #define PKW(P,B) cvtpk_s(P[B],P[B+1])
  #define PAF(k) __builtin_bit_cast(bf16x8,pw##k)
  #define VFR(i) (bf16x8){vlo[i][0],vlo[i][1],vlo[i][2],vlo[i][3],vhi[i][0],vhi[i][1],vhi[i][2],vhi[i][3]}
  #define PIN(x) asm volatile("":"+v"(x))
  #define MX3(a,b,c) __builtin_fmaxf(__builtin_fmaxf((a),(b)),(c))
  #define GAPA(MF,A0,A1,A2,A3,W0,W1,PW) do{ MF; sacc+=A0; sacc+=A1; sacc+=A2; sacc+=A3; PIN(sacc); W0; W1; PIN(PW); SBAR(); }while(0)
  #define EX(v) __builtin_amdgcn_exp2f(v)
  #define GAPB(MF,X,B) do{ MF; X[B]=EX(X[B]); X[B+1]=EX(X[B+1]); X[B+2]=EX(X[B+2]); X[B+3]=EX(X[B+3]); PIN(X); SBAR(); }while(0)
  #define VRD(i) do{ vlo[i]=vtr(vp_+(((i)>>2)*4096+((i)&3)*1024)); vhi[i]=vtr(vp_+(((i)>>2)*4096+((i)&3)*1024+512)); }while(0)
  #define KRD(G,j) do{ if(G){ kload2(kf,kp0+sl_next,j); SBAR(); } }while(0)
  #define STEP(C0,C1,P0,P1,t,GK,GV,GL) do{ SBAR(); \
    if(FOX){ bf16x8 bk0_,bk1_; LOADBK(bk0_,bk1_,t); C0=__builtin_amdgcn_mfma_f32_32x32x16_bf16(bk0_,qone,negm,0,0,0); C1=__builtin_amdgcn_mfma_f32_32x32x16_bf16(bk1_,qone,negm,0,0,0); SBAR(); } \
    const lds_cptr vp_=vp0+sl_prev; \
    bf16x8 qa_,qb_; if(FOX){qa_=QL(0);}else{qa_=qr[0];} \
    VRD(0); SBAR(); float sacc=(P0[0]+P0[1]); \
    GAPA(C0=__builtin_amdgcn_mfma_f32_32x32x16_bf16(kf[0],qa_,FOX?C0:negm,0,0,0), P0[2],P0[3],P0[4],P0[5],     pw0[0]=PKW(P0,0), pw0[1]=PKW(P0,2), pw0); \
    VRD(4); if(FOX){qb_=QL(1);}else{qb_=qr[1];} SBAR(); GAPA(C1=__builtin_amdgcn_mfma_f32_32x32x16_bf16(kf[1],qa_,FOX?C1:negm,0,0,0), P0[6],P0[7],P0[8],P0[9],     pw0[2]=PKW(P0,4), pw0[3]=PKW(P0,6), pw0); \
    VRD(1); SBAR(); GAPA(C0=__builtin_amdgcn_mfma_f32_32x32x16_bf16(kf[2],qb_,C0,0,0,0),   P0[10],P0[11],P0[12],P0[13], pw1[0]=PKW(P0,8), pw1[1]=PKW(P0,10), pw1); \
    VRD(5); if(FOX){qa_=QL(2);}else{qa_=qr[2];} SBAR(); GAPA(C1=__builtin_amdgcn_mfma_f32_32x32x16_bf16(kf[3],qb_,C1,0,0,0),   P0[14],P0[15],P1[0],P1[1],   pw1[2]=PKW(P0,12),pw1[3]=PKW(P0,14), pw1); \
    VRD(2); SBAR(); GAPA(C0=__builtin_amdgcn_mfma_f32_32x32x16_bf16(kf[4],qa_,C0,0,0,0),   P1[2],P1[3],P1[4],P1[5],     pw2[0]=PKW(P1,0), pw2[1]=PKW(P1,2), pw2); \
    VRD(6); if(FOX){qb_=QL(3);}else{qb_=qr[3];} SBAR(); GAPA(C1=__builtin_amdgcn_mfma_f32_32x32x16_bf16(kf[5],qa_,C1,0,0,0),   P1[6],P1[7],P1[8],P1[9],     pw2[2]=PKW(P1,4), pw2[3]=PKW(P1,6), pw2); \
    VRD(3); SBAR(); GAPA(C0=__builtin_amdgcn_mfma_f32_32x32x16_bf16(kf[6],qb_,C0,0,0,0),   P1[10],P1[11],P1[12],P1[13], pw3[0]=PKW(P1,8), pw3[1]=PKW(P1,10), pw3); \
    VRD(7); SBAR(); GAPA(C1=__builtin_amdgcn_mfma_f32_32x32x16_bf16(kf[7],qb_,C1,0,0,0),   P1[14],P1[15],0.f,0.f,       pw3[2]=PKW(P1,12),pw3[3]=PKW(P1,14), pw3); \
    l_reg+=sacc; \
    if(GK){DMA_K((t)+3,sl_cur);} if(GV){DMA_V((t)+1,sl_next);} \
    CMASK(C0,C1,t); \
    { float a=MX3(C0[0],C0[1],C1[0]),b=MX3(C0[2],C0[3],C1[1]); a=MX3(a,C1[2],C1[3]); \
      _Pragma("unroll") for(int r=4;r<16;r+=4){a=MX3(a,C0[r],C0[r+1]);b=MX3(b,C0[r+2],C0[r+3]);a=MX3(a,C1[r],C1[r+1]);b=MX3(b,C1[r+2],C1[r+3]);} \
      float rm=__builtin_fmaxf(a,b); { auto rr=__builtin_amdgcn_permlane32_swap(__float_as_uint(rm),__float_as_uint(rm),false,false); rm=__builtin_fmaxf(__uint_as_float(rr[0]),__uint_as_float(rr[1])); } \
      resc=false; \
      if(__builtin_expect(__any(rm>(float)THRL),0)){ const float dl=__builtin_fmaxf(rm,0.f); mhat+=dl; \
        _Pragma("unroll") for(int r=0;r<16;++r){C0[r]-=dl;C1[r]-=dl;} \
        _Pragma("unroll") for(int r=0;r<16;++r)negm[r]=-mhat; asm volatile("":"+v"(negm)); \
        const float f=__builtin_amdgcn_exp2f(-dl); l_reg*=f; if(hi==0)wsf[r32]=f; resc=true; } } \
    SBAR(); \
    GAPB(o[0]=__builtin_amdgcn_mfma_f32_32x32x16_bf16(PAF(0),VFR(0),o[0],0,0,0), C0,0); \
    GAPB(o[1]=__builtin_amdgcn_mfma_f32_32x32x16_bf16(PAF(0),VFR(4),o[1],0,0,0), C0,4); \
    KRD(GL,0); GAPB(o[0]=__builtin_amdgcn_mfma_f32_32x32x16_bf16(PAF(1),VFR(1),o[0],0,0,0), C0,8); \
    KRD(GL,1); GAPB(o[1]=__builtin_amdgcn_mfma_f32_32x32x16_bf16(PAF(1),VFR(5),o[1],0,0,0), C0,12); \
    KRD(GL,2); GAPB(o[0]=__builtin_amdgcn_mfma_f32_32x32x16_bf16(PAF(2),VFR(2),o[0],0,0,0), C1,0); \
    KRD(GL,3); GAPB(o[1]=__builtin_amdgcn_mfma_f32_32x32x16_bf16(PAF(2),VFR(6),o[1],0,0,0), C1,4); \
    GAPB(o[0]=__builtin_amdgcn_mfma_f32_32x32x16_bf16(PAF(3),VFR(3),o[0],0,0,0), C1,8); \
    GAPB(o[1]=__builtin_amdgcn_mfma_f32_32x32x16_bf16(PAF(3),VFR(7),o[1],0,0,0), C1,12); \
    }while(0)
  int t=1;
  #undef CMASK
  #define CMASK(P0,P1,t) do{}while(0)
  for(;t+5<NT;t+=2){
    STEP(pB0,pB1,pA0,pA1,t,true,true,true);     WAIT_BAR(2); RESC(); ROT();
    STEP(pA0,pA1,pB0,pB1,t+1,true,true,true);   WAIT_BAR(2); RESC(); ROT();
  }
  #undef CMASK
  #define CMASK(P0,P1,t) do{ if(FOX && !defined_nomask){int jb_=(t)-(NT-4); if(jb_>=0)cmask(P0,P1,jb_,qrel,hi);} }while(0)
  #define ENDW(tt) do{ if((tt)+3<NT){WAIT_BAR(2);} else if((tt)+2<NT){WAIT_BAR(1);} else {WAIT_BAR(0);} }while(0)
  for(;t+1<NT;t+=2){
    STEP(pB0,pB1,pA0,pA1,t,(t+3<NT),(t+1<NT),(t+1<NT));       ENDW(t);   RESC(); ROT();
    STEP(pA0,pA1,pB0,pB1,t+1,(t+4<NT),(t+2<NT),(t+2<NT));     ENDW(t+1); RESC(); ROT();
  }
  STEP(pB0,pB1,pA0,pA1,NT-1,false,false,false); RESC();
  { float sacc=pB0[0]+pB0[1]; _Pragma("unroll") for(int r=2;r<16;++r)sacc+=pB0[r]; _Pragma("unroll") for(int r=0;r<16;++r)sacc+=pB1[r]; l_reg+=sacc;
    pw0=(u32x4){PKW(pB0,0),PKW(pB0,2),PKW(pB0,4),PKW(pB0,6)};pw1=(u32x4){PKW(pB0,8),PKW(pB0,10),PKW(pB0,12),PKW(pB0,14)};pw2=(u32x4){PKW(pB1,0),PKW(pB1,2),PKW(pB1,4),PKW(pB1,6)};pw3=(u32x4){PKW(pB1,8),PKW(pB1,10),PKW(pB1,12),PKW(pB1,14)};
    SBAR(); pv(o,vb0+sl_cur,PAF(0),PAF(1),PAF(2),PAF(3)); }
  #undef PKW
  #undef PAF
  #undef VFR
  #undef PIN
  #undef MX3
  #undef GAPA
  #undef GAPB
  #undef EX
  #undef VRD
  #undef KRD
  #undef STEP
  #undef ENDW
  {auto rr=__builtin_amdgcn_permlane32_swap(__float_as_uint(l_reg),__float_as_uint(l_reg),false,false);l_reg=__uint_as_float(rr[0])+__uint_as_float(rr[1]);}
  if(hi==0)wsf[32+r32]=l_reg;asm volatile("s_waitcnt lgkmcnt(0)":::"memory");
  float rli[16];
  #pragma unroll
  for(int r=0;r<16;++r)rli[r]=__builtin_amdgcn_rcpf(wsf[32+crow(r,hi)]);
  bf16*Yw=Y+(rowbase+q0+wid*QBLK)*YP+ycol0+h*D;
  { bf16*stg=(bf16*)(shm+LDS_OST)+wid*2048;
    #pragma unroll
    for(int r=0;r<16;++r){const int orow=crow(r,hi);
      #pragma unroll
      for(int d0=0;d0<2;++d0)stg[orow*64+d0*32+r32]=__float2bfloat16(o[d0][r]*rli[r]);}
    asm volatile("s_waitcnt lgkmcnt(0)":::"memory");
    const int ch=lane&7; const f32x4v g0=*(const f32x4v*)(gout+h*D+ch*8), g1=*(const f32x4v*)(gout+h*D+ch*8+4);
    #pragma unroll
    for(int i=0;i<4;++i){const int row=i*8+(lane>>3); const u32x4 v=*(const u32x4*)(stg+row*64+ch*8);
      float f[8];
      #pragma unroll
      for(int k=0;k<4;++k){ f[2*k]=__uint_as_float(v[k]<<16); f[2*k+1]=__uint_as_float(v[k]&0xffff0000u); }
      float ss=0.f;
      #pragma unroll
      for(int k=0;k<8;++k)ss+=f[k]*f[k];
      ss+=__shfl_xor(ss,1); ss+=__shfl_xor(ss,2); ss+=__shfl_xor(ss,4);
      const float rstd=1.0f/sqrtf(ss*(1.0f/64.0f)+1e-6f);
      u32x4 w; w.x=cvtpk_s(f[0]*rstd*g0[0],f[1]*rstd*g0[1]); w.y=cvtpk_s(f[2]*rstd*g0[2],f[3]*rstd*g0[3]); w.z=cvtpk_s(f[4]*rstd*g1[0],f[5]*rstd*g1[1]); w.w=cvtpk_s(f[6]*rstd*g1[2],f[7]*rstd*g1[3]);
      ATTN_STORE16(Yw+(long)row*YP+ch*8,w);} }
  asm volatile("s_waitcnt lgkmcnt(0)\n\ts_barrier":::"memory");
  #undef LOADBK
  #undef QL
  #undef DMA_K
  #undef DMA_V
  #undef CMASK
  #undef START
  #undef RESC
  #undef ROT
}
constexpr int ATTN_LDS_BYTES=LDS_BYTES;
struct AttnUnit { int bh; int qb; };
#undef SBAR
#undef WAIT_BAR
}
#define GAS __attribute__((address_space(1)))
#define LAS __attribute__((address_space(3)))
typedef unsigned short bf16;
typedef unsigned v4u __attribute__((ext_vector_type(4)));
typedef float f32x4 __attribute__((ext_vector_type(4)));
typedef short bf16x8 __attribute__((ext_vector_type(8)));
typedef GAS unsigned gu32;
typedef GAS unsigned long long gu64;
#define RLX_AGENT __ATOMIC_RELAXED, __HIP_MEMORY_SCOPE_AGENT
#define LDS_WAIT() asm volatile("s_waitcnt lgkmcnt(0)" ::: "memory")
#define VM_WAIT() asm volatile("s_waitcnt vmcnt(0)" ::: "memory")
__device__ __forceinline__ unsigned long long rt() { return __builtin_amdgcn_s_memrealtime(); }
__device__ __forceinline__ unsigned f2bf(float f) { unsigned u = __builtin_bit_cast(unsigned, f); return (u + 0x7fffu + ((u >> 16) & 1u)) >> 16; }
__device__ __forceinline__ unsigned pk2(float lo, float hi) { return f2bf(lo) | (f2bf(hi) << 16); }

#define XB_TMO      128
#define XB_XCNT(j)  (256  + 64 * (j))
#define XB_XSUB(j)  (1280 + 64 * (j))
#define XB_XGEN(j)  (2304 + 64 * (j))
#define XB_TOP      3328
#define XB_TOPGEN   3392
#define XCD_BAR_WORDS 3456
#define XB_SPIN_CAP (1u << 18)

__device__ __forceinline__ unsigned xb_ld(unsigned* p)              { return __hip_atomic_load(p, __ATOMIC_RELAXED, __HIP_MEMORY_SCOPE_AGENT); }
__device__ __forceinline__ unsigned xb_add(unsigned* p, unsigned v) { return __hip_atomic_fetch_add(p, v, __ATOMIC_RELAXED, __HIP_MEMORY_SCOPE_AGENT); }
__device__ __forceinline__ unsigned xb_xcc_id() { return (unsigned)__builtin_amdgcn_s_getreg((3 << 11) | 20) & 0xFu; }
#define XB_SPIN(cond, bar) do { unsigned _sp = 0; while (cond) { __builtin_amdgcn_s_sleep(1); \
    if ((++_sp & 255u) == 0u) { if (xb_ld(&(bar)[XB_TMO])) break; if (_sp > XB_SPIN_CAP) { atomicAdd(&(bar)[XB_TMO], 1u); break; } } } } while (0)

struct XcdBarrier {
    unsigned* bar; unsigned x;
    volatile LAS unsigned* st;
};

__device__ __forceinline__ XcdBarrier xcd_barrier_post(unsigned* bar, volatile LAS unsigned* st) {
    XcdBarrier b; b.bar = bar; b.x = xb_xcc_id(); b.st = st;
    if (threadIdx.x == 0) (void)xb_add(&bar[XB_XCNT(b.x)], 1u);
    return b;
}
__device__ __forceinline__ void xcd_barrier_complete(unsigned* bar, unsigned x, unsigned& nloc, unsigned& nx) {
    const unsigned G = gridDim.x * gridDim.y * gridDim.z;
    unsigned sum, cnt, mine, sp = 0u;
    for (;;) {
        sum = 0u; cnt = 0u; mine = 0u;
#pragma unroll
        for (unsigned j = 0; j < 16; ++j) { const unsigned c = xb_ld(&bar[XB_XCNT(j)]); sum += c; cnt += (c > 0u) ? 1u : 0u; mine = (j == x) ? c : mine; }
        if (sum == G) break;
        __builtin_amdgcn_s_sleep(1);
        if ((++sp & 255u) == 0u) { if (xb_ld(&bar[XB_TMO])) break; if (sp > XB_SPIN_CAP) { atomicAdd(&bar[XB_TMO], 1u); break; } }
    }
    nloc = mine > 0u ? mine : 1u; nx = cnt > 0u ? cnt : 1u;
}

__device__ __forceinline__ void xcd_barrier(const XcdBarrier& b) {
    asm volatile("s_waitcnt vmcnt(0)" ::: "memory");
    __syncthreads();
    if (threadIdx.x == 0) {
        unsigned* bar = b.bar;
        __builtin_amdgcn_s_waitcnt(0);
        unsigned nloc = b.st[0], nx = b.st[1];
        if (nloc == 0u) { xcd_barrier_complete(bar, b.x, nloc, nx); b.st[0] = nloc; b.st[1] = nx; }
        const unsigned old = xb_add(&bar[XB_XSUB(b.x)], 1u);
        const unsigned gen = old / nloc;
        if (old + 1u == (gen + 1u) * nloc) {
            __builtin_amdgcn_fence(__ATOMIC_RELEASE, "agent");
            asm volatile("s_waitcnt vmcnt(0)" ::: "memory");
            const unsigned og = xb_add(&bar[XB_TOP], 1u);
            const unsigned tg = og / nx;
            if (og + 1u == (tg + 1u) * nx) xb_add(&bar[XB_TOPGEN], 1u);
            else XB_SPIN(xb_ld(&bar[XB_TOPGEN]) == tg, bar);
            __builtin_amdgcn_fence(__ATOMIC_ACQUIRE, "agent");
            xb_add(&bar[XB_XGEN(b.x)], 1u);
            asm volatile("s_waitcnt vmcnt(0)" ::: "memory");
        } else {
            XB_SPIN(xb_ld(&bar[XB_XGEN(b.x)]) == gen, bar);
            __builtin_amdgcn_fence(__ATOMIC_ACQUIRE, "agent");
            asm volatile("s_waitcnt vmcnt(0)" ::: "memory");
        }
    }
    __syncthreads();
}
constexpr int RING_OFF = 0, RING_BYTES = 153600;
constexpr int LDSCTL_OFF = RING_BYTES, GTAB_OFF = LDSCTL_OFF  , MISC_OFF = LDSCTL_OFF + 320;
constexpr int LDS_BYTES = 154624;
static_assert(MISC_OFF + 128 <= LDS_BYTES && attn_body::LDS_BYTES <= RING_BYTES, "LDS map");

struct Frame {
    LAS unsigned char* lds;
    volatile LAS unsigned* MISC;
    gu32* ctl;
    int tid, lane, wave, vcu, G;
};
__device__ __forceinline__ float wave_sum(float v) {
#pragma unroll
    for (int o = 1; o < 64; o <<= 1) v += __shfl_xor(v, o);
    return v;
}

struct WSrc { const float* p; int col; int N; };
__device__ __forceinline__ WSrc wsrc(int kind, int d, const float* w0, const float* w1) {
    WSrc s; s.p = w0; s.col = -1; s.N = 1;
    if (kind == 0) {
        const int pn = d >> 8, c = d & 255, bj = c >> 7, wc = (c >> 5) & 3, dlo = c & 31, hd = 64 * wc + 32 * bj + dlo;
        s.N = IN_COLS;
        if (pn == 0) s.col = hd; else if (pn == 1) s.col = 256 + hd; else if (pn <= 3) s.col = 512 + 256 * (pn - 2) + c; else if (pn <= 5) s.col = 1024 + 256 * (pn - 4) + c;
        else if (pn == 6) s.col = 1536 + hd; else if (pn == 7) s.col = 1792 + hd; else if (pn == 8) s.col = 2048 + c; else if (pn == 9) s.col = 2308 + hd;
        else if (pn == 10) s.col = c < 4 ? 2304 + c : -1;
        else { s.p = w1; s.N = 512; s.col = pn == 11 ? hd : 256 + c; }
    } else if (kind == 1) { s.N = D_MODEL; s.col = d; }
    else if (kind == 2) { const int pn = d >> 8, c = d & 255, f = 128 * pn + (c & 127); s.N = D_FF; s.p = c < 128 ? w0 : w1; s.col = f < D_FF ? f : -1; }
    else { s.N = D_MODEL; s.col = d; }
    return s;
}
constexpr int TR_P = 68;
struct TrItem { int kind; const float* w0; const float* w1; int Ksrc; bf16* dst; int Kd; int row0, k0; const float* gk; float s8; };
__device__ __forceinline__ void tr_load(const TrItem& d, int lane, f32x4 (&v)[16]) {
    const int q = lane & 15, kr = lane >> 4;
    const WSrc s = wsrc(d.kind, d.row0 + 4 * q, d.w0, d.w1);
#pragma unroll
    for (int i = 0; i < 16; ++i) { const int k = d.k0 + 4 * i + kr; v[i] = (f32x4){0.f, 0.f, 0.f, 0.f}; if (s.col >= 0 && k < d.Ksrc) v[i] = __builtin_nontemporal_load((const GAS f32x4*)(s.p + (size_t)k * s.N + s.col)); }
}
__device__ __forceinline__ void tr_store(const TrItem& d, int lane, const f32x4 (&v)[16], LAS float* scr) {
    const int q = lane & 15, kr = lane >> 4;
#pragma unroll
    for (int i = 0; i < 16; ++i) { const int kk = 4 * i + kr; f32x4 x = v[i]; if (d.gk) x = x * d.gk[(d.k0 + kk) < d.Ksrc ? d.k0 + kk : 0];
        *(LAS f32x4*)(scr + kk * TR_P + ((4 * q + 4 * (kk >> 3)) & 63)) = x; }
    LDS_WAIT(); asm volatile("" ::: "memory");
    const int c = lane & 7;
#pragma unroll
    for (int j = 0; j < 8; ++j) { const int n = (lane >> 3) + 8 * j; const LAS float* p = scr + (8 * c) * TR_P + ((n + 4 * c) & 63);
        if (d.s8 > 0.f) { typedef unsigned u32x2 __attribute__((ext_vector_type(2))); u32x2 o; const float s = d.s8;
            o.x = pg8::pk4_fp8(p[0 * TR_P] * s, p[1 * TR_P] * s, p[2 * TR_P] * s, p[3 * TR_P] * s); o.y = pg8::pk4_fp8(p[4 * TR_P] * s, p[5 * TR_P] * s, p[6 * TR_P] * s, p[7 * TR_P] * s);
            *(GAS u32x2*)((unsigned char*)d.dst + (size_t)(d.row0 + n) * d.Kd + d.k0 + 8 * c) = o; }
        else { v4u o; o.x = pg8::cvt_pk_bf16(p[0 * TR_P], p[1 * TR_P]); o.y = pg8::cvt_pk_bf16(p[2 * TR_P], p[3 * TR_P]); o.z = pg8::cvt_pk_bf16(p[4 * TR_P], p[5 * TR_P]); o.w = pg8::cvt_pk_bf16(p[6 * TR_P], p[7 * TR_P]);
            *(GAS v4u*)(d.dst + (size_t)(d.row0 + n) * d.Kd + d.k0 + 8 * c) = o; } }
    LDS_WAIT(); asm volatile("" ::: "memory");
}
struct In { const float *x, *mem, *attn_g, *w_in, *fbias, *fqg, *fkg, *mqg, *mkg, *memg, *wmemkv, *outg, *w_out, *ffn_g, *dwg, *dwu, *dwd, *router, *ewg, *ewu, *ewd; };

struct FfnMat { const float *g, *u, *d; };
__device__ __forceinline__ FfnMat ffn_mat(const In& I, int mi) { FfnMat f;
    f.g = mi < 2 ? I.dwg + (size_t)mi * D_MODEL * D_FF : I.ewg + (size_t)(mi - 2) * D_MODEL * D_FF; f.u = mi < 2 ? I.dwu + (size_t)mi * D_MODEL * D_FF : I.ewu + (size_t)(mi - 2) * D_MODEL * D_FF;
    f.d = mi < 2 ? I.dwd + (size_t)mi * D_FF * D_MODEL : I.ewd + (size_t)(mi - 2) * D_FF * D_MODEL; return f; }
constexpr int I_IN = (D_MODEL / 64) * (NINKV / 64), I_OUT = (D_MODEL / 64) * (D_MODEL / 64), I_GU = (D_MODEL / 64) * (NGU / 64), I_DN = (FFP / 64) * (D_MODEL / 64);
constexpr int T_IN = 4 * I_IN, T_OUT = 4 * I_OUT, T_GU = 18 * I_GU, T_DN = 18 * I_DN;
constexpr int DEF_M0 = 10, N_DEF = (18 - DEF_M0) * (I_GU + I_DN);
constexpr int N_DEF1 = (256 - 196) * 8 * 3 + (256 - 128) * 8 * 5, U_DEF1 = T_IN + T_OUT + 2 * I_GU;
constexpr int N_DEF_T = (16320 < N_DEF ? 16320 : N_DEF);
constexpr int N_DEF3 = 2 * I_IN + 2 * I_OUT + I_GU + I_DN, N_PRO = T_IN + T_OUT + DEF_M0 * (I_GU + I_DN) - N_DEF1 - N_DEF3;
__device__ __forceinline__ TrItem decode_item(const In& I, unsigned char* ws, int r) { TrItem d;
    if (r < T_IN) { const int l = r / I_IN, q = r % I_IN, kb = q / (NINKV / 64), nb = q % (NINKV / 64);
        d = TrItem{0, I.w_in + (size_t)l * D_MODEL * IN_COLS, I.wmemkv + (size_t)l * D_MODEL * 512, D_MODEL, (bf16*)(ws + WS_WIN + l * SZ_WIN), D_MODEL, 64 * nb, 64 * kb, nb < NIN / 64 ? I.attn_g + l * D_MODEL : nullptr, 0.f}; return d; }
    r -= T_IN;
    if (r < T_OUT) { const int l = r / I_OUT, q = r % I_OUT, kb = q / (D_MODEL / 64), nb = q % (D_MODEL / 64);
        d = TrItem{1, I.w_out + (size_t)l * D_MODEL * D_MODEL, nullptr, D_MODEL, (bf16*)(ws + WS_WOUT + l * SZ_WOUT), D_MODEL, 64 * nb, 64 * kb, nullptr, 0.f}; return d; }
    r -= T_OUT;
    if (r < T_GU) { const int mi = r / I_GU, q = r % I_GU, kb = q / (NGU / 64), nb = q % (NGU / 64); const FfnMat f = ffn_mat(I, mi);
        d = TrItem{2, f.g, f.u, D_MODEL, (bf16*)(mi < 2 ? (ws + WS_WGU + mi * SZ_WGU) : (ws + WS_EGU + (size_t)(mi - 2) * SZ_EGU)), D_MODEL, 64 * nb, 64 * kb, I.ffn_g + (mi < 2 ? 2 * mi : 2 * ((mi - 2) >> 3) + 1) * D_MODEL, (FP8_MOE_GU && mi >= 2) ? SW_GU : 0.f}; return d; }
    r -= T_GU;
    { const int mi = r / I_DN, q = r % I_DN, kb = q / (D_MODEL / 64), nb = q % (D_MODEL / 64); const FfnMat f = ffn_mat(I, mi);
        d = TrItem{3, f.d, nullptr, D_FF, (bf16*)(mi < 2 ? (ws + WS_WDN + mi * SZ_WDN) : (ws + WS_EDN + (size_t)(mi - 2) * SZ_WDN)), FFP, 64 * nb, 64 * kb, nullptr, FP8_DN ? SW_DN : 0.f}; return d; }
}
__device__ __forceinline__ int list_item(int list, int p) {
    if (list == 0 && p >= N_PRO) { list = 1; p = N_DEF_T + (p - N_PRO); }
    if (list == 0) {
        if (p < 2 * I_IN) return p;                                  p -= 2 * I_IN;
        if (p < 2 * I_OUT) return T_IN + p;                          p -= 2 * I_OUT;
        if (p < I_GU) return T_IN + T_OUT + p;                       p -= I_GU;
        if (p < 8 * I_GU - N_DEF1) return U_DEF1 + N_DEF1 + p;       p -= 8 * I_GU - N_DEF1;
        if (p < I_DN) return T_IN + T_OUT + T_GU + p;                p -= I_DN;
        return T_IN + T_OUT + T_GU + 2 * I_DN + p;
    }
    if (list == 3) {
        if (p < 2 * I_IN) return 2 * I_IN + p;                       p -= 2 * I_IN;
        if (p < 2 * I_OUT) return T_IN + 2 * I_OUT + p;              p -= 2 * I_OUT;
        if (p < I_GU) return T_IN + T_OUT + I_GU + p;                p -= I_GU;
        return T_IN + T_OUT + T_GU + I_DN + p;
    }
    if (list == 2) return U_DEF1 + p;
    return p < (18 - DEF_M0) * I_GU ? T_IN + T_OUT + DEF_M0 * I_GU + p : T_IN + T_OUT + T_GU + DEF_M0 * I_DN + (p - (18 - DEF_M0) * I_GU);
}
__device__ __forceinline__ void p_convert(Frame& F, const In& I, unsigned char* ws, int list, int first, int stride, int quota) {
    LAS float* scr = (LAS float*)(F.lds + RING_OFF + F.wave * (64 * TR_P * 4));
    const int nlist = list == 0 ? N_PRO + (N_DEF - N_DEF_T) : list == 1 ? N_DEF_T : list == 2 ? N_DEF1 : N_DEF3;
    f32x4 va[16], vb[16]; TrItem da, db; int it = first, left = quota; bool hasa = it < nlist && left > 0, hasb = false;
    if (hasa) { da = decode_item(I, ws, list_item(list, it)); tr_load(da, F.lane, va); --left; }
    while (hasa) {
        hasb = it + stride < nlist && left > 0; if (hasb) { db = decode_item(I, ws, list_item(list, it + stride)); tr_load(db, F.lane, vb); --left; }
        tr_store(da, F.lane, va, scr);
        if (!hasb) break;
        it += 2 * stride; hasa = it < nlist && left > 0; if (hasa) { da = decode_item(I, ws, list_item(list, it)); tr_load(da, F.lane, va); --left; }
        tr_store(db, F.lane, vb, scr);
    }
}
constexpr int DQ_IP = 3, DQ_F = 5, DQ_D1 = 3, DQ_M1 = 2, DQ_D1X = 3, DC_IP = 196, DC_F = 128, DC_D1 = 16, DC_M1 = 96;
static_assert((256 - DC_D1) * 8 * DQ_D1X >= N_DEF3, "list 3 fits its slot (the expert down phase of layer 1)");
constexpr int DS2_IP0 = 0, DS2_F0 = DS2_IP0 + (256 - DC_IP) * 8 * DQ_IP;
static_assert(DS2_F0 + (256 - DC_F) * 8 * DQ_F >= N_DEF1, "list 2 slots cover the list");
constexpr int DS_IP1 = 0, DS_M1 = DS_IP1 + (256 - DC_IP) * 8 * DQ_IP, DS_D1 = DS_M1 + (256 - DC_M1) * 8 * DQ_M1, DS_IP2 = DS_D1 + (256 - DC_D1) * 8 * DQ_D1, DS_F2 = DS_IP2 + (256 - DC_IP) * 8 * DQ_IP;
constexpr int N_DEF_T_ = DS_F2 + (256 - DC_F) * 8 * DQ_F;
static_assert(N_DEF_T_ >= N_DEF_T, "list 1 slots cover the deferred part of the list");
__device__ __forceinline__ void p_convert_tail(Frame& F, const In& I, unsigned char* ws, int list, int slot, int c0, int quota) {
    if ((int)blockIdx.x < c0 || F.G != 256) return;
    const int nw = (256 - c0) * NWAVES, r = ((int)blockIdx.x - c0) * NWAVES + F.wave;
    p_convert(F, I, ws, list, slot + r, nw, quota);
}

__device__ __forceinline__ void p_prologue(Frame& F, const In& I, unsigned char* ws) {
    const int gw = F.vcu * NWAVES + F.wave, NGW = F.G * NWAVES;
    if (F.vcu == 0) for (int i = F.tid; i < 1024; i += NWAVES * 64) { const int l = i >> 8, w = (i >> 6) & 3, d = i & 63; const float* src = w == 0 ? I.fqg : w == 1 ? I.fkg : w == 2 ? I.mqg : I.mkg; ((float*)(ws + WS_GAINS))[i] = src[l * 64 + d]; }
    constexpr int NROWS = M_TOK + 4 * M_MEM;
#define PR_LOAD(mr, HV) do { const int mr_ = (mr); if (mr_ < NROWS) { const bool im_ = mr_ >= M_TOK; const int rm_ = im_ ? (mr_ - M_TOK) % M_MEM : mr_; \
        const GAS f32x4* xr_ = (const GAS f32x4*)((im_ ? I.mem : I.x) + (size_t)rm_ * D_MODEL) + F.lane; _Pragma("unroll") for (int j = 0; j < 4; ++j) HV[j] = __builtin_nontemporal_load(xr_ + 64 * j); } } while (0)
#define PR_DO(mr, HV) do { const int mr_ = (mr); if (mr_ < NROWS) { const bool ismem = mr_ >= M_TOK; const int lm = ismem ? (mr_ - M_TOK) / M_MEM : 0, rm = ismem ? (mr_ - M_TOK) % M_MEM : mr_; float s = 0.f; \
        _Pragma("unroll") for (int j = 0; j < 4; ++j) s += (HV[j].x * HV[j].x + HV[j].y * HV[j].y) + (HV[j].z * HV[j].z + HV[j].w * HV[j].w); \
        s = wave_sum(s); \
        if (ismem) { const float rstd = __builtin_amdgcn_rsqf(s * (1.f / D_MODEL) + EPS); const GAS f32x4* gr = (const GAS f32x4*)(I.memg + lm * D_MODEL) + F.lane; \
            _Pragma("unroll") for (int j = 0; j < 4; ++j) HV[j] = HV[j] * rstd * gr[64 * j]; } \
        GAS unsigned long long* o8 = (GAS unsigned long long*)((ismem ? (bf16*)(ws + WS_MEMN) + (size_t)(lm * M_MEM + rm) * D_MODEL : (bf16*)(ws + WS_XB) + (size_t)rm * D_MODEL)) + F.lane; \
        _Pragma("unroll") for (int j = 0; j < 4; ++j) o8[64 * j] = (unsigned long long)pg8::cvt_pk_bf16(HV[j].x, HV[j].y) | ((unsigned long long)pg8::cvt_pk_bf16(HV[j].z, HV[j].w) << 32); \
        if (!ismem && F.lane == 0) *(GAS f32x4*)((float*)(ws + WS_SSA) + (size_t)rm * 4) = (f32x4){s, 0.f, 0.f, 0.f}; } } while (0)
    { f32x4 h0[4], h1[4], h2[4];
      for (int mr = gw; mr < NROWS; mr += 3 * NGW) { PR_LOAD(mr, h0); PR_LOAD(mr + NGW, h1); PR_LOAD(mr + 2 * NGW, h2); PR_DO(mr, h0); PR_DO(mr + NGW, h1); PR_DO(mr + 2 * NGW, h2); } }
#undef PR_LOAD
#undef PR_DO
    p_convert(F, I, ws, 0, gw, NGW, 1 << 30);
}

struct TokRoute { int e1, p1, e2, p2; float g1, g2; int pad0, pad1; };
__device__ __forceinline__ void load_xb_row(const bf16* XB, int m, int lane, f32x4 (&xv)[4]) {
    const GAS unsigned long long* xr = (const GAS unsigned long long*)(XB + (size_t)m * D_MODEL) + lane;
#pragma unroll
    for (int j = 0; j < 4; ++j) { const unsigned long long a = xr[64 * j]; xv[j].x = pg8::bf_lo((unsigned)a); xv[j].y = pg8::bf_hi((unsigned)a); xv[j].z = pg8::bf_lo((unsigned)(a >> 32)); xv[j].w = pg8::bf_hi((unsigned)(a >> 32)); }
}
__device__ __forceinline__ void build_tab(LAS int* tab, const gu32* counts) {
    __syncthreads();
    if (threadIdx.x == 0) { int t = 0; for (int e = 0; e < N_EXPERTS; ++e) { int n = (int)__hip_atomic_load(counts + e, RLX_AGENT); n = n > 16384 ? 16384 : n; tab[e] = t; t += (n + 255) / 256; } tab[N_EXPERTS] = t; }
    __syncthreads();
}
__device__ __forceinline__ void p_combine(Frame& F, bf16* XB, const bf16* YD, const TokRoute* R, const LAS int* tab, float* SSA, float* OUT, bool final_) {
    const int gw = F.vcu * NWAVES + F.wave, NGW = F.G * NWAVES; const int nrows = (M_TOK - gw + NGW - 1) / NGW;
    int s1_l = 0, s2_l = 0; float g1_l = 0.f, g2_l = 0.f;
    if (F.lane < nrows) { const GAS v4u* rr = (const GAS v4u*)(R + gw + F.lane * NGW); const v4u ra = rr[0], rb = rr[1]; s1_l = tab[ra[0]] * 256 + (int)ra[1]; s2_l = tab[ra[2]] * 256 + (int)ra[3]; g1_l = __uint_as_float(rb[0]); g2_l = __uint_as_float(rb[1]); }
    f32x4 xa[4], ya[4], za[4], xb[4], yb[4], zb[4];
#define CB_LOAD(i, X, Y, Z) do { load_xb_row(XB, gw + (i) * NGW, F.lane, X); load_xb_row(YD, __builtin_amdgcn_readlane(s1_l, (i)), F.lane, Y); load_xb_row(YD, __builtin_amdgcn_readlane(s2_l, (i)), F.lane, Z); } while (0)
#define CB_DO(i, X, Y, Z) do { const int m_ = gw + (i) * NGW; const float g1 = __int_as_float(__builtin_amdgcn_readlane(__float_as_int(g1_l), (i))), g2 = __int_as_float(__builtin_amdgcn_readlane(__float_as_int(g2_l), (i))); float s = 0.f; \
        _Pragma("unroll") for (int j = 0; j < 4; ++j) { X[j] = (X[j] + Y[j] * g1) + Z[j] * g2; s += (X[j].x * X[j].x + X[j].y * X[j].y) + (X[j].z * X[j].z + X[j].w * X[j].w); } \
        if (final_) { GAS f32x4* xo = (GAS f32x4*)(OUT + (size_t)m_ * D_MODEL) + F.lane; _Pragma("unroll") for (int j = 0; j < 4; ++j) xo[64 * j] = X[j]; } \
        else { s = wave_sum(s); GAS unsigned long long* o8 = (GAS unsigned long long*)(XB + (size_t)m_ * D_MODEL) + F.lane; \
            _Pragma("unroll") for (int j = 0; j < 4; ++j) o8[64 * j] = (unsigned long long)pg8::cvt_pk_bf16(X[j].x, X[j].y) | ((unsigned long long)pg8::cvt_pk_bf16(X[j].z, X[j].w) << 32); \
            if (F.lane == 0) *(GAS f32x4*)(SSA + (size_t)m_ * 4) = (f32x4){s, 0.f, 0.f, 0.f}; } } while (0)
    if (nrows > 0) CB_LOAD(0, xa, ya, za);
    for (int i = 0; i < nrows; i += 2) {
        if (i + 1 < nrows) CB_LOAD(i + 1, xb, yb, zb);
        CB_DO(i, xa, ya, za);
        if (i + 1 < nrows) { if (i + 2 < nrows) CB_LOAD(i + 2, xa, ya, za); CB_DO(i + 1, xb, yb, zb); }
    }
#undef CB_LOAD
#undef CB_DO
}
__device__ __forceinline__ void p_route(Frame& F, const bf16* XB, const float* SSF, const float* g, const float* router, gu32* counts, int* list, TokRoute* R, float* RSS, unsigned char* X8) {
    const int gw = F.vcu * NWAVES + F.wave, NGW = F.G * NWAVES; f32x4 hv[4];
    LAS float* wr = (LAS float*)(F.lds + RING_OFF);
    LAS unsigned* lcnt = (LAS unsigned*)(F.lds + RING_OFF + 32768);
    LAS v4u* lrec = (LAS v4u*)(F.lds + RING_OFF + 32768 + 64);
    for (int i = F.tid; i < D_MODEL * N_EXPERTS; i += NWAVES * 64) wr[(i & 7) * D_MODEL + (i >> 3)] = router[i] * g[i >> 3];
    if (F.tid < 16) lcnt[F.tid] = 0u;
    __syncthreads();
    int nrow = 0; f32x4 hw[4]; f32x4 pa, pb;
    f32x4 wreg[4][N_EXPERTS];
#pragma unroll
    for (int j = 0; j < 4; ++j)
#pragma unroll
        for (int e = 0; e < N_EXPERTS; ++e) wreg[j][e] = *(const LAS f32x4*)(wr + e * D_MODEL + 256 * j + 4 * F.lane);
#define RT_LOAD(mm, H, P) do { load_xb_row(XB, (mm), F.lane, H); P = *(const GAS f32x4*)(SSF + (size_t)(mm) * 4); } while (0)
#define RT_DO(mm, H, P) do { const int m = (mm); const float rstd = __builtin_amdgcn_rsqf(((P[0] + P[1]) + (P[2] + P[3])) * (1.0f / D_MODEL) + EPS); \
        if (FP8_MOE_GU) { GAS unsigned* o4 = (GAS unsigned*)(X8 + (size_t)m * D_MODEL) + F.lane; const float s8 = rstd * SA_HB; \
            _Pragma("unroll") for (int j = 0; j < 4; ++j) o4[64 * j] = pg8::pk4_fp8(H[j].x * s8, H[j].y * s8, H[j].z * s8, H[j].w * s8); } \
        float lg[N_EXPERTS]; \
        _Pragma("unroll") for (int e = 0; e < N_EXPERTS; ++e) lg[e] = 0.f; \
        _Pragma("unroll") for (int j = 0; j < 4; ++j) _Pragma("unroll") for (int e = 0; e < N_EXPERTS; ++e) { const f32x4 w = wreg[j][e]; lg[e] += (H[j].x * w.x + H[j].y * w.y) + (H[j].z * w.z + H[j].w * w.w); } \
        { const int ln_ = F.lane; float a4_[4], b2_[2], c1_;   \
          _Pragma("unroll") for (int k = 0; k < 4; ++k) { const float keep = (ln_ & 32) ? lg[4 + k] : lg[k], send = (ln_ & 32) ? lg[k] : lg[4 + k]; a4_[k] = keep + __shfl_xor(send, 32); } \
          _Pragma("unroll") for (int k = 0; k < 2; ++k) { const float keep = (ln_ & 16) ? a4_[2 + k] : a4_[k], send = (ln_ & 16) ? a4_[k] : a4_[2 + k]; b2_[k] = keep + __shfl_xor(send, 16); } \
          { const float keep = (ln_ & 8) ? b2_[1] : b2_[0], send = (ln_ & 8) ? b2_[0] : b2_[1]; c1_ = keep + __shfl_xor(send, 8); } \
          c1_ += __shfl_xor(c1_, 4); c1_ += __shfl_xor(c1_, 2); c1_ += __shfl_xor(c1_, 1);     \
          _Pragma("unroll") for (int e = 0; e < N_EXPERTS; ++e) lg[e] = __int_as_float(__builtin_amdgcn_readlane(__float_as_int(c1_), ((e >> 2) & 1) * 32 + ((e >> 1) & 1) * 16 + (e & 1) * 8)) * rstd; } \
        int e1 = 0; float v1 = lg[0]; \
        _Pragma("unroll") for (int e = 1; e < N_EXPERTS; ++e) if (lg[e] > v1) { v1 = lg[e]; e1 = e; } \
        int e2 = -1; float v2 = -INFINITY; \
        _Pragma("unroll") for (int e = 0; e < N_EXPERTS; ++e) if (e != e1 && lg[e] > v2) { v2 = lg[e]; e2 = e; } \
        const float g2 = 1.0f / (1.0f + __expf(v1 - v2)), g1 = 1.0f - g2; \
        if (F.lane == 0) {   \
            const unsigned r1 = __hip_atomic_fetch_add((unsigned*)(lcnt + e1), 1u, __ATOMIC_RELAXED, __HIP_MEMORY_SCOPE_WORKGROUP), r2 = __hip_atomic_fetch_add((unsigned*)(lcnt + e2), 1u, __ATOMIC_RELAXED, __HIP_MEMORY_SCOPE_WORKGROUP); \
            lrec[(F.wave * 8 + nrow) * 2] = (v4u){(unsigned)e1, r1, (unsigned)e2, r2}; lrec[(F.wave * 8 + nrow) * 2 + 1] = (v4u){__float_as_uint(g1), __float_as_uint(g2), (unsigned)m, __float_as_uint(rstd)}; } \
        ++nrow; } while (0)
    { int m0 = gw; if (m0 < M_TOK) RT_LOAD(m0, hv, pa);
      for (; m0 < M_TOK; m0 += 2 * NGW) { const int m1 = m0 + NGW, m2 = m0 + 2 * NGW;
          if (m1 < M_TOK) RT_LOAD(m1, hw, pb);
          RT_DO(m0, hv, pa);
          if (m1 < M_TOK) { if (m2 < M_TOK) RT_LOAD(m2, hv, pa); RT_DO(m1, hw, pb); } } }
#undef RT_LOAD
#undef RT_DO
    __syncthreads();
    if (F.tid < N_EXPERTS) lcnt[8 + F.tid] = __hip_atomic_fetch_add(counts + F.tid, lcnt[F.tid], RLX_AGENT);
    __syncthreads();
    if (F.lane < nrow) { const v4u a = lrec[(F.wave * 8 + F.lane) * 2], b = lrec[(F.wave * 8 + F.lane) * 2 + 1]; const int mm = (int)b[2];
        unsigned p1 = lcnt[8 + a[0]] + a[1], p2 = lcnt[8 + a[2]] + a[3];
        if (p1 < 16384u) { list[a[0] * 16384 + p1] = mm; RSS[a[0] * 16384 + p1] = __uint_as_float(b[3]); } else p1 = 16383u;
        if (p2 < 16384u) { list[a[2] * 16384 + p2] = mm; RSS[a[2] * 16384 + p2] = __uint_as_float(b[3]); } else p2 = 16383u;
        GAS v4u* ro = (GAS v4u*)(R + mm); ro[0] = (v4u){a[0], p1, a[2], p2}; ro[1] = (v4u){b[0], b[1], 0u, 0u}; }
    __syncthreads();
}

__device__ __forceinline__ void p_cumsum(Frame& F, const float* LOGF, float* CB) {
    if (F.vcu >= 8) return;
    const float* src = LOGF + (size_t)F.vcu * SEQ + F.tid * 16; float* dst = CB + (size_t)F.vcu * SEQ + F.tid * 16;
    float v[16];
#pragma unroll
    for (int j = 0; j < 4; ++j) { const f32x4 t = *(const f32x4*)(src + 4 * j); v[4 * j] = t.x; v[4 * j + 1] = t.y; v[4 * j + 2] = t.z; v[4 * j + 3] = t.w; }
#pragma unroll
    for (int j = 1; j < 16; ++j) v[j] += v[j - 1];
    float incl = v[15];
#pragma unroll
    for (int o = 1; o < 64; o <<= 1) { const float t = __shfl_up(incl, o); if (F.lane >= o) incl += t; }
    LAS float* wt = (LAS float*)(F.lds + RING_OFF);
    if (F.lane == 63) wt[F.wave] = incl;
    __syncthreads();
    float base = incl - v[15];
    for (int w = 0; w < F.wave; ++w) base += wt[w];
#pragma unroll
    for (int j = 0; j < 4; ++j) { f32x4 t; t.x = (v[4 * j] + base) * 1.4426950408889634f; t.y = (v[4 * j + 1] + base) * 1.4426950408889634f; t.z = (v[4 * j + 2] + base) * 1.4426950408889634f; t.w = (v[4 * j + 3] + base) * 1.4426950408889634f; *(f32x4*)(dst + 4 * j) = t; }
    __syncthreads();
}

constexpr int RT_VP = 144, RT_KP = 72;
typedef short rt_v4i16 __attribute__((ext_vector_type(4)));
__device__ __forceinline__ float ret_log2g(int h) { return log2f(1.0f - exp2f(-5.0f - (float)h)); }
__device__ __forceinline__ bf16x8 ret_tr8(const LAS bf16* tile, int P, int tA, int tB, int c0, int lane) {
    const int q = (lane & 15) >> 2, p = lane & 3;
    const rt_v4i16 a = __builtin_amdgcn_ds_read_tr16_b64_v4i16((LAS rt_v4i16*)(tile + (tA + q) * P + c0 + 4 * p));
    const rt_v4i16 b = __builtin_amdgcn_ds_read_tr16_b64_v4i16((LAS rt_v4i16*)(tile + (tB + q) * P + c0 + 4 * p));
    return (bf16x8){a[0], a[1], a[2], a[3], b[0], b[1], b[2], b[3]};
}
__device__ __forceinline__ void ret_stage_v(Frame& F, const bf16* RV, int t0, int h, LAS bf16* Vr) {
#pragma unroll
    for (int q = 0; q < 4; ++q) { const int p = F.tid + 512 * q, j = p >> 4, ec = p & 15; *(LAS v4u*)(Vr + j * RT_VP + 8 * ec) = *(const GAS v4u*)(RV + (size_t)(t0 + j) * 512 + 128 * h + 8 * ec); }
}
__device__ __forceinline__ void p_ret_kv(Frame& F, const bf16* RK, const bf16* RV, float* KVT) {
    LAS bf16* Vr = (LAS bf16*)(F.lds + RING_OFF); LAS bf16* Kd = Vr + 128 * RT_VP;
    const int er = F.lane & 15, g = F.lane >> 4;
    for (int u = F.vcu; u < 512; u += F.G) {
        const int bh = u >> 6, n = u & 63, b = bh >> 2, h = bh & 3, t0 = b * SEQ + n * 128; const float l2g = ret_log2g(h);
        ret_stage_v(F, RV, t0, h, Vr);
#pragma unroll
        for (int q = 0; q < 2; ++q) { const int p = F.tid + 512 * q, j = p >> 3, dc = p & 7; const v4u raw = *(const GAS v4u*)(RK + (size_t)(t0 + j) * 256 + 64 * h + 8 * dc); const float dec = exp2f((float)(127 - j) * l2g);
            v4u o;
#pragma unroll
            for (int k = 0; k < 4; ++k) o[k] = pk2(__uint_as_float(raw[k] << 16) * dec, __uint_as_float(raw[k] & 0xffff0000u) * dec);
            *(LAS v4u*)(Kd + j * RT_KP + 8 * dc) = o; }
        __syncthreads();
        f32x4 acc[4];
#pragma unroll
        for (int dt = 0; dt < 4; ++dt) acc[dt] = (f32x4){0.f, 0.f, 0.f, 0.f};
#pragma unroll
        for (int ks = 0; ks < 4; ++ks) { const int tA = 32 * ks + 8 * g; const bf16x8 a = ret_tr8(Vr, RT_VP, tA, tA + 4, 16 * F.wave, F.lane);
#pragma unroll
            for (int dt = 0; dt < 4; ++dt) { const bf16x8 bb = ret_tr8(Kd, RT_KP, tA, tA + 4, 16 * dt, F.lane); acc[dt] = __builtin_amdgcn_mfma_f32_16x16x32_bf16(a, bb, acc[dt], 0, 0, 0); } }
        float* out = KVT + (size_t)u * 8192;
#pragma unroll
        for (int dt = 0; dt < 4; ++dt)
#pragma unroll
            for (int r = 0; r < 4; ++r) out[(16 * F.wave + 4 * g + r) * 64 + 16 * dt + er] = acc[dt][r];
        __syncthreads();
    }
}
__device__ __forceinline__ void p_ret_scan(Frame& F, const float* KVT, bf16* PREVT, int item) {
    { const int idx = item * 512 + F.tid;
        const int bh = idx >> 13, ed = idx & 8191, h = bh & 3; const float cd = exp2f(128.0f * ret_log2g(h));
        const float* src = KVT + (size_t)bh * 64 * 8192 + ed; bf16* dst = PREVT + (size_t)bh * 64 * 8192 + ed; float st = 0.f;
#pragma unroll 32
        for (int n = 0; n < 64; ++n) { dst[(size_t)n * 8192] = (bf16)f2bf(st); st = st * cd + src[(size_t)n * 8192]; }
    }
}
__device__ __forceinline__ void p_ret_out(Frame& F, const bf16* RQ, const bf16* RK, const bf16* RV, const bf16* RGs, const bf16* PREVT, const float* gret, bf16* Y) {
    const int lc = F.lane & 15, g = F.lane >> 4, uh = F.wave >> 2, wl = F.wave & 3;
    LAS bf16* Vr = (LAS bf16*)(F.lds + RING_OFF) + uh * (128 * RT_VP);
    for (int u0 = F.vcu; u0 < 256; u0 += F.G) {
        const int u = u0 + 256 * uh;
        const int bh = u >> 6, n = u & 63, b = bh >> 2, h = bh & 3, t0 = b * SEQ + n * 128; const float l2g = ret_log2g(h);
        { const int th = F.tid & 255;
#pragma unroll
            for (int q = 0; q < 8; ++q) { const int p = th + 256 * q, j = p >> 4, ec = p & 15; *(LAS v4u*)(Vr + j * RT_VP + 8 * ec) = *(const GAS v4u*)(RV + (size_t)(t0 + j) * 512 + 128 * h + 8 * ec); } }
        __syncthreads();
        const bf16* pv = PREVT + (size_t)u * 8192;
#pragma unroll 1
        for (int tbi = 0; tbi < 2; ++tbi) {
            const int w = 2 * wl + tbi;
            bf16x8 qf[2];
#pragma unroll
            for (int ks = 0; ks < 2; ++ks) qf[ks] = *(const GAS bf16x8*)(RQ + (size_t)(t0 + 16 * w + lc) * 256 + 64 * h + 32 * ks + 8 * g);
            bf16x8 kf[8][2];
#pragma unroll
            for (int jt = 0; jt < 8; ++jt)
#pragma unroll
                for (int ks = 0; ks < 2; ++ks) { kf[jt][ks] = (bf16x8){0, 0, 0, 0, 0, 0, 0, 0}; if (jt <= w) kf[jt][ks] = *(const GAS bf16x8*)(RK + (size_t)(t0 + 16 * jt + lc) * 256 + 64 * h + 32 * ks + 8 * g); }
            f32x4 accC[8], accI[8];
#pragma unroll
            for (int et = 0; et < 8; ++et) { accC[et] = (f32x4){0.f, 0.f, 0.f, 0.f}; accI[et] = (f32x4){0.f, 0.f, 0.f, 0.f};
#pragma unroll
                for (int ks = 0; ks < 2; ++ks) { const bf16x8 a = *(const GAS bf16x8*)(pv + (16 * et + lc) * 64 + 32 * ks + 8 * g); accC[et] = __builtin_amdgcn_mfma_f32_16x16x32_bf16(a, qf[ks], accC[et], 0, 0, 0); } }
            const int iloc = 16 * w + lc;
#pragma unroll
            for (int kp = 0; kp < 4; ++kp) if (kp <= (w >> 1)) {
                unsigned pk[4];
#pragma unroll
                for (int half = 0; half < 2; ++half) { const int jt = 2 * kp + half; f32x4 s = (f32x4){0.f, 0.f, 0.f, 0.f};
                    if (jt <= w) {
#pragma unroll
                        for (int ks = 0; ks < 2; ++ks) s = __builtin_amdgcn_mfma_f32_16x16x32_bf16(kf[jt][ks], qf[ks], s, 0, 0, 0);
#pragma unroll
                        for (int r = 0; r < 4; ++r) { const int jloc = 16 * jt + 4 * g + r; s[r] = (iloc >= jloc) ? s[r] * exp2f((float)(iloc - jloc) * l2g) : 0.f; }
                    }
                    pk[2 * half] = pg8::cvt_pk_bf16(s[0], s[1]); pk[2 * half + 1] = pg8::cvt_pk_bf16(s[2], s[3]); }
                const bf16x8 pb = __builtin_bit_cast(bf16x8, (v4u){pk[0], pk[1], pk[2], pk[3]});
#pragma unroll
                for (int et = 0; et < 8; ++et) { const bf16x8 a = ret_tr8(Vr, RT_VP, 32 * kp + 4 * g, 32 * kp + 16 + 4 * g, 16 * et, F.lane);
                    accI[et] = __builtin_amdgcn_mfma_f32_16x16x32_bf16(a, pb, accI[et], 0, 0, 0); }
            }
            const float qd = exp2f((float)(iloc + 1) * l2g); float ss = 0.f;
#pragma unroll
            for (int et = 0; et < 8; ++et) { accI[et] = accI[et] + accC[et] * qd; ss += (accI[et][0] * accI[et][0] + accI[et][1] * accI[et][1]) + (accI[et][2] * accI[et][2] + accI[et][3] * accI[et][3]); }
            ss += __shfl_xor(ss, 16); ss += __shfl_xor(ss, 32);
            const float rstd = __builtin_amdgcn_rsqf(ss * (1.0f / 128.0f) + EPS);
            const size_t rowo = (size_t)(t0 + iloc);
#pragma unroll
            for (int et = 0; et < 8; ++et) { const int e = 16 * et + 4 * g; const f32x4 gg = *(const f32x4*)(gret + 128 * h + e);
                const unsigned long long rg_ = *(const GAS unsigned long long*)(RGs + rowo * 512 + 128 * h + e);
                const float r0 = __uint_as_float((unsigned)rg_ << 16), r1 = __uint_as_float((unsigned)rg_ & 0xffff0000u), r2 = __uint_as_float((unsigned)(rg_ >> 32) << 16), r3 = __uint_as_float((unsigned)(rg_ >> 32) & 0xffff0000u);
                const unsigned long long o = (unsigned long long)pk2(accI[et][0] * rstd * gg.x * r0, accI[et][1] * rstd * gg.y * r1) | ((unsigned long long)pk2(accI[et][2] * rstd * gg.z * r2, accI[et][3] * rstd * gg.w * r3) << 32);
                *(GAS unsigned long long*)(Y + rowo * D_MODEL + 128 * h + e) = o; }
        }
        __syncthreads();
    }
}
struct Args { const float* in[21]; float* out; unsigned char* ws; int ph_lo, ph_hi; };
typedef const __attribute__((address_space(4))) Args* kargs_t;
#define KARGS() ({ unsigned long long p_ = (unsigned long long)__builtin_amdgcn_kernarg_segment_ptr(); asm volatile("" : "+s"(p_)); (kargs_t)p_; })
__global__ void __launch_bounds__(NWAVES * 64, 2) trunk_fwd(Args args_unused) {
    extern __shared__ __attribute__((aligned(16))) unsigned char lds[];
    Frame F;
    F.lds = (LAS unsigned char*)lds;
    F.MISC = (volatile LAS unsigned*)(F.lds + MISC_OFF);
    F.tid = threadIdx.x; F.lane = F.tid & 63; F.wave = __builtin_amdgcn_readfirstlane(F.tid >> 6);
    F.G = gridDim.x; { const int bx = blockIdx.x; F.vcu = (F.G % 8 == 0) ? (bx % 8) * (F.G / 8) + bx / 8 : bx; }
    F.ctl = nullptr;
    for (int u = F.tid; u < (LDS_BYTES - LDSCTL_OFF) / 4; u += NWAVES * 64) ((LAS unsigned*)(F.lds + LDSCTL_OFF))[u] = 0u;
    __syncthreads();
    { kargs_t A = KARGS(); (void)xcd_barrier_post((unsigned*)(A->ws + WS_CTL) + CW_BAR, F.MISC + 8); }
#define GRID_BAR() do { kargs_t A_ = KARGS(); XcdBarrier b_; b_.bar = (unsigned*)(A_->ws + WS_CTL) + CW_BAR; b_.x = xb_xcc_id(); b_.st = F.MISC + 8; xcd_barrier(b_); } while (0)
#define WSP(T, off) ((T*)(ws + (off)))
#define LAUNDER_F() do { asm volatile("" : "+v"(F.tid)); F.lane = F.tid & 63; F.wave = __builtin_amdgcn_readfirstlane(F.tid >> 6); } while (0)
#ifndef ALIGN_F1
#define ALIGN_F1 true
#endif
#ifndef ALIGN_IP
#define ALIGN_IP true
#endif
#define CONV_IN(A_) In Ic; Ic.attn_g = (A_)->in[2]; Ic.w_in = (A_)->in[3]; Ic.wmemkv = (A_)->in[10]; Ic.w_out = (A_)->in[12]; Ic.ffn_g = (A_)->in[13]; Ic.dwg = (A_)->in[14]; Ic.dwu = (A_)->in[15]; Ic.dwd = (A_)->in[16]; Ic.ewg = (A_)->in[18]; Ic.ewu = (A_)->in[19]; Ic.ewd = (A_)->in[20];
#define XLDS ((unsigned)(RING_OFF + 131072))
#ifdef PROBE_T
    unsigned long long tacc_ = 0ull, ts_ = 0ull;
#define TSTART(p) do { if (PROBE_T == (p)) ts_ = __builtin_amdgcn_s_memrealtime(); } while (0)
#define TEND(p) do { if (PROBE_T == (p)) tacc_ += __builtin_amdgcn_s_memrealtime() - ts_; } while (0)
#else
#define TSTART(p) do { } while (0)
#define TEND(p) do { } while (0)
#endif
#if defined(PROBE_T) && defined(PROBE_EPI)
#define EPIACC(p) const unsigned long long te_ =
#define EPIEND(p) if (PROBE_T == 100 + (p)) tacc_ += te_;
#else
#define EPIACC(p) (void)
#define EPIEND(p)
#endif

#ifndef SKIP_PRO
    TSTART(9);
    { LAUNDER_F(); kargs_t A = KARGS(); In I; I.x = A->in[0]; I.mem = A->in[1]; I.attn_g = A->in[2]; I.w_in = A->in[3]; I.fqg = A->in[5]; I.fkg = A->in[6]; I.mqg = A->in[7]; I.mkg = A->in[8]; I.memg = A->in[9];
        I.wmemkv = A->in[10]; I.w_out = A->in[12]; I.ffn_g = A->in[13]; I.dwg = A->in[14]; I.dwu = A->in[15]; I.dwd = A->in[16]; I.ewg = A->in[18]; I.ewu = A->in[19]; I.ewd = A->in[20];
        p_prologue(F, I, A->ws); }
    GRID_BAR();
    TEND(9);

#endif
            for (int l = 0; l < DEPTH; ++l) {
#ifndef SKIP_P0
        if (l == 2) { TSTART(0); { LAUNDER_F(); kargs_t A = KARGS(); unsigned char* ws = A->ws;
            build_tab((LAS int*)(F.lds + GTAB_OFF), (const gu32*)(ws + WS_CTL) + CW_CNT + 64 * ((l - 1) >> 1));
            p_combine(F, WSP(bf16, WS_XB), WSP(const bf16, WS_YD), WSP(const TokRoute, WS_GATEW), (const LAS int*)(F.lds + GTAB_OFF), WSP(float, WS_SSA), nullptr, false); }
            GRID_BAR(); TEND(0); }
        #endif
#ifndef SKIP_P1
        TSTART(1);
        { LAUNDER_F(); kargs_t A = KARGS(); unsigned char* ws = A->ws;
            pg8::Gemm g{WSP(bf16, WS_XB), (const bf16*)(ws + WS_WIN + l * SZ_WIN), D_MODEL * 2, 0, (const bf16*)(ws + WS_MEMN) + (size_t)l * M_MEM * D_MODEL, M_TOK / 256};
            pg8::TileOrder S{M_TOK / 256, NIN / 256, F.G, (int)blockIdx.x, M_TOK / 256, NIN / 256, 2, 2};
            pg8::EpiInProj E{ws, A->in[4] + l * 4, WSP(float, WS_GAINS) + l * 256, WSP(float, WS_SSA)};
            EPIACC(1) pg8::gemm_phase<pg8::EpiInProj, pg8::TileOrder, ALIGN_IP, true, false, false>(F.lds + RING_OFF, g, S, E); EPIEND(1)
        }
        if (l < 3) { LAUNDER_F(); kargs_t A = KARGS(); CONV_IN(A); p_convert_tail(F, Ic, A->ws, l == 0 ? 2 : 1, l == 0 ? DS2_IP0 : l == 1 ? DS_IP1 : DS_IP2, DC_IP, DQ_IP); }
        GRID_BAR(); TEND(1);
        #endif
#ifndef SKIP_P2
        TSTART(2);
        { LAUNDER_F(); kargs_t A = KARGS(); unsigned char* ws = A->ws; p_cumsum(F, WSP(float, WS_LOGF), WSP(float, WS_CB)); p_ret_kv(F, WSP(bf16, WS_RK), WSP(bf16, WS_RV), WSP(float, WS_KVT)); }
        GRID_BAR(); TEND(2);
        #endif
#ifndef SKIP_P3
        TSTART(3);
        {
            for (int uu = F.vcu; uu < 256; uu += F.G) { const int bh = uu >> 5, qb = uu & 31;
                { LAUNDER_F(); kargs_t A = KARGS(); unsigned char* ws = A->ws;
                attn_body::attn_unit<8, true>(bh >> 2, bh & 3, qb, WSP(const attn_body::bf16, WS_FQ), WSP(const attn_body::bf16, WS_FK), WSP(const attn_body::bf16, WS_FV), WSP(attn_body::bf16, WS_Y), 512, A->in[11] + l * D_MODEL + 512, WSP(float, WS_CB) + (size_t)bh * SEQ, WSP(float, WS_GAINS) + l * 256, (char*)lds + RING_OFF); }
            }
            for (;;) {
                if (F.tid == 0) { kargs_t A = KARGS(); F.MISC[16] = __hip_atomic_fetch_add((unsigned*)(A->ws + WS_CTL) + CW_MEMQ + 64 * l, 1u, RLX_AGENT); }
                __syncthreads(); const int uu = (int)F.MISC[16]; __syncthreads();
                if (uu >= 256 + 128) break;
                if (uu < 128) { LAUNDER_F(); kargs_t A = KARGS(); unsigned char* ws = A->ws; p_ret_scan(F, WSP(float, WS_KVT), WSP(bf16, WS_PREVT), uu); continue; }
                const int bh = (uu - 128) >> 5, qb = (uu - 128) & 31;
                { LAUNDER_F(); kargs_t A = KARGS(); unsigned char* ws = A->ws;
                attn_body::attn_unit<8, false>(bh >> 2, bh & 3, qb, WSP(const attn_body::bf16, WS_MQ), WSP(const attn_body::bf16, WS_MK), WSP(const attn_body::bf16, WS_MV), WSP(attn_body::bf16, WS_Y), 768, A->in[11] + l * D_MODEL + 768, nullptr, nullptr, (char*)lds + RING_OFF); }
            }
        }
        GRID_BAR(); TEND(3);
        #endif
#ifndef SKIP_P4
        TSTART(4);
        { LAUNDER_F(); kargs_t A = KARGS(); unsigned char* ws = A->ws;
            p_ret_out(F, WSP(bf16, WS_RQ), WSP(bf16, WS_RK), WSP(bf16, WS_RV), WSP(bf16, WS_RG), WSP(bf16, WS_PREVT), A->in[11] + l * D_MODEL, WSP(bf16, WS_Y)); }
        GRID_BAR(); TEND(4);
        #endif
#ifndef SKIP_P5
        TSTART(5);
        { LAUNDER_F(); kargs_t A = KARGS(); unsigned char* ws = A->ws;
            pg8::Gemm g{WSP(bf16, WS_Y), (const bf16*)(ws + WS_WOUT + l * SZ_WOUT), D_MODEL * 2, 0, WSP(bf16, WS_Y), 1 << 30};
            pg8::TileOrder S{M_TOK / 256, D_MODEL / 256, F.G, (int)blockIdx.x, 0, 0, 0, 0};
            pg8::EpiDown E{WSP(bf16, WS_XB), WSP(float, WS_SSF), WSP(bf16, WS_YD), XLDS, false, 1.0f};
            EPIACC(5) pg8::gemm_phase<pg8::EpiDown, pg8::TileOrder, true, true, false, false>(F.lds + RING_OFF, g, S, E); EPIEND(5)
        }
        GRID_BAR(); TEND(5);
        #endif
#ifndef SKIP_P6
        if (l & 1) { TSTART(6); { LAUNDER_F(); kargs_t A = KARGS(); unsigned char* ws = A->ws; const int j2 = l >> 1;
            p_route(F, WSP(const bf16, WS_XB), WSP(const float, WS_SSF), A->in[13] + l * D_MODEL, A->in[17] + (size_t)j2 * D_MODEL * N_EXPERTS, (gu32*)(ws + WS_CTL) + CW_CNT + 64 * j2, WSP(int, WS_LIST), WSP(TokRoute, WS_GATEW), WSP(float, WS_RSS), ws + WS_X8); }
            GRID_BAR(); TEND(6); }
        #endif
#ifndef SKIP_P7
        TSTART(7);
        { LAUNDER_F(); kargs_t A = KARGS(); unsigned char* ws = A->ws; const int j2 = l >> 1; const bool moe = (l & 1) != 0;
            pg8::GroupedOrder S; S.init(F.G, (int)blockIdx.x, NGU / 256, (LAS int*)(F.lds + GTAB_OFF), moe ? (const unsigned*)(ws + WS_CTL) + CW_CNT + 64 * j2 : nullptr, WSP(int, WS_LIST));
            if (FP8_MOE_GU && moe) {
                pg8::Gemm g{ws + WS_X8, (const void*)(ws + WS_EGU + (size_t)j2 * 8 * SZ_EGU), D_MODEL, SZ_EGU, ws + WS_X8, 1 << 30};
                pg8::EpiSwiGLU<true> E{ws + WS_HF, WSP(const float, WS_SSF), WSP(const float, WS_RSS), false};
                EPIACC(7) pg8::gemm_phase<pg8::EpiSwiGLU<true>, pg8::GroupedOrder, ALIGN_F1, true, true, true>(F.lds + RING_OFF, g, S, E); EPIEND(7)
            } else {
                pg8::Gemm g{WSP(bf16, WS_XB), moe ? (const void*)(ws + WS_EGU + (size_t)j2 * 8 * SZ_EGU) : (const void*)(ws + WS_WGU + (size_t)j2 * SZ_WGU), D_MODEL * 2, moe ? SZ_EGU : 0, WSP(bf16, WS_XB), 1 << 30};
                pg8::EpiSwiGLU<false> E{ws + WS_HF, WSP(const float, WS_SSF), WSP(const float, WS_RSS), !moe};
                EPIACC(7) pg8::gemm_phase<pg8::EpiSwiGLU<false>, pg8::GroupedOrder, ALIGN_F1, true, true, false>(F.lds + RING_OFF, g, S, E); EPIEND(7)
            }
        }
        if (l == 0 || l == 2) { LAUNDER_F(); kargs_t A = KARGS(); CONV_IN(A); p_convert_tail(F, Ic, A->ws, l == 0 ? 2 : 1, l == 0 ? DS2_F0 : DS_F2, DC_F, DQ_F); }
        if (l == 1) { LAUNDER_F(); kargs_t A = KARGS(); CONV_IN(A); p_convert_tail(F, Ic, A->ws, 1, DS_M1, DC_M1, DQ_M1); }
        GRID_BAR(); TEND(7);
        #endif
#ifndef SKIP_P8
        TSTART(8);
        { LAUNDER_F(); kargs_t A = KARGS(); unsigned char* ws = A->ws; const int j2 = l >> 1; const bool moe = (l & 1) != 0;
            pg8::GroupedOrder S; S.init(F.G, (int)blockIdx.x, D_MODEL / 256, (LAS int*)(F.lds + GTAB_OFF), moe ? (const unsigned*)(ws + WS_CTL) + CW_CNT + 64 * j2 : nullptr, WSP(int, WS_LIST));
            pg8::Gemm g{WSP(bf16, WS_HF), moe ? (const void*)(ws + WS_EDN + (size_t)j2 * 8 * SZ_WDN) : (const void*)(ws + WS_WDN + (size_t)j2 * SZ_WDN), FFP * FES_DN, moe ? SZ_WDN : 0, WSP(bf16, WS_HF), 1 << 30};
            pg8::EpiDown E{WSP(bf16, WS_XB), WSP(float, WS_SSA), WSP(bf16, WS_YD), XLDS, moe, FP8_DN ? 1.0f / (SW_DN * SA_HF) : 1.0f};
            EPIACC(8) pg8::gemm_phase<pg8::EpiDown, pg8::GroupedOrder, true, true, false, FP8_DN != 0>(F.lds + RING_OFF, g, S, E); EPIEND(8)
        }
        if (l == 1) { LAUNDER_F(); kargs_t A = KARGS(); CONV_IN(A); p_convert_tail(F, Ic, A->ws, 3, 0, DC_D1, DQ_D1X); p_convert_tail(F, Ic, A->ws, 1, DS_D1, DC_D1, DQ_D1); }
        GRID_BAR(); TEND(8);
#endif
            }
#ifndef SKIP_FIN
    TSTART(10);
    { LAUNDER_F(); kargs_t A = KARGS(); unsigned char* ws = A->ws;
        build_tab((LAS int*)(F.lds + GTAB_OFF), (const gu32*)(ws + WS_CTL) + CW_CNT + 64 * ((DEPTH - 1) >> 1));
        p_combine(F, WSP(bf16, WS_XB), WSP(const bf16, WS_YD), WSP(const TokRoute, WS_GATEW), (const LAS int*)(F.lds + GTAB_OFF), nullptr, A->out, true); }
    TEND(10);
#endif
        #ifdef PROBE_T
    if (blockIdx.x == 0) { const unsigned long long t1_ = __builtin_amdgcn_s_memrealtime() + (unsigned long long)PROBE_K * tacc_; while (__builtin_amdgcn_s_memrealtime() < t1_) __builtin_amdgcn_s_sleep(32); }
#endif
#undef GRID_BAR
#undef WSP
}

extern "C" void kernel_launch(void* const* d_in, const int* in_sizes, int n_in, void* d_out, int out_size, void* d_ws, size_t ws_size, hipStream_t stream) {
    static int grid = 0;
    if (grid == 0) {
        if (n_in != 21 || in_sizes[0] != M_TOK * D_MODEL || out_size != M_TOK * D_MODEL || ws_size < WS_END) {
            fprintf(stderr, "kernel_launch: built for 21 inputs, x/out of %d floats, >= %zu bytes of workspace; got n_in %d, in0 %d, out %d, ws %zu; nothing launched\n", M_TOK * D_MODEL, (size_t)WS_END, n_in, n_in > 0 ? in_sizes[0] : -1, out_size, ws_size); grid = -1; return; }
        int dev = 0, cus = 0, per_cu = 0;
        if (hipGetDevice(&dev) != hipSuccess || hipDeviceGetAttribute(&cus, hipDeviceAttributeMultiprocessorCount, dev) != hipSuccess) { fprintf(stderr, "kernel_launch: device query failed\n"); grid = -1; return; }
        if (hipFuncSetAttribute((const void*)trunk_fwd, hipFuncAttributeMaxDynamicSharedMemorySize, LDS_BYTES) != hipSuccess) { fprintf(stderr, "kernel_launch: hipFuncSetAttribute failed\n"); grid = -1; return; }
        if (hipOccupancyMaxActiveBlocksPerMultiprocessor(&per_cu, (const void*)trunk_fwd, NWAVES * 64, LDS_BYTES) != hipSuccess || per_cu < 1)
            fprintf(stderr, "kernel_launch: note: occupancy query reports %d workgroups per CU\n", per_cu);
        (void)hipGetLastError();
        grid = cus;
        if (grid > 256) grid = 256;
    }
    if (grid < 0) return;
    if (hipMemsetAsync((char*)d_ws + WS_CTL, 0, CTL_ZERO_BYTES, stream) != hipSuccess) { fprintf(stderr, "kernel_launch: hipMemsetAsync failed\n"); return; }
    Args a{};
    for (int i = 0; i < 21; ++i) a.in[i] = (const float*)d_in[i];
    a.out = (float*)d_out; a.ws = (unsigned char*)d_ws;
    a.ph_lo = 0; a.ph_hi = 0;
    hipLaunchKernelGGL(trunk_fwd, dim3(grid), dim3(NWAVES * 64), LDS_BYTES, stream, a);
    const hipError_t le = hipPeekAtLastError();
    if (le != hipSuccess) fprintf(stderr, "kernel_launch: launch failed: %s\n", hipGetErrorName(le));
}
```

```cpp
#include <hip/hip_runtime.h>
#include <hip/hip_bf16.h>
#include <cstdio>
#include <cstdint>
#include <cmath>

constexpr int D_MODEL = 1024, BATCH = 2, SEQ = 8192, DEPTH = 4, M_TOK = BATCH * SEQ;
constexpr int MEM_LEN = 256, M_MEM = BATCH * MEM_LEN;
constexpr int D_FF = 2752, FFP = 2816  , NGU = 2 * FFP  ;
constexpr int N_EXPERTS = 8, IN_COLS = 2564, NIN = 2816  , NINKV = NIN + 512  ;
constexpr float EPS = 1e-6f;
constexpr int NWAVES = 8;

constexpr size_t MiB = 1u << 20;
constexpr size_t WS_CTL = 0, CTL_ZERO_BYTES = 1 * MiB;
#ifndef FP8_GU
#define FP8_GU 0
#endif
#ifndef FP8_DN
#define FP8_DN 1
#endif
constexpr int FES_GU = FP8_GU ? 1 : 2, FES_DN = FP8_DN ? 1 : 2;
#ifndef FP8_MOE_GU
#define FP8_MOE_GU 1
#endif
static_assert(FP8_GU == 0, "dense fp8 gate|up: not wired");
constexpr float SW_GU = 64.0f;
constexpr int FES_EGU = FP8_MOE_GU ? 1 : 2;
constexpr float SW_DN = 64.0f;
constexpr float SA_HB = 8.0f, SA_HF = 4.0f;
constexpr size_t SZ_WIN = (size_t)NINKV * D_MODEL * 2, SZ_WOUT = (size_t)D_MODEL * D_MODEL * 2, SZ_WGU = (size_t)NGU * D_MODEL * FES_GU, SZ_WDN = (size_t)D_MODEL * FFP * FES_DN;
constexpr size_t WS_WIN = 1 * MiB;
constexpr size_t WS_WOUT = WS_WIN + 4 * SZ_WIN;
constexpr size_t WS_WGU = WS_WOUT + 4 * SZ_WOUT;
constexpr size_t WS_WDN = WS_WGU + 2 * SZ_WGU;
constexpr size_t WS_EGU = WS_WDN + 2 * SZ_WDN;
constexpr size_t SZ_EGU = (size_t)NGU * D_MODEL * FES_EGU;
constexpr size_t WS_EDN = WS_EGU + 16 * SZ_EGU;
constexpr size_t WS_XB = WS_EDN + 16 * SZ_WDN;
constexpr size_t WS_X8 = WS_XB + (size_t)M_TOK * D_MODEL * 2;
constexpr size_t WS_MEMN = WS_X8 + (size_t)M_TOK * D_MODEL;
constexpr size_t WS_SSA = WS_MEMN + (size_t)4 * M_MEM * D_MODEL * 2;
constexpr size_t WS_SSF = WS_SSA + (size_t)M_TOK * 4 * 4;
constexpr size_t WS_LIST = WS_SSF + (size_t)M_TOK * 4 * 4;
constexpr size_t WS_GATEW = WS_LIST + (size_t)N_EXPERTS * 16384 * 4;
constexpr size_t WS_RSS = WS_GATEW + (size_t)N_EXPERTS * 16384 * 4;
constexpr size_t WS_WRT = WS_RSS + (size_t)N_EXPERTS * 16384 * 4;
constexpr size_t WS_LOGP = WS_WRT + (size_t)2 * 16 * D_MODEL * 2;
constexpr size_t WS_LOGF = WS_LOGP + (size_t)M_TOK * 16 * 8 * 4;
constexpr size_t WS_CB = WS_LOGF + (size_t)8 * SEQ * 4;
constexpr size_t WS_MK = WS_CB + (size_t)8 * SEQ * 4;
constexpr size_t WS_MV = WS_MK + (size_t)M_MEM * 256 * 2;
constexpr size_t WS_INVGU = WS_MV + (size_t)M_MEM * 256 * 2;
constexpr size_t WS_INVDN = WS_INVGU + (size_t)18 * NGU * 4;
constexpr size_t WS_GAINS = WS_INVDN + (size_t)18 * D_MODEL * 4;
constexpr size_t WS_U = WS_GAINS + 4096;
constexpr size_t WS_RQ = WS_U, WS_RK = WS_RQ + (size_t)M_TOK * 256 * 2, WS_RV = WS_RK + (size_t)M_TOK * 256 * 2, WS_RG = WS_RV + (size_t)M_TOK * 512 * 2;
constexpr size_t WS_FQ = WS_RG + (size_t)M_TOK * 512 * 2, WS_FK = WS_FQ + (size_t)M_TOK * 256 * 2, WS_FV = WS_FK + (size_t)M_TOK * 256 * 2, WS_MQ = WS_FV + (size_t)M_TOK * 256 * 2;
constexpr size_t WS_KVT = WS_MQ + (size_t)M_TOK * 256 * 2;
constexpr size_t WS_PREVT = WS_KVT + (size_t)512 * 128 * 64 * 4;
constexpr size_t WS_Y = WS_PREVT + (size_t)512 * 128 * 64 * 2;
constexpr size_t WS_UEND_MIX = WS_Y + (size_t)M_TOK * D_MODEL * 2;
constexpr int HF_ROWS = 2 * M_TOK + N_EXPERTS * 256;
constexpr size_t WS_HF = WS_U;
constexpr size_t WS_UEND_HF = WS_HF + (size_t)HF_ROWS * FFP * FES_DN;
constexpr size_t WS_YD = (WS_UEND_HF > WS_UEND_MIX ? WS_UEND_HF : WS_UEND_MIX);
constexpr size_t WS_END = WS_YD + (size_t)HF_ROWS * D_MODEL * 2;
constexpr int CW_BAR = 4096;
constexpr int CW_CMAX_GU = 16384, CW_CMAX_DN = CW_CMAX_GU + 18 * NGU;
static_assert((size_t)(CW_CMAX_DN + 18 * D_MODEL) * 4 <= CTL_ZERO_BYTES, "CTL words inside the memset region");
constexpr int CW_MEMQ = 12288;
constexpr int CW_CNT = 8192;

namespace pg8 {
#define PG8_LAS __attribute__((address_space(3)))
typedef unsigned short bf16_t;
typedef short bf16x8 __attribute__((ext_vector_type(8)));
typedef float f32x4 __attribute__((ext_vector_type(4)));
typedef unsigned u32x4 __attribute__((ext_vector_type(4)));
typedef short bf16x16 __attribute__((ext_vector_type(16)));
constexpr int BM = 256, BK = 64, HALF = 128, HTB = HALF * BK * 2  , STAGE_BYTES = 8 * HTB, NXCD = 8, WGM = 8;

__host__ __device__ __forceinline__ int lds_byte(int r, int c) { const int st = (r >> 4) * 2 + (c >> 5), rr = r & 15, cc = c & 31, ob = rr * 64 + cc * 2; return st * 1024 + (ob ^ (((ob >> 9) & 1) << 5)); }
__host__ __device__ __forceinline__ void stage_rc(int b, int& R, int& C) { const int st = b / 1024, sb = b % 1024, swz = sb ^ (((sb >> 9) & 1) << 5); R = (st >> 1) * 16 + swz / 64; C = (st & 1) * 32 + (swz % 64) / 2; }
__host__ __device__ __forceinline__ int perm32(int rho) { const int n = rho >> 4, i = rho & 15; return 8 * (i >> 2) + 4 * n + (i & 3); }

struct Unit { int pm, pn, e, lt, cnt; };
struct Gemm { const void* A; const void* Bt; int KB; size_t bstride; const void* A2; int pm2; };
typedef int i32x8 __attribute__((ext_vector_type(8)));

__device__ __forceinline__ unsigned cvt_pk_bf16(float lo, float hi) { unsigned r; asm volatile("v_cvt_pk_bf16_f32 %0, %1, %2" : "=v"(r) : "v"(lo), "v"(hi)); return r; }

__device__ __forceinline__ bool static_tile(int i, int G, int c, int nM, int nN, int& pm, int& pn) {
    const int nwg = nM * nN; const long L = (long)i * G + c; if (L >= nwg) return false;
    int wgid = (int)L; { const int q = nwg / NXCD, r = nwg % NXCD, xcd = wgid % NXCD, off = wgid / NXCD; wgid = (xcd < r ? xcd * (q + 1) : r * (q + 1) + (xcd - r) * q) + off; }
    const int nig = WGM * nN, gid = wgid / nig, fm = gid * WGM, gsz = (nM - fm) < WGM ? (nM - fm) : WGM;
    pm = fm + ((wgid % nig) % gsz); pn = (wgid % nig) / gsz; return true;
}

template <class Epi, class Sched, bool ALIGN_EPI, bool SP2, bool GATHER, bool FP8>
__device__ __forceinline__ unsigned long long gemm_phase(PG8_LAS unsigned char* lds, const Gemm g, const Sched& S, const Epi& E) {
    unsigned long long tepi_ = 0ull;
    int tid_ = threadIdx.x; asm volatile("" : "+v"(tid_));
    const int tid = tid_, wid = __builtin_amdgcn_readfirstlane(tid >> 6), lane = tid & 63, wr = wid >> 2, wc = wid & 3, fr = lane & 15, fq = lane >> 4;
    const int K = g.KB / 2  , nt = g.KB / (BK * 2);
    unsigned voffB[2]; unsigned vA[2][2], vN[2][2]; int RA[2], CA[2];
#pragma unroll
    for (int i = 0; i < 2; ++i) { int R, C; stage_rc(tid * 16 + i * 8192, R, C); const int Rb = Epi::PERM ? ((R & ~31) + perm32(R & 31)) : R;
        RA[i] = R; CA[i] = C; voffB[i] = (unsigned)(Rb * K + C) * 2u;
#pragma unroll
        for (int h = 0; h < 2; ++h) { vA[h][i] = (unsigned)((R + h * HALF) * K + C) * 2u; vN[h][i] = vA[h][i]; } }
    const size_t kstep = (size_t)(BK * 2);
    const size_t hstep = (size_t)HALF * K * 2;
    const size_t tstep = 2 * hstep;
    const unsigned ldsw = (unsigned)wid * 1024u;
    const int aoff = lds_byte(wr * 64 + fr, fq * 8), boff = lds_byte(wc * 32 + fr, fq * 8);
#define PG8_SA(b, h) (((b) * 2 + (h)) * HTB)
#define PG8_SB(b, h) ((4 + (b) * 2 + (h)) * HTB)
#define PG8_STAGE(bufoff, gbase, voff) do { _Pragma("unroll") for (int _i = 0; _i < 2; ++_i) \
        __builtin_amdgcn_global_load_lds((const unsigned*)((const char*)(gbase) + (voff)[_i]), (PG8_LAS unsigned*)(lds + (bufoff) + ldsw + _i * 8192), 16, 0, 0); } while (0)
#define PG8_STAGEA(b, h, kptr, vv) PG8_STAGE(PG8_SA(b, h), (GATHER ? (kptr) : (kptr) + (h) * hstep), (vv)[GATHER ? (h) : 0])
#define PG8_LDA(dst, b, h) do { _Pragma("unroll") for (int m = 0; m < 4; ++m) _Pragma("unroll") for (int k = 0; k < 2; ++k) dst[m][k] = *(const PG8_LAS bf16x8*)(lds + PG8_SA(b, h) + aoff + m * 2048 + k * 1024); } while (0)
#define PG8_LDB(dst, b, h) do { _Pragma("unroll") for (int n = 0; n < 2; ++n) _Pragma("unroll") for (int k = 0; k < 2; ++k) dst[n][k] = *(const PG8_LAS bf16x8*)(lds + PG8_SB(b, h) + boff + n * 2048 + k * 1024); } while (0)
#define PG8_CAT(x) __builtin_bit_cast(i32x8, (bf16x16){x[0][0], x[0][1], x[0][2], x[0][3], x[0][4], x[0][5], x[0][6], x[0][7], x[1][0], x[1][1], x[1][2], x[1][3], x[1][4], x[1][5], x[1][6], x[1][7]})
#define PG8_MMA(ai, bj, At, Bt) do { __builtin_amdgcn_s_setprio(1); _Pragma("unroll") for (int m = 0; m < 4; ++m) _Pragma("unroll") for (int n = 0; n < 2; ++n) { \
        if constexpr (FP8) { const i32x8 a8_ = PG8_CAT(Bt[n]), b8_ = PG8_CAT(At[m]);   \
            asm volatile("v_mfma_scale_f32_16x16x128_f8f6f4 %0, %1, %2, %0, %3, %3 op_sel_hi:[0,0,0]" : "+v"(acc[ai][bj][m][n]) : "v"(a8_), "v"(b8_), "v"(sc1_)); } \
        else { _Pragma("unroll") for (int k = 0; k < 2; ++k) acc[ai][bj][m][n] = __builtin_amdgcn_mfma_f32_16x16x32_bf16(Bt[n][k], At[m][k], acc[ai][bj][m][n], 0, 0, 0); } } \
        __builtin_amdgcn_s_setprio(0); } while (0)
#define PG8_WAIT_V(n) asm volatile("s_waitcnt vmcnt(" #n ")" ::: "memory")
#define PG8_WAIT_L(n) asm volatile("s_waitcnt lgkmcnt(" #n ")" ::: "memory")
#define PG8_BAR __builtin_amdgcn_s_barrier()
#define PG8_SCHED __builtin_amdgcn_sched_barrier(0)
    Unit cur, nxt; int ui = 0;
    if (!S.next(0, cur)) return 0ull;
    typename Epi::Pre pre;
    f32x4 acc[2][2][4][2];
#pragma unroll
    for (int a = 0; a < 2; ++a)
#pragma unroll
        for (int b = 0; b < 2; ++b)
#pragma unroll
            for (int m = 0; m < 4; ++m)
#pragma unroll
                for (int n = 0; n < 2; ++n) acc[a][b][m][n] = (f32x4){0.f, 0.f, 0.f, 0.f};
    bf16x8 At[4][2], B0[2][2], B1[2][2];
    int sc1_ = 0x7F7F7F7F; asm volatile("" : "+v"(sc1_));
#define PG8_ATILE(pm_) (GATHER ? (const char*)g.A : ((pm_) >= g.pm2 ? (const char*)g.A2 + (size_t)((pm_) - g.pm2) * tstep : (const char*)g.A + (size_t)(pm_) * tstep))
    const char* cA = PG8_ATILE(cur.pm); const char* cB = (const char*)g.Bt + (size_t)cur.e * g.bstride + (size_t)cur.pn * tstep;
    if constexpr (GATHER) {
#pragma unroll
        for (int i = 0; i < 2; ++i)
#pragma unroll
            for (int h = 0; h < 2; ++h) { vA[h][i] = (unsigned)(S.row_token(cur, RA[i] + h * HALF) * K + CA[i]) * 2u; vN[h][i] = vA[h][i]; }
    }
    {
        PG8_STAGE(PG8_SB(0, 0), cB, voffB); PG8_STAGE(PG8_SB(0, 1), cB + hstep, voffB); PG8_STAGEA(0, 0, cA, vA); PG8_STAGEA(0, 1, cA, vA);
        if (wr == 1) PG8_BAR;
        PG8_WAIT_V(2); PG8_BAR;
        PG8_STAGE(PG8_SB(1, 0), cB + kstep, voffB); PG8_STAGEA(1, 0, cA + kstep, vA); PG8_STAGE(PG8_SB(1, 1), cB + hstep + kstep, voffB);
        PG8_WAIT_V(6); PG8_BAR;
    }
    for (;;) {
        const bool has_next = S.next(ui + 1, nxt);
        const char* nA = has_next ? PG8_ATILE(nxt.pm) : cA;
        const char* nB = has_next ? (const char*)g.Bt + (size_t)nxt.e * g.bstride + (size_t)nxt.pn * tstep : cB;
        if constexpr (GATHER) {
            if (has_next) {
#pragma unroll
                for (int i = 0; i < 2; ++i)
#pragma unroll
                    for (int h = 0; h < 2; ++h) vN[h][i] = (unsigned)(S.row_token(nxt, RA[i] + h * HALF) * K + CA[i]) * 2u;
            }
        }
#pragma nounroll
        for (int t = 0; t < nt; t += 2) {
            const bool last = (t == nt - 2);
            if (last) pre = E.prefetch(cur, wr, wc, fr, fq);
            const char* a1 = cA + (size_t)(t + 1) * kstep;
            const char* a2 = last ? nA : cA + (size_t)(t + 2) * kstep; const char* b2 = last ? nB : cB + (size_t)(t + 2) * kstep;
            const char* a3 = a2 + kstep; const char* b3 = b2 + kstep;
            unsigned vS[2][2];
#pragma unroll
            for (int i = 0; i < 2; ++i)
#pragma unroll
                for (int h = 0; h < 2; ++h) vS[h][i] = (GATHER && last) ? vN[h][i] : vA[h][i];
            PG8_LDB(B0, 0, 0); PG8_LDB(B1, 0, 1); PG8_SCHED; PG8_LDA(At, 0, 0); PG8_STAGEA(1, 1, a1, vA);
            PG8_WAIT_V(8); PG8_WAIT_L(0); PG8_BAR; PG8_MMA(0, 0, At, B0); PG8_MMA(0, 1, At, B1); PG8_BAR; PG8_SCHED;
            PG8_LDA(At, 0, 1); PG8_STAGE(PG8_SB(0, 0), b2, voffB); PG8_STAGE(PG8_SB(0, 1), b2 + hstep, voffB); PG8_STAGEA(0, 0, a2, vS);
            PG8_WAIT_V(8); PG8_WAIT_L(0); PG8_BAR; PG8_MMA(1, 0, At, B0); PG8_MMA(1, 1, At, B1); PG8_BAR; PG8_SCHED;
            PG8_LDB(B0, 1, 0); PG8_LDB(B1, 1, 1); PG8_SCHED; PG8_LDA(At, 1, 0); PG8_STAGEA(0, 1, a2, vS);
            PG8_WAIT_V(8); PG8_WAIT_L(0); PG8_BAR; PG8_MMA(0, 0, At, B0); PG8_MMA(0, 1, At, B1); PG8_BAR; PG8_SCHED;
            PG8_LDA(At, 1, 1); PG8_STAGE(PG8_SB(1, 0), b3, voffB); PG8_STAGE(PG8_SB(1, 1), b3 + hstep, voffB); PG8_STAGEA(1, 0, a3, vS);
            PG8_WAIT_V(8); PG8_WAIT_L(0); PG8_BAR; PG8_MMA(1, 0, At, B0); PG8_MMA(1, 1, At, B1); PG8_BAR; PG8_SCHED;
        }
        if constexpr (ALIGN_EPI) { if (wr == 0) PG8_BAR; }
        if constexpr (FP8) asm volatile("s_nop 15\n\ts_nop 7" ::: "memory");
#ifdef PROBE_EPI
        const unsigned long long te0_ = __builtin_amdgcn_s_memrealtime();
#endif
        E(acc, cur, wr, wc, fr, fq, pre);
#ifdef PROBE_EPI
        tepi_ += __builtin_amdgcn_s_memrealtime() - te0_;
#endif
        if (!has_next) break;
#pragma unroll
        for (int a = 0; a < 2; ++a)
#pragma unroll
            for (int b = 0; b < 2; ++b)
#pragma unroll
                for (int m = 0; m < 4; ++m)
#pragma unroll
                    for (int n = 0; n < 2; ++n) acc[a][b][m][n] = (f32x4){0.f, 0.f, 0.f, 0.f};
        cur = nxt; cA = nA; cB = nB; ++ui;
#pragma unroll
        for (int i = 0; i < 2; ++i)
#pragma unroll
            for (int h = 0; h < 2; ++h) vA[h][i] = vN[h][i];
        if constexpr (ALIGN_EPI) { if (wr == 1) PG8_BAR; }
    }
    PG8_WAIT_V(0);
    if constexpr (!ALIGN_EPI) { if (wr == 0) PG8_BAR; }
    PG8_BAR;
    return tepi_;
#undef PG8_SA
#undef PG8_SB
#undef PG8_STAGE
#undef PG8_STAGEA
#undef PG8_LDA
#undef PG8_LDB
#undef PG8_MMA
#undef PG8_ATILE
#undef PG8_CAT
#undef PG8_WAIT_V
#undef PG8_WAIT_L
#undef PG8_BAR
#undef PG8_SCHED
}
}
namespace pg8 {
constexpr int LIST_CAP = 16384;

struct TileOrder {
    int nM, nN, G, c, xM0, xN0, xM, xN;
    __device__ __forceinline__ bool next(int i, Unit& u) const {
        int pm, pn; u.e = 0; u.lt = 0; u.cnt = 0;
        if (static_tile(i, G, c, nM, nN, pm, pn)) { u.pm = pm; u.pn = pn; return true; }
        const long L = (long)i * G + c - (long)nM * nN;
        if (L < (long)xM * xN) { u.pm = xM0 + (int)(L % xM); u.pn = xN0 + (int)(L / xM); return true; }
        return false;
    }
    __device__ __forceinline__ int row_token(const Unit& u, int r) const { return u.pm * BM + r; }    __device__ __forceinline__ int row_token_raw(const Unit& u, int r) const { return u.pm * BM + r; }
    __device__ __forceinline__ int row_token_fix(const Unit&, int, int raw) const { return raw; }
};

struct GroupedOrder {
    int G, c, nN, ntiles; const PG8_LAS int* tab; const int* list; bool dense;
    __device__ __forceinline__ void init(int G_, int c_, int nN_, PG8_LAS int* tab_, const unsigned* counts, const int* list_) { G = G_; c = c_; nN = nN_; tab = tab_; list = list_; dense = (counts == nullptr);
        __syncthreads();
        if (threadIdx.x == 0) { int t = 0;
            for (int e = 0; e < N_EXPERTS; ++e) { int n = dense ? (e == 0 ? M_TOK : 0) : (int)__hip_atomic_load(counts + e, __ATOMIC_RELAXED, __HIP_MEMORY_SCOPE_AGENT); n = n > LIST_CAP ? LIST_CAP : n; tab_[16 + e] = n; tab_[e] = t; t += (n + BM - 1) / BM; }
            tab_[N_EXPERTS] = t; }
        __syncthreads();
        ntiles = __builtin_amdgcn_readfirstlane(tab_[N_EXPERTS]); }
    __device__ __forceinline__ bool next(int i, Unit& u) const {
        int pm, pn; if (!static_tile(i, G, c, ntiles, nN, pm, pn)) return false;
        int e = 0;
#pragma unroll
        for (int j = 1; j < N_EXPERTS; ++j) e += (pm >= tab[j]) ? 1 : 0;
        e = __builtin_amdgcn_readfirstlane(e);
        u.pm = pm; u.pn = pn; u.e = e; u.lt = pm - __builtin_amdgcn_readfirstlane(tab[e]); u.cnt = __builtin_amdgcn_readfirstlane(tab[16 + e]); return true;
    }
    __device__ __forceinline__ int row_token(const Unit& u, int r) const { const int pos = u.lt * BM + r; if (dense) return pos; return pos < u.cnt ? list[u.e * LIST_CAP + pos] : 0; }    __device__ __forceinline__ int row_token_raw(const Unit& u, int r) const { const int pos = u.lt * BM + r; if (dense) return pos; return list[u.e * LIST_CAP + (pos < u.cnt ? pos : 0)]; }
    __device__ __forceinline__ int row_token_fix(const Unit& u, int r, int raw) const { const int pos = u.lt * BM + r; return (dense || pos < u.cnt) ? raw : 0; }
};

__device__ __forceinline__ float silu_f(float x) { return x * __builtin_amdgcn_rcpf(1.0f + __builtin_amdgcn_exp2f(x * -1.4426950408889634f)); }
__device__ __forceinline__ float logsigmoid_f(float z) { const float a = fabsf(z); return fminf(z, 0.f) - 0.6931471805599453f * __builtin_amdgcn_logf(1.0f + __builtin_amdgcn_exp2f(a * -1.4426950408889634f)); }

struct EpiInProj {
    static constexpr bool PERM = true;
    unsigned char* ws; const float* fbias; const float* gains; const float* SSA;
    struct Pre {};
    __device__ __forceinline__ Pre prefetch(const Unit&, int, int, int, int) const { return Pre{}; }
    __device__ __forceinline__ void operator()(const f32x4 (&acc)[2][2][4][2], const Unit& u, int wr, int wc, int fr, int fq, const Pre&) const {
        const int pn = u.pn; const int row0 = u.pm * BM + wr * 64 + fr;
        float rs[2][4];
#pragma unroll
        for (int ai = 0; ai < 2; ++ai)
#pragma unroll
            for (int m = 0; m < 4; ++m) { rs[ai][m] = 1.0f; if (u.pm < M_TOK / BM) { const f32x4 p = *(const f32x4*)(SSA + (size_t)(row0 + ai * HALF + m * 16) * 4); rs[ai][m] = __builtin_amdgcn_rsqf(((p[0] + p[1]) + (p[2] + p[3])) * (1.0f / D_MODEL) + EPS); } }
        if (pn <= 1) {
            bf16_t* dst = (bf16_t*)(ws + (pn == 0 ? WS_RQ : WS_RK)); const float sc = pn == 0 ? 0.125f : 1.0f;
            float invf[2][4];
#pragma unroll
            for (int n = 0; n < 2; ++n)
#pragma unroll
                for (int j = 0; j < 4; ++j) invf[n][j] = exp2f(-(float)(8 * fq + 4 * n + j) * (13.287712379549449f / 32.0f)) * 0.15915494309189535f;
#pragma unroll
            for (int ai = 0; ai < 2; ++ai)
#pragma unroll
                for (int m = 0; m < 4; ++m) { const int row = row0 + ai * HALF + m * 16; const float pos = (float)(row & (SEQ - 1));
                    float y1[8], y2[8];
#pragma unroll
                    for (int n = 0; n < 2; ++n)
#pragma unroll
                        for (int j = 0; j < 4; ++j) { const float pr = pos * invf[n][j]; const float rf = __builtin_amdgcn_fractf(pr) + __builtin_fmaf(pos, invf[n][j], -pr);
                            const float cs = __builtin_amdgcn_cosf(rf), sn = __builtin_amdgcn_sinf(rf); const float x1 = acc[ai][0][m][n][j] * rs[ai][m], x2 = acc[ai][1][m][n][j] * rs[ai][m];
                            y1[n * 4 + j] = (x1 * cs - x2 * sn) * sc; y2[n * 4 + j] = (x2 * cs + x1 * sn) * sc; }
                    bf16_t* rowp = dst + (size_t)row * 256 + 64 * wc + 8 * fq;
                    u32x4 w; w.x = cvt_pk_bf16(y1[0], y1[1]); w.y = cvt_pk_bf16(y1[2], y1[3]); w.z = cvt_pk_bf16(y1[4], y1[5]); w.w = cvt_pk_bf16(y1[6], y1[7]); *(u32x4*)rowp = w;
                    w.x = cvt_pk_bf16(y2[0], y2[1]); w.y = cvt_pk_bf16(y2[2], y2[3]); w.z = cvt_pk_bf16(y2[4], y2[5]); w.w = cvt_pk_bf16(y2[6], y2[7]); *(u32x4*)(rowp + 32) = w; }
        } else if (pn == 6 || pn == 7 || pn == 9 || pn == 11) {
            const size_t doff = pn == 6 ? WS_FQ : pn == 7 ? WS_FK : pn == 9 ? WS_MQ : WS_MK; const int gi = pn == 6 ? 0 : pn == 7 ? 1 : pn == 9 ? 2 : 3;
            bf16_t* dst = (bf16_t*)(ws + doff); const float* gp = gains + gi * 64;
            const float sc = (pn == 6 || pn == 9) ? (0.125f * 1.4426950408889634f) : 1.0f; const int rsub = pn == 11 ? M_TOK : 0;
            f32x4 gv[2][2];
#pragma unroll
            for (int bj = 0; bj < 2; ++bj)
#pragma unroll
                for (int n = 0; n < 2; ++n) gv[bj][n] = *(const f32x4*)(gp + 32 * bj + 8 * fq + 4 * n) * sc;
#pragma unroll
            for (int ai = 0; ai < 2; ++ai)
#pragma unroll
                for (int m = 0; m < 4; ++m) { const int row = row0 + ai * HALF + m * 16 - rsub; float ss = 0.f;
#pragma unroll
                    for (int bj = 0; bj < 2; ++bj)
#pragma unroll
                        for (int n = 0; n < 2; ++n) { const f32x4 x = acc[ai][bj][m][n] * rs[ai][m]; ss += (x[0] * x[0] + x[1] * x[1]) + (x[2] * x[2] + x[3] * x[3]); }
                    ss += __shfl_xor(ss, 16); ss += __shfl_xor(ss, 32);
                    const float rstd = rs[ai][m] * __builtin_amdgcn_rsqf(ss * (1.0f / 64.0f) + EPS);
                    bf16_t* rowp = dst + (size_t)row * 256 + 64 * wc + 8 * fq;
#pragma unroll
                    for (int bj = 0; bj < 2; ++bj) { const f32x4 v0 = acc[ai][bj][m][0] * rstd * gv[bj][0], v1 = acc[ai][bj][m][1] * rstd * gv[bj][1];
                        u32x4 w; w.x = cvt_pk_bf16(v0[0], v0[1]); w.y = cvt_pk_bf16(v0[2], v0[3]); w.z = cvt_pk_bf16(v1[0], v1[1]); w.w = cvt_pk_bf16(v1[2], v1[3]); *(u32x4*)(rowp + 32 * bj) = w; } }
        } else if (pn == 10) {
            if (wc == 0 && fq == 0) {
                const f32x4 bv = *(const f32x4*)fbias; float* LOGF = (float*)(ws + WS_LOGF);
#pragma unroll
                for (int ai = 0; ai < 2; ++ai)
#pragma unroll
                    for (int m = 0; m < 4; ++m) { const int row = row0 + ai * HALF + m * 16; const int b = row >> 13, t = row & (SEQ - 1);
#pragma unroll
                        for (int j = 0; j < 4; ++j) LOGF[(size_t)(b * 4 + j) * SEQ + t] = logsigmoid_f(acc[ai][0][m][0][j] * rs[ai][m] + bv[j]); }
            }
        } else {
            size_t doff; int ldc, ct, rsub = 0; bool act = false;
            if (pn <= 3) { doff = WS_RV; ldc = 512; ct = pn - 2; } else if (pn <= 5) { doff = WS_RG; ldc = 512; ct = pn - 4; act = true; } else if (pn == 8) { doff = WS_FV; ldc = 256; ct = 0; } else { doff = WS_MV; ldc = 256; ct = 0; rsub = M_TOK; }
            bf16_t* dst = (bf16_t*)(ws + doff);
#pragma unroll
            for (int ai = 0; ai < 2; ++ai)
#pragma unroll
                for (int m = 0; m < 4; ++m) { const int row = row0 + ai * HALF + m * 16 - rsub; bf16_t* rowp = dst + (size_t)row * ldc + ct * 256 + 32 * wc + 8 * fq;
#pragma unroll
                    for (int bj = 0; bj < 2; ++bj) { f32x4 v0 = acc[ai][bj][m][0] * rs[ai][m], v1 = acc[ai][bj][m][1] * rs[ai][m];
                        if (act) {
#pragma unroll
                            for (int j = 0; j < 4; ++j) { v0[j] = silu_f(v0[j]); v1[j] = silu_f(v1[j]); } }
                        u32x4 w; w.x = cvt_pk_bf16(v0[0], v0[1]); w.y = cvt_pk_bf16(v0[2], v0[3]); w.z = cvt_pk_bf16(v1[0], v1[1]); w.w = cvt_pk_bf16(v1[2], v1[3]); *(u32x4*)(rowp + bj * HALF) = w; } }
        }
    }
};

__device__ __forceinline__ float bf_lo(unsigned w) { return __uint_as_float(w << 16); }
__device__ __forceinline__ float bf_hi(unsigned w) { return __uint_as_float(w & 0xffff0000u); }
__device__ __forceinline__ unsigned pk4_fp8(float a, float b, float c, float d) {
    a = __builtin_amdgcn_fmed3f(a, -448.f, 448.f); b = __builtin_amdgcn_fmed3f(b, -448.f, 448.f); c = __builtin_amdgcn_fmed3f(c, -448.f, 448.f); d = __builtin_amdgcn_fmed3f(d, -448.f, 448.f);
    int p = __builtin_amdgcn_cvt_pk_fp8_f32(a, b, 0, false); p = __builtin_amdgcn_cvt_pk_fp8_f32(c, d, p, true); return (unsigned)p; }

struct EpiDown {
    static constexpr bool PERM = true;
    bf16_t* XB; float* SS; bf16_t* YD; unsigned xl_off; bool moe; float dsc;
    bool route; unsigned char* X8; const bf16_t* WRT; float* LOGP;
    struct Pre {};
    __device__ __forceinline__ Pre prefetch(const Unit&, int, int, int, int) const { return Pre{}; }
    __device__ __forceinline__ void operator()(const f32x4 (&acc)[2][2][4][2], const Unit& u, int wr, int wc, int fr, int fq, const Pre&) const {
        const int row0 = u.pm * BM + wr * 64 + fr, col0 = u.pn * BM + wc * 32 + 8 * fq;
        if (moe) {
#pragma unroll
            for (int ai = 0; ai < 2; ++ai)
#pragma unroll
                for (int m = 0; m < 4; ++m) { bf16_t* rowp = YD + (size_t)(row0 + ai * HALF + m * 16) * D_MODEL + col0;
#pragma unroll
                    for (int bj = 0; bj < 2; ++bj) { const f32x4 v0 = acc[ai][bj][m][0] * dsc, v1 = acc[ai][bj][m][1] * dsc;
                        u32x4 w; w.x = cvt_pk_bf16(v0[0], v0[1]); w.y = cvt_pk_bf16(v0[2], v0[3]); w.z = cvt_pk_bf16(v1[0], v1[1]); w.w = cvt_pk_bf16(v1[2], v1[3]); *(u32x4*)(rowp + bj * HALF) = w; } }
        } else {
        bf16x8 wa[2];
        if (route) {
#pragma unroll
            for (int bj = 0; bj < 2; ++bj) wa[bj] = *(const bf16x8*)(WRT + (size_t)fr * D_MODEL + u.pn * BM + bj * HALF + wc * 32 + 8 * fq); }
#pragma unroll
        for (int ai = 0; ai < 2; ++ai)
#pragma unroll
            for (int m = 0; m < 4; ++m) { bf16_t* rowp = XB + (size_t)(row0 + ai * HALF + m * 16) * D_MODEL + col0; float ss = 0.f; f32x4 lacc = (f32x4){0.f, 0.f, 0.f, 0.f};
#pragma unroll
                for (int bj = 0; bj < 2; ++bj) { const u32x4 xb = *(const u32x4*)(rowp + bj * HALF); f32x4 v0 = acc[ai][bj][m][0] * dsc, v1 = acc[ai][bj][m][1] * dsc;
                    v0[0] += bf_lo(xb.x); v0[1] += bf_hi(xb.x); v0[2] += bf_lo(xb.y); v0[3] += bf_hi(xb.y); v1[0] += bf_lo(xb.z); v1[1] += bf_hi(xb.z); v1[2] += bf_lo(xb.w); v1[3] += bf_hi(xb.w);
                    ss += ((v0[0] * v0[0] + v0[1] * v0[1]) + (v0[2] * v0[2] + v0[3] * v0[3])) + ((v1[0] * v1[0] + v1[1] * v1[1]) + (v1[2] * v1[2] + v1[3] * v1[3]));
                    u32x4 w; w.x = cvt_pk_bf16(v0[0], v0[1]); w.y = cvt_pk_bf16(v0[2], v0[3]); w.z = cvt_pk_bf16(v1[0], v1[1]); w.w = cvt_pk_bf16(v1[2], v1[3]); *(u32x4*)(rowp + bj * HALF) = w;
                    if (route) { typedef unsigned u32x2r __attribute__((ext_vector_type(2))); u32x2r w8; w8.x = pk4_fp8(v0[0] * SA_HB, v0[1] * SA_HB, v0[2] * SA_HB, v0[3] * SA_HB); w8.y = pk4_fp8(v1[0] * SA_HB, v1[1] * SA_HB, v1[2] * SA_HB, v1[3] * SA_HB);
                        *(u32x2r*)(X8 + (size_t)(row0 + ai * HALF + m * 16) * D_MODEL + col0 + bj * HALF) = w8;
                        lacc = __builtin_amdgcn_mfma_f32_16x16x32_bf16(wa[bj], __builtin_bit_cast(bf16x8, w), lacc, 0, 0, 0); } }
                if (route && fq < 2) *(f32x4*)(LOGP + ((size_t)(row0 + ai * HALF + m * 16) * 16 + u.pn * 4 + wc) * 8 + 4 * fq) = lacc;
                ss += __shfl_xor(ss, 16); ss += __shfl_xor(ss, 32);
                if (fq == 0) ((PG8_LAS float*)(size_t)xl_off)[(ai * HALF + wr * 64 + m * 16 + fr) * 4 + wc] = ss;
                if (m & 1) asm volatile("" ::: "memory"); }
#ifndef T_NOEXCH
        asm volatile("s_waitcnt lgkmcnt(0)" ::: "memory"); __builtin_amdgcn_s_barrier(); asm volatile("" ::: "memory");
        { const int t = threadIdx.x; if (t < BM) { const f32x4 p = *(const PG8_LAS f32x4*)((PG8_LAS float*)(size_t)xl_off + t * 4); SS[(size_t)(u.pm * BM + t) * 4 + u.pn] = (p[0] + p[1]) + (p[2] + p[3]); } }
        asm volatile("s_waitcnt lgkmcnt(0)" ::: "memory"); __builtin_amdgcn_s_barrier(); asm volatile("" ::: "memory");
#endif
        }
    }
};

template <bool A8> struct EpiSwiGLU {
    static constexpr bool PERM = true;
    unsigned char* HF; const float* SSF; const float* RSS; bool dense;
    struct Pre {};
    __device__ __forceinline__ Pre prefetch(const Unit&, int, int, int, int) const { return Pre{}; }
    __device__ __forceinline__ void operator()(const f32x4 (&acc)[2][2][4][2], const Unit& u, int wr, int wc, int fr, int fq, const Pre&) const {
        const int row0 = u.pm * BM + wr * 64 + fr, col0 = u.pn * HALF + wc * 32 + 8 * fq;
        float rs[2][4];
        if constexpr (A8) {
#pragma unroll
            for (int ai = 0; ai < 2; ++ai)
#pragma unroll
                for (int m = 0; m < 4; ++m) { const int pos = u.lt * BM + ai * HALF + wr * 64 + m * 16 + fr; rs[ai][m] = RSS[u.e * LIST_CAP + (pos < u.cnt ? pos : 0)] * (1.0f / (SA_HB * SW_GU)); }
        } else if (dense) {
#pragma unroll
            for (int ai = 0; ai < 2; ++ai)
#pragma unroll
                for (int m = 0; m < 4; ++m) { const f32x4 p = *(const f32x4*)(SSF + (size_t)(row0 + ai * HALF + m * 16) * 4); rs[ai][m] = __builtin_amdgcn_rsqf(((p[0] + p[1]) + (p[2] + p[3])) * (1.0f / D_MODEL) + EPS); }
        } else {
#pragma unroll
            for (int ai = 0; ai < 2; ++ai)
#pragma unroll
                for (int m = 0; m < 4; ++m) { const int pos = u.lt * BM + ai * HALF + wr * 64 + m * 16 + fr; rs[ai][m] = RSS[u.e * LIST_CAP + (pos < u.cnt ? pos : 0)]; }
        }
#pragma unroll
        for (int ai = 0; ai < 2; ++ai)
#pragma unroll
            for (int m = 0; m < 4; ++m) { const float r = rs[ai][m]; float h[8];
#pragma unroll
                for (int n = 0; n < 2; ++n)
#pragma unroll
                    for (int j = 0; j < 4; ++j) h[n * 4 + j] = silu_f(acc[ai][0][m][n][j] * r) * (acc[ai][1][m][n][j] * r) * (FP8_DN ? SA_HF : 1.0f);
                const size_t ro = (size_t)(row0 + ai * HALF + m * 16) * FFP + col0;
                if constexpr (FP8_DN) { typedef unsigned u32x2 __attribute__((ext_vector_type(2))); u32x2 w; w.x = pk4_fp8(h[0], h[1], h[2], h[3]); w.y = pk4_fp8(h[4], h[5], h[6], h[7]); *(u32x2*)(HF + ro) = w; }
                else { u32x4 w; w.x = cvt_pk_bf16(h[0], h[1]); w.y = cvt_pk_bf16(h[2], h[3]); w.z = cvt_pk_bf16(h[4], h[5]); w.w = cvt_pk_bf16(h[6], h[7]); *(u32x4*)((bf16_t*)HF + ro) = w; } }
    }
};
}
namespace attn_body {
#ifdef T_NOMASK
constexpr bool defined_nomask=true;
#else
constexpr bool defined_nomask=false;
#endif
#ifdef T_NOBIAS
constexpr bool defined_nobias=true;
#else
constexpr bool defined_nobias=false;
#endif
using bf16=__hip_bfloat16;
using bf16x8=__attribute__((ext_vector_type(8)))short;
using s16x4=__attribute__((ext_vector_type(4)))short;
using f32x16=__attribute__((ext_vector_type(16)))float;
using u32x4=__attribute__((ext_vector_type(4)))unsigned;
using f32x4v=__attribute__((ext_vector_type(4)))float;
constexpr int BATCH=2,NHEAD=4,SEQ=8192,D=64,DM=NHEAD*D,KVMEM=256,YP=1024;
constexpr int NW=8,QBLK=32,QB=QBLK*NW,KVBLK=64,NQB=SEQ/QB;
constexpr int ATTN_PITCH=DM, ATTN_UNIT_ROWS=QB;
__device__ __forceinline__ int crow(int r,int hi){return (r&3)+8*(r>>2)+4*hi;}
__device__ __forceinline__ unsigned f2bf_a(float f){ unsigned u=__builtin_bit_cast(unsigned,f); return (u+0x7fffu+((u>>16)&1u))>>16; }
#define SBAR() __builtin_amdgcn_sched_barrier(0)
__device__ __forceinline__ void cmask(f32x16&p0,f32x16&p1,int jb,int qrel,int hi){
  int dd=qrel-(64*jb+4*hi); asm volatile("":"+v"(dd));
  #pragma unroll
  for(int r=0;r<16;++r){const int c=(r&3)+8*(r>>2);
    const unsigned t0=(((unsigned)(dd-c))&0x80000000u)|0x7F800000u, t1=(((unsigned)(dd-c-32))&0x80000000u)|0x7F800000u;
    p0[r]=__builtin_fminf(p0[r],__uint_as_float(t0)); p1[r]=__builtin_fminf(p1[r],__uint_as_float(t1));}
}

constexpr int NSLOT=3, SLOTB=8192;
constexpr int LDS_K=0, LDS_V=NSLOT*SLOTB, LDS_WS=2*NSLOT*SLOTB, LDS_OST=LDS_WS+NW*64*4, LDS_CB=LDS_OST+NW*4096, LDS_CBZ=LDS_CB+SEQ*8, LDS_BYTES=LDS_CBZ+16;
constexpr float C2=0.125f*1.4426950408889634f;
__device__ __forceinline__ void glds16(const void*gsrc,unsigned lds_dst){unsigned keep;
  asm volatile("s_mov_b32 %0, m0\n\ts_mov_b32 m0, %2\n\ts_nop 0\n\tglobal_load_lds_dwordx4 %1, off\n\ts_mov_b32 m0, %0":"=&s"(keep):"v"(gsrc),"s"(lds_dst):"memory");}
__device__ __forceinline__ float max3f(float a,float b,float c){float r;asm("v_max3_f32 %0, %1, %2, %3":"=v"(r):"v"(a),"v"(b),"v"(c));return r;}
__device__ __forceinline__ float max2f(float a,float b){float r;asm("v_max_f32_e32 %0, %1, %2":"=v"(r):"v"(a),"v"(b));return r;}
__device__ __forceinline__ float fadd_s(float a,float b){float r;asm("v_add_f32_e32 %0, %1, %2":"=v"(r):"v"(a),"v"(b));return r;}
__device__ __forceinline__ float fsub_s(float a,float b){float r;asm("v_sub_f32_e32 %0, %1, %2":"=v"(r):"v"(a),"v"(b));return r;}
typedef float f32x2_t __attribute__((ext_vector_type(2))); typedef __bf16 bf16x2_t __attribute__((ext_vector_type(2)));
__device__ __forceinline__ unsigned cvtpk_s(float lo,float hi){f32x2_t v={lo,hi};bf16x2_t b=__builtin_convertvector(v,bf16x2_t);return __builtin_bit_cast(unsigned,b);}
#define WAIT_BAR(N) asm volatile("s_waitcnt vmcnt(" #N ") lgkmcnt(0)\n\ts_barrier":::"memory")

__device__ __forceinline__ void qkt(f32x16&p0,f32x16&p1,const char*Kslot,const bf16x8*qr,const f32x16&c0,const f32x16&c1,int r32,int hi){
  const char*kb=Kslot+hi*1024+r32*16;
  #pragma unroll
  for(int d0=0;d0<4;++d0){
    const bf16x8 b0=*reinterpret_cast<const bf16x8*>(kb+d0*2048);
    const bf16x8 b1=*reinterpret_cast<const bf16x8*>(kb+d0*2048+512);
    if(d0==0){p0=__builtin_amdgcn_mfma_f32_32x32x16_bf16(b0,qr[0],c0,0,0,0);p1=__builtin_amdgcn_mfma_f32_32x32x16_bf16(b1,qr[0],c1,0,0,0);}
    else{p0=__builtin_amdgcn_mfma_f32_32x32x16_bf16(b0,qr[d0],p0,0,0,0);p1=__builtin_amdgcn_mfma_f32_32x32x16_bf16(b1,qr[d0],p1,0,0,0);}}
}
typedef __attribute__((address_space(3))) const char* lds_cptr;
typedef short v4i16_t __attribute__((ext_vector_type(4)));
__device__ __forceinline__ void kload8(bf16x8*kf,lds_cptr kp){
  kf[0]=*(const __attribute__((address_space(3))) bf16x8*)(kp);      kf[1]=*(const __attribute__((address_space(3))) bf16x8*)(kp+512);
  kf[2]=*(const __attribute__((address_space(3))) bf16x8*)(kp+2048); kf[3]=*(const __attribute__((address_space(3))) bf16x8*)(kp+2560);
  kf[4]=*(const __attribute__((address_space(3))) bf16x8*)(kp+4096); kf[5]=*(const __attribute__((address_space(3))) bf16x8*)(kp+4608);
  kf[6]=*(const __attribute__((address_space(3))) bf16x8*)(kp+6144); kf[7]=*(const __attribute__((address_space(3))) bf16x8*)(kp+6656);
}
__device__ __forceinline__ void kload2(bf16x8*kf,lds_cptr kp,int j){ kf[2*j]=*(const __attribute__((address_space(3))) bf16x8*)(kp+j*2048); kf[2*j+1]=*(const __attribute__((address_space(3))) bf16x8*)(kp+j*2048+512); }
__device__ __forceinline__ s16x4 vtr(lds_cptr p){ return __builtin_bit_cast(s16x4,__builtin_amdgcn_ds_read_tr16_b64_v4i16((__attribute__((address_space(3))) v4i16_t*)p)); }
__device__ __forceinline__ float rowmax(const f32x16&p0,const f32x16&p1){
  float a=max3f(p0[0],p0[1],p1[0]),b=max3f(p0[2],p0[3],p1[1]);a=max3f(a,p1[2],p1[3]);
  #pragma unroll
  for(int r=4;r<16;r+=4){a=max3f(a,p0[r],p0[r+1]);b=max3f(b,p0[r+2],p0[r+3]);a=max3f(a,p1[r],p1[r+1]);b=max3f(b,p1[r+2],p1[r+3]);}
  const float m=max2f(a,b);
  auto rr=__builtin_amdgcn_permlane32_swap(__float_as_uint(m),__float_as_uint(m),false,false);
  return max2f(__uint_as_float(rr[0]),__uint_as_float(rr[1]));
}
__device__ __forceinline__ void pv(f32x16*o,int vb,bf16x8 pa0,bf16x8 pa1,bf16x8 pa2,bf16x8 pa3){
  #pragma unroll
  for(int d0=0;d0<2;++d0){s16x4 lo[4],hi[4];
    #pragma unroll
    for(int ks=0;ks<4;++ks){
      asm volatile("ds_read_b64_tr_b16 %0,%1 offset:%c2":"=&v"(lo[ks]):"v"(vb),"i"(d0*4096+ks*1024):"memory");
      asm volatile("ds_read_b64_tr_b16 %0,%1 offset:%c2":"=&v"(hi[ks]):"v"(vb),"i"(d0*4096+ks*1024+512):"memory");}
    asm volatile("s_waitcnt lgkmcnt(0)":::"memory");SBAR();
    #define PK(k) (bf16x8){lo[k][0],lo[k][1],lo[k][2],lo[k][3],hi[k][0],hi[k][1],hi[k][2],hi[k][3]}
    o[d0]=__builtin_amdgcn_mfma_f32_32x32x16_bf16(pa0,PK(0),o[d0],0,0,0);
    o[d0]=__builtin_amdgcn_mfma_f32_32x32x16_bf16(pa1,PK(1),o[d0],0,0,0);
    o[d0]=__builtin_amdgcn_mfma_f32_32x32x16_bf16(pa2,PK(2),o[d0],0,0,0);
    o[d0]=__builtin_amdgcn_mfma_f32_32x32x16_bf16(pa3,PK(3),o[d0],0,0,0);
    #undef PK
  }
}

#ifndef ATTN_STORE16
#define ATTN_STORE16(p,v) (*(u32x4*)(p)=(v))
#endif
template<int THRL,bool FOX> __device__ __forceinline__ void attn_unit(int b,int h,int qb,const bf16*Q,const bf16*__restrict__ K,const bf16*__restrict__ V,bf16*Y,int ycol0,const float*__restrict__ gout,const float*__restrict__ cbg,const float*__restrict__ gqk,char*shm){
  int tid_=threadIdx.x; asm volatile("":"+v"(tid_));
  const int tid=tid_,lane=tid&63,r32=lane&31,hi=lane>>5; const int wid=__builtin_amdgcn_readfirstlane(tid>>6);
  const long rowbase=(long)b*SEQ; const long kvbase=FOX?rowbase:(long)b*KVMEM; const int q0=qb*QB;
  const bf16*Qw=Q+(rowbase+q0+wid*QBLK)*DM+h*D;
  int t0=0;
  if(FOX){ float gq=fabsf(gqk[lane]),gk=fabsf(gqk[64+lane]);
    #pragma unroll
    for(int o=1;o<64;o<<=1){ gq=fmaxf(gq,__shfl_xor(gq,o)); gk=fmaxf(gk,__shfl_xor(gk,o)); }
    const float margin=2.04f*(8.0f*1.4426950408889634f)*gq*gk+40.0f; const float thr=cbg[q0]+margin; const int ntf=(q0+QB)/KVBLK-4; int cnt=0;
    for(int tt=lane;tt<ntf;tt+=64) cnt+=(cbg[64*tt+63]>=thr)?1:0;
    #pragma unroll
    for(int o=1;o<64;o<<=1) cnt+=__shfl_xor(cnt,o);
    t0=__builtin_amdgcn_readfirstlane(cnt)&~1; }
  const bf16*Kh=K+(kvbase+64*t0)*DM+h*D,*Vh=V+(kvbase+64*t0)*DM+h*D;
  const unsigned lds0=(unsigned)(uintptr_t)shm;
  float*wsf=(float*)(shm+LDS_WS)+wid*64;
  const bf16*ksrc=Kh+(long)lane*DM+wid*8;
  const bf16*vsrc=Vh+(long)(16*(wid&3)+(lane>>2))*DM+(wid>>2)*32+(lane&3)*8;
  const unsigned kdst=lds0+LDS_K+wid*1024, vdst=lds0+LDS_V+wid*1024;
  #define DMA_K(t,slot) glds16(ksrc+(long)(t)*KVBLK*DM,(unsigned)__builtin_amdgcn_readfirstlane(kdst+(slot)))
  #define DMA_V(t,slot) glds16(vsrc+(long)(t)*KVBLK*DM,(unsigned)__builtin_amdgcn_readfirstlane(vdst+(slot)))
  const int vb0=(int)(lds0+LDS_V)+((lane>>4)&1)*32+(lane&3)*8+(4*hi+((lane&15)>>2))*64;
  const char*Kbase=shm+LDS_K; bf16x8 kf[8];
  const lds_cptr shm3=(lds_cptr)shm; const lds_cptr kp0=shm3+LDS_K+hi*1024+r32*16; const lds_cptr vp0=shm3+LDS_V+((lane>>4)&1)*32+(lane&3)*8+(4*hi+((lane&15)>>2))*64;
  const int NT=FOX?(q0+QB)/KVBLK-t0:KVMEM/KVBLK;
  const int qrel=wid*QBLK+r32;
  typedef __attribute__((address_space(3))) unsigned long long lds_u64;
  float cbq=0.f; unsigned bkbase=0u, bkstep=0u;
  if(FOX){ lds_u64*tb=(lds_u64*)((__attribute__((address_space(3))) char*)shm+LDS_CB); const int ncb=q0+QB-64*t0; const float*cbt=cbg+64*t0;
    for(int i=tid;i<ncb;i+=NW*64){ const float x=-cbt[i]; const unsigned h_=f2bf_a(x); const float r1=x-__uint_as_float(h_<<16); const unsigned m_=f2bf_a(r1); const float r2=r1-__uint_as_float(m_<<16); const unsigned l_=f2bf_a(r2);
      tb[i]=(unsigned long long)(h_|(m_<<16))|((unsigned long long)l_<<32); }
    if(tid==0){ unsigned long long z_=0ull; asm volatile("":"+v"(z_)); tb[SEQ]=z_; tb[SEQ+1]=z_; }
    cbq=cbg[q0+qrel];
    asm volatile("s_waitcnt vmcnt(0) lgkmcnt(0)\n\ts_barrier":::"memory");
    bkbase=hi?(unsigned)(LDS_CBZ):(unsigned)(LDS_CB+r32*8); bkstep=hi?0u:512u; }
  const bf16x8 qone=(bf16x8){(short)0x3F80,(short)0x3F80,(short)0x3F80,(short)0x3F80,(short)0x3F80,(short)0x3F80,(short)0x3F80,(short)0x3F80};
  #define LOADBK(B0,B1,t) do{ const lds_cptr bp_=(lds_cptr)shm+bkbase+(unsigned)(t)*bkstep; const unsigned long long x0_=*(const __attribute__((address_space(3))) unsigned long long*)bp_, x1_=*(const __attribute__((address_space(3))) unsigned long long*)(bp_+(hi?0:256)); \
    B0=__builtin_bit_cast(bf16x8,(u32x4){(unsigned)x0_,(unsigned)(x0_>>32),0u,0u}); B1=__builtin_bit_cast(bf16x8,(u32x4){(unsigned)x1_,(unsigned)(x1_>>32),0u,0u}); }while(0)
  DMA_K(0,0);DMA_V(0,0);DMA_K(1,SLOTB);
  bf16x8 qr[4];
  #pragma unroll
  for(int d0=0;d0<4;++d0)qr[d0]=*reinterpret_cast<const bf16x8*>(&Qw[(long)r32*DM+d0*16+hi*8]);
  typedef __attribute__((address_space(3))) bf16x8 lds_bf8; lds_bf8*qst=(lds_bf8*)((__attribute__((address_space(3))) char*)shm+LDS_OST+wid*4096)+lane;
  if(FOX){
  #pragma unroll
  for(int d0=0;d0<4;++d0)qst[d0*64]=qr[d0]; }
  #define QL(i) (*(qst+(i)*64))
  float mhat=-cbq,l_reg=0.f;f32x16 o[2];o[0]=f32x16{};o[1]=f32x16{};f32x16 negm;
  #pragma unroll
  for(int r=0;r<16;++r)negm[r]=cbq;
  asm volatile("":"+v"(negm));
  #define CMASK(P0,P1,t) do{ if(FOX && !defined_nomask){int jb_=(t)-(NT-4); if(jb_>=0)cmask(P0,P1,jb_,qrel,hi);} }while(0)
  bool resc=false;
  #define START(P0,P1) do{ const float rm=rowmax(P0,P1); resc=false; \
    { const float dl=rm; mhat=fadd_s(mhat,dl); \
      _Pragma("unroll") for(int r=0;r<16;++r){P0[r]=fsub_s(P0[r],dl);P1[r]=fsub_s(P1[r],dl);} \
      _Pragma("unroll") for(int r=0;r<16;++r)negm[r]=-mhat; asm volatile("":"+v"(negm)); } \
    _Pragma("unroll") for(int r=0;r<16;++r)P0[r]=__builtin_amdgcn_exp2f(P0[r]); }while(0)
  #define RESC() do{ if(resc){ asm volatile("s_waitcnt lgkmcnt(0)":::"memory"); \
      _Pragma("unroll") for(int d_=0;d_<2;++d_) _Pragma("unroll") for(int r=0;r<16;++r)o[d_][r]*=wsf[crow(r,hi)]; } }while(0)
  f32x16 pA0,pA1,pB0,pB1;
  int sl_prev=0,sl_cur=0,sl_next=SLOTB;
  #define ROT() do{sl_prev=sl_cur;sl_cur=sl_next;sl_next=(sl_next==(NSLOT-1)*SLOTB)?0:sl_next+SLOTB;}while(0)
  DMA_K(2,2*SLOTB);
  WAIT_BAR(3);
  if(FOX){ bf16x8 bk0_,bk1_; LOADBK(bk0_,bk1_,0); pA0=__builtin_amdgcn_mfma_f32_32x32x16_bf16(bk0_,qone,negm,0,0,0); pA1=__builtin_amdgcn_mfma_f32_32x32x16_bf16(bk1_,qone,negm,0,0,0); qkt(pA0,pA1,Kbase,qr,pA0,pA1,r32,hi); }
  else qkt(pA0,pA1,Kbase,qr,negm,negm,r32,hi);
  asm volatile("s_nop 15\n\ts_nop 7":"+v"(pA0),"+v"(pA1));CMASK(pA0,pA1,0);
  START(pA0,pA1);
  _Pragma("unroll") for(int r=0;r<16;++r)pA1[r]=__builtin_amdgcn_exp2f(pA1[r]);
  WAIT_BAR(0);
  DMA_K(3,0);DMA_V(1,SLOTB);
  ROT();
  kload8(kf,kp0+sl_cur);
  WAIT_BAR(2);
  s16x4 vlo[8],vhi[8]; u32x4 pw0,pw1,pw2,pw3;
  #define PKW(P,B) cvtpk_s(P[B],P[B+1])
  #define PAF(k) __builtin_bit_cast(bf16x8,pw##k)
  #define VFR(i) (bf16x8){vlo[i][0],vlo[i][1],vlo[i][2],vlo[i][3],vhi[i][0],vhi[i][1],vhi[i][2],vhi[i][3]}
  #define PIN(x) asm volatile("":"+v"(x))
  #define MX3(a,b,c) __builtin_fmaxf(__builtin_fmaxf((a),(b)),(c))
  #define GAPA(MF,A0,A1,A2,A3,W0,W1,PW) do{ MF; sacc+=A0; sacc+=A1; sacc+=A2; sacc+=A3; PIN(sacc); W0; W1; PIN(PW); SBAR(); }while(0)
  #define EX(v) __builtin_amdgcn_exp2f(v)
  #define GAPB(MF,X,B) do{ MF; X[B]=EX(X[B]); X[B+1]=EX(X[B+1]); X[B+2]=EX(X[B+2]); X[B+3]=EX(X[B+3]); PIN(X); SBAR(); }while(0)
  #define VRD(i) do{ vlo[i]=vtr(vp_+(((i)>>2)*4096+((i)&3)*1024)); vhi[i]=vtr(vp_+(((i)>>2)*4096+((i)&3)*1024+512)); }while(0)
  #define KRD(G,j) do{ if(G){ kload2(kf,kp0+sl_next,j); SBAR(); } }while(0)
  #define STEP(C0,C1,P0,P1,t,GK,GV,GL) do{ SBAR(); \
    if(FOX){ bf16x8 bk0_,bk1_; LOADBK(bk0_,bk1_,t); C0=__builtin_amdgcn_mfma_f32_32x32x16_bf16(bk0_,qone,negm,0,0,0); C1=__builtin_amdgcn_mfma_f32_32x32x16_bf16(bk1_,qone,negm,0,0,0); SBAR(); } \
    const lds_cptr vp_=vp0+sl_prev; \
    bf16x8 qa_,qb_; if(FOX){qa_=QL(0);}else{qa_=qr[0];} \
    VRD(0); SBAR(); float sacc=(P0[0]+P0[1]); \
    GAPA(C0=__builtin_amdgcn_mfma_f32_32x32x16_bf16(kf[0],qa_,FOX?C0:negm,0,0,0), P0[2],P0[3],P0[4],P0[5],     pw0[0]=PKW(P0,0), pw0[1]=PKW(P0,2), pw0); \
    VRD(4); if(FOX){qb_=QL(1);}else{qb_=qr[1];} SBAR(); GAPA(C1=__builtin_amdgcn_mfma_f32_32x32x16_bf16(kf[1],qa_,FOX?C1:negm,0,0,0), P0[6],P0[7],P0[8],P0[9],     pw0[2]=PKW(P0,4), pw0[3]=PKW(P0,6), pw0); \
    VRD(1); SBAR(); GAPA(C0=__builtin_amdgcn_mfma_f32_32x32x16_bf16(kf[2],qb_,C0,0,0,0),   P0[10],P0[11],P0[12],P0[13], pw1[0]=PKW(P0,8), pw1[1]=PKW(P0,10), pw1); \
    VRD(5); if(FOX){qa_=QL(2);}else{qa_=qr[2];} SBAR(); GAPA(C1=__builtin_amdgcn_mfma_f32_32x32x16_bf16(kf[3],qb_,C1,0,0,0),   P0[14],P0[15],P1[0],P1[1],   pw1[2]=PKW(P0,12),pw1[3]=PKW(P0,14), pw1); \
    VRD(2); SBAR(); GAPA(C0=__builtin_amdgcn_mfma_f32_32x32x16_bf16(kf[4],qa_,C0,0,0,0),   P1[2],P1[3],P1[4],P1[5],     pw2[0]=PKW(P1,0), pw2[1]=PKW(P1,2), pw2); \
    VRD(6); if(FOX){qb_=QL(3);}else{qb_=qr[3];} SBAR(); GAPA(C1=__builtin_amdgcn_mfma_f32_32x32x16_bf16(kf[5],qa_,C1,0,0,0),   P1[6],P1[7],P1[8],P1[9],     pw2[2]=PKW(P1,4), pw2[3]=PKW(P1,6), pw2); \
    VRD(3); SBAR(); GAPA(C0=__builtin_amdgcn_mfma_f32_32x32x16_bf16(kf[6],qb_,C0,0,0,0),   P1[10],P1[11],P1[12],P1[13], pw3[0]=PKW(P1,8), pw3[1]=PKW(P1,10), pw3); \
    VRD(7); SBAR(); GAPA(C1=__builtin_amdgcn_mfma_f32_32x32x16_bf16(kf[7],qb_,C1,0,0,0),   P1[14],P1[15],0.f,0.f,       pw3[2]=PKW(P1,12),pw3[3]=PKW(P1,14), pw3); \
    l_reg+=sacc; \
    if(GK){DMA_K((t)+3,sl_cur);} if(GV){DMA_V((t)+1,sl_next);} \
    CMASK(C0,C1,t); \
    { float a=MX3(C0[0],C0[1],C1[0]),b=MX3(C0[2],C0[3],C1[1]); a=MX3(a,C1[2],C1[3]); \
      _Pragma("unroll") for(int r=4;r<16;r+=4){a=MX3(a,C0[r],C0[r+1]);b=MX3(b,C0[r+2],C0[r+3]);a=MX3(a,C1[r],C1[r+1]);b=MX3(b,C1[r+2],C1[r+3]);} \
      float rm=__builtin_fmaxf(a,b); { auto rr=__builtin_amdgcn_permlane32_swap(__float_as_uint(rm),__float_as_uint(rm),false,false); rm=__builtin_fmaxf(__uint_as_float(rr[0]),__uint_as_float(rr[1])); } \
      resc=false; \
      if(__builtin_expect(__any(rm>(float)THRL),0)){ const float dl=__builtin_fmaxf(rm,0.f); mhat+=dl; \
        _Pragma("unroll") for(int r=0;r<16;++r){C0[r]-=dl;C1[r]-=dl;} \
        _Pragma("unroll") for(int r=0;r<16;++r)negm[r]=-mhat; asm volatile("":"+v"(negm)); \
        const float f=__builtin_amdgcn_exp2f(-dl); l_reg*=f; if(hi==0)wsf[r32]=f; resc=true; } } \
    SBAR(); \
    GAPB(o[0]=__builtin_amdgcn_mfma_f32_32x32x16_bf16(PAF(0),VFR(0),o[0],0,0,0), C0,0); \
    GAPB(o[1]=__builtin_amdgcn_mfma_f32_32x32x16_bf16(PAF(0),VFR(4),o[1],0,0,0), C0,4); \
    KRD(GL,0); GAPB(o[0]=__builtin_amdgcn_mfma_f32_32x32x16_bf16(PAF(1),VFR(1),o[0],0,0,0), C0,8); \
    KRD(GL,1); GAPB(o[1]=__builtin_amdgcn_mfma_f32_32x32x16_bf16(PAF(1),VFR(5),o[1],0,0,0), C0,12); \
    KRD(GL,2); GAPB(o[0]=__builtin_amdgcn_mfma_f32_32x32x16_bf16(PAF(2),VFR(2),o[0],0,0,0), C1,0); \
    KRD(GL,3); GAPB(o[1]=__builtin_amdgcn_mfma_f32_32x32x16_bf16(PAF(2),VFR(6),o[1],0,0,0), C1,4); \
    GAPB(o[0]=__builtin_amdgcn_mfma_f32_32x32x16_bf16(PAF(3),VFR(3),o[0],0,0,0), C1,8); \
    GAPB(o[1]=__builtin_amdgcn_mfma_f32_32x32x16_bf16(PAF(3),VFR(7),o[1],0,0,0), C1,12); \
    }while(0)
  int t=1;
  #undef CMASK
  #define CMASK(P0,P1,t) do{}while(0)
  for(;t+5<NT;t+=2){
    STEP(pB0,pB1,pA0,pA1,t,true,true,true);     WAIT_BAR(2); RESC(); ROT();
    STEP(pA0,pA1,pB0,pB1,t+1,true,true,true);   WAIT_BAR(2); RESC(); ROT();
  }
  #undef CMASK
  #define CMASK(P0,P1,t) do{ if(FOX && !defined_nomask){int jb_=(t)-(NT-4); if(jb_>=0)cmask(P0,P1,jb_,qrel,hi);} }while(0)
  #define ENDW(tt) do{ if((tt)+3<NT){WAIT_BAR(2);} else if((tt)+2<NT){WAIT_BAR(1);} else {WAIT_BAR(0);} }while(0)
  for(;t+1<NT;t+=2){
    STEP(pB0,pB1,pA0,pA1,t,(t+3<NT),(t+1<NT),(t+1<NT));       ENDW(t);   RESC(); ROT();
    STEP(pA0,pA1,pB0,pB1,t+1,(t+4<NT),(t+2<NT),(t+2<NT));     ENDW(t+1); RESC(); ROT();
  }
  STEP(pB0,pB1,pA0,pA1,NT-1,false,false,false); RESC();
  { float sacc=pB0[0]+pB0[1]; _Pragma("unroll") for(int r=2;r<16;++r)sacc+=pB0[r]; _Pragma("unroll") for(int r=0;r<16;++r)sacc+=pB1[r]; l_reg+=sacc;
    pw0=(u32x4){PKW(pB0,0),PKW(pB0,2),PKW(pB0,4),PKW(pB0,6)};pw1=(u32x4){PKW(pB0,8),PKW(pB0,10),PKW(pB0,12),PKW(pB0,14)};pw2=(u32x4){PKW(pB1,0),PKW(pB1,2),PKW(pB1,4),PKW(pB1,6)};pw3=(u32x4){PKW(pB1,8),PKW(pB1,10),PKW(pB1,12),PKW(pB1,14)};
    SBAR(); pv(o,vb0+sl_cur,PAF(0),PAF(1),PAF(2),PAF(3)); }
  #undef PKW
  #undef PAF
  #undef VFR
  #undef PIN
  #undef MX3
  #undef GAPA
  #undef GAPB
  #undef EX
  #undef VRD
  #undef KRD
  #undef STEP
  #undef ENDW
  {auto rr=__builtin_amdgcn_permlane32_swap(__float_as_uint(l_reg),__float_as_uint(l_reg),false,false);l_reg=__uint_as_float(rr[0])+__uint_as_float(rr[1]);}
  if(hi==0)wsf[32+r32]=l_reg;asm volatile("s_waitcnt lgkmcnt(0)":::"memory");
  float rli[16];
  #pragma unroll
  for(int r=0;r<16;++r)rli[r]=__builtin_amdgcn_rcpf(wsf[32+crow(r,hi)]);
  bf16*Yw=Y+(rowbase+q0+wid*QBLK)*YP+ycol0+h*D;
  { bf16*stg=(bf16*)(shm+LDS_OST)+wid*2048;
    #pragma unroll
    for(int r=0;r<16;++r){const int orow=crow(r,hi);
      #pragma unroll
      for(int d0=0;d0<2;++d0)stg[orow*64+d0*32+r32]=__float2bfloat16(o[d0][r]*rli[r]);}
    asm volatile("s_waitcnt lgkmcnt(0)":::"memory");
    const int ch=lane&7; const f32x4v g0=*(const f32x4v*)(gout+h*D+ch*8), g1=*(const f32x4v*)(gout+h*D+ch*8+4);
    #pragma unroll
    for(int i=0;i<4;++i){const int row=i*8+(lane>>3); const u32x4 v=*(const u32x4*)(stg+row*64+ch*8);
      float f[8];
      #pragma unroll
      for(int k=0;k<4;++k){ f[2*k]=__uint_as_float(v[k]<<16); f[2*k+1]=__uint_as_float(v[k]&0xffff0000u); }
      float ss=0.f;
      #pragma unroll
      for(int k=0;k<8;++k)ss+=f[k]*f[k];
      ss+=__shfl_xor(ss,1); ss+=__shfl_xor(ss,2); ss+=__shfl_xor(ss,4);
      const float rstd=1.0f/sqrtf(ss*(1.0f/64.0f)+1e-6f);
      u32x4 w; w.x=cvtpk_s(f[0]*rstd*g0[0],f[1]*rstd*g0[1]); w.y=cvtpk_s(f[2]*rstd*g0[2],f[3]*rstd*g0[3]); w.z=cvtpk_s(f[4]*rstd*g1[0],f[5]*rstd*g1[1]); w.w=cvtpk_s(f[6]*rstd*g1[2],f[7]*rstd*g1[3]);
      ATTN_STORE16(Yw+(long)row*YP+ch*8,w);} }
  asm volatile("s_waitcnt lgkmcnt(0)\n\ts_barrier":::"memory");
  #undef LOADBK
  #undef QL
  #undef DMA_K
  #undef DMA_V
  #undef CMASK
  #undef START
  #undef RESC
  #undef ROT
}
constexpr int ATTN_LDS_BYTES=LDS_BYTES;
struct AttnUnit { int bh; int qb; };
#undef SBAR
#undef WAIT_BAR
}
#define GAS __attribute__((address_space(1)))
#define LAS __attribute__((address_space(3)))
typedef unsigned short bf16;
typedef unsigned v4u __attribute__((ext_vector_type(4)));
typedef float f32x4 __attribute__((ext_vector_type(4)));
typedef short bf16x8 __attribute__((ext_vector_type(8)));
typedef GAS unsigned gu32;
typedef GAS unsigned long long gu64;
#define RLX_AGENT __ATOMIC_RELAXED, __HIP_MEMORY_SCOPE_AGENT
#define LDS_WAIT() asm volatile("s_waitcnt lgkmcnt(0)" ::: "memory")
#define VM_WAIT() asm volatile("s_waitcnt vmcnt(0)" ::: "memory")
__device__ __forceinline__ unsigned long long rt() { return __builtin_amdgcn_s_memrealtime(); }
__device__ __forceinline__ unsigned f2bf(float f) { unsigned u = __builtin_bit_cast(unsigned, f); return (u + 0x7fffu + ((u >> 16) & 1u)) >> 16; }
__device__ __forceinline__ unsigned pk2(float lo, float hi) { return f2bf(lo) | (f2bf(hi) << 16); }

#define XB_TMO      128
#define XB_XCNT(j)  (256  + 64 * (j))
#define XB_XSUB(j)  (1280 + 64 * (j))
#define XB_XGEN(j)  (2304 + 64 * (j))
#define XB_TOP      3328
#define XB_TOPGEN   3392
#define XCD_BAR_WORDS 3456
#define XB_SPIN_CAP (1u << 18)

__device__ __forceinline__ unsigned xb_ld(unsigned* p)              { return __hip_atomic_load(p, __ATOMIC_RELAXED, __HIP_MEMORY_SCOPE_AGENT); }
__device__ __forceinline__ unsigned xb_add(unsigned* p, unsigned v) { return __hip_atomic_fetch_add(p, v, __ATOMIC_RELAXED, __HIP_MEMORY_SCOPE_AGENT); }
__device__ __forceinline__ unsigned xb_xcc_id() { return (unsigned)__builtin_amdgcn_s_getreg((3 << 11) | 20) & 0xFu; }
#define XB_SPIN(cond, bar) do { unsigned _sp = 0; while (cond) { __builtin_amdgcn_s_sleep(1); \
    if ((++_sp & 255u) == 0u) { if (xb_ld(&(bar)[XB_TMO])) break; if (_sp > XB_SPIN_CAP) { atomicAdd(&(bar)[XB_TMO], 1u); break; } } } } while (0)

struct XcdBarrier {
    unsigned* bar; unsigned x;
    volatile LAS unsigned* st;
};

__device__ __forceinline__ XcdBarrier xcd_barrier_post(unsigned* bar, volatile LAS unsigned* st) {
    XcdBarrier b; b.bar = bar; b.x = xb_xcc_id(); b.st = st;
    if (threadIdx.x == 0) (void)xb_add(&bar[XB_XCNT(b.x)], 1u);
    return b;
}
__device__ __forceinline__ void xcd_barrier_complete(unsigned* bar, unsigned x, unsigned& nloc, unsigned& nx) {
    const unsigned G = gridDim.x * gridDim.y * gridDim.z;
    unsigned sum, cnt, mine, sp = 0u;
    for (;;) {
        sum = 0u; cnt = 0u; mine = 0u;
#pragma unroll
        for (unsigned j = 0; j < 16; ++j) { const unsigned c = xb_ld(&bar[XB_XCNT(j)]); sum += c; cnt += (c > 0u) ? 1u : 0u; mine = (j == x) ? c : mine; }
        if (sum == G) break;
        __builtin_amdgcn_s_sleep(1);
        if ((++sp & 255u) == 0u) { if (xb_ld(&bar[XB_TMO])) break; if (sp > XB_SPIN_CAP) { atomicAdd(&bar[XB_TMO], 1u); break; } }
    }
    nloc = mine > 0u ? mine : 1u; nx = cnt > 0u ? cnt : 1u;
}

__device__ __forceinline__ void xcd_barrier(const XcdBarrier& b) {
    asm volatile("s_waitcnt vmcnt(0)" ::: "memory");
    __syncthreads();
    if (threadIdx.x == 0) {
        unsigned* bar = b.bar;
        __builtin_amdgcn_s_waitcnt(0);
        unsigned nloc = b.st[0], nx = b.st[1];
        if (nloc == 0u) { xcd_barrier_complete(bar, b.x, nloc, nx); b.st[0] = nloc; b.st[1] = nx; }
        const unsigned old = xb_add(&bar[XB_XSUB(b.x)], 1u);
        const unsigned gen = old / nloc;
        if (old + 1u == (gen + 1u) * nloc) {
            __builtin_amdgcn_fence(__ATOMIC_RELEASE, "agent");
            asm volatile("s_waitcnt vmcnt(0)" ::: "memory");
            const unsigned og = xb_add(&bar[XB_TOP], 1u);
            const unsigned tg = og / nx;
            if (og + 1u == (tg + 1u) * nx) xb_add(&bar[XB_TOPGEN], 1u);
            else XB_SPIN(xb_ld(&bar[XB_TOPGEN]) == tg, bar);
            __builtin_amdgcn_fence(__ATOMIC_ACQUIRE, "agent");
            xb_add(&bar[XB_XGEN(b.x)], 1u);
            asm volatile("s_waitcnt vmcnt(0)" ::: "memory");
        } else {
            XB_SPIN(xb_ld(&bar[XB_XGEN(b.x)]) == gen, bar);
            __builtin_amdgcn_fence(__ATOMIC_ACQUIRE, "agent");
            asm volatile("s_waitcnt vmcnt(0)" ::: "memory");
        }
    }
    __syncthreads();
}
constexpr int RING_OFF = 0, RING_BYTES = 153600;
constexpr int LDSCTL_OFF = RING_BYTES, GTAB_OFF = LDSCTL_OFF  , MISC_OFF = LDSCTL_OFF + 320;
constexpr int LDS_BYTES = 154624;
static_assert(MISC_OFF + 128 <= LDS_BYTES && attn_body::LDS_BYTES <= RING_BYTES, "LDS map");

struct Frame {
    LAS unsigned char* lds;
    volatile LAS unsigned* MISC;
    gu32* ctl;
    int tid, lane, wave, vcu, G;
};
__device__ __forceinline__ float wave_sum(float v) {
#pragma unroll
    for (int o = 1; o < 64; o <<= 1) v += __shfl_xor(v, o);
    return v;
}

struct WSrc { const float* p; int col; int N; };
__device__ __forceinline__ WSrc wsrc(int kind, int d, const float* w0, const float* w1) {
    WSrc s; s.p = w0; s.col = -1; s.N = 1;
    if (kind == 0) {
        const int pn = d >> 8, c = d & 255, bj = c >> 7, wc = (c >> 5) & 3, dlo = c & 31, hd = 64 * wc + 32 * bj + dlo;
        s.N = IN_COLS;
        if (pn == 0) s.col = hd; else if (pn == 1) s.col = 256 + hd; else if (pn <= 3) s.col = 512 + 256 * (pn - 2) + c; else if (pn <= 5) s.col = 1024 + 256 * (pn - 4) + c;
        else if (pn == 6) s.col = 1536 + hd; else if (pn == 7) s.col = 1792 + hd; else if (pn == 8) s.col = 2048 + c; else if (pn == 9) s.col = 2308 + hd;
        else if (pn == 10) s.col = c < 4 ? 2304 + c : -1;
        else { s.p = w1; s.N = 512; s.col = pn == 11 ? hd : 256 + c; }
    } else if (kind == 1) { s.N = D_MODEL; s.col = d; }
    else if (kind == 2) { const int pn = d >> 8, c = d & 255, f = 128 * pn + (c & 127); s.N = D_FF; s.p = c < 128 ? w0 : w1; s.col = f < D_FF ? f : -1; }
    else { s.N = D_MODEL; s.col = d; }
    return s;
}
constexpr int TR_P = 68;
struct TrItem { int kind; const float* w0; const float* w1; int Ksrc; bf16* dst; int Kd; int row0, k0; const float* gk; float s8; };
__device__ __forceinline__ void tr_load(const TrItem& d, int lane, f32x4 (&v)[16]) {
    const int q = lane & 15, kr = lane >> 4;
    const WSrc s = wsrc(d.kind, d.row0 + 4 * q, d.w0, d.w1);
#pragma unroll
    for (int i = 0; i < 16; ++i) { const int k = d.k0 + 4 * i + kr; v[i] = (f32x4){0.f, 0.f, 0.f, 0.f}; if (s.col >= 0 && k < d.Ksrc) v[i] = __builtin_nontemporal_load((const GAS f32x4*)(s.p + (size_t)k * s.N + s.col)); }
}
__device__ __forceinline__ void tr_store(const TrItem& d, int lane, const f32x4 (&v)[16], LAS float* scr) {
    const int q = lane & 15, kr = lane >> 4;
#pragma unroll
    for (int i = 0; i < 16; ++i) { const int kk = 4 * i + kr; f32x4 x = v[i]; if (d.gk) x = x * d.gk[(d.k0 + kk) < d.Ksrc ? d.k0 + kk : 0];
        *(LAS f32x4*)(scr + kk * TR_P + ((4 * q + 4 * (kk >> 3)) & 63)) = x; }
    LDS_WAIT(); asm volatile("" ::: "memory");
    const int c = lane & 7;
#pragma unroll
    for (int j = 0; j < 8; ++j) { const int n = (lane >> 3) + 8 * j; const LAS float* p = scr + (8 * c) * TR_P + ((n + 4 * c) & 63);
        if (d.s8 > 0.f) { typedef unsigned u32x2 __attribute__((ext_vector_type(2))); u32x2 o; const float s = d.s8;
            o.x = pg8::pk4_fp8(p[0 * TR_P] * s, p[1 * TR_P] * s, p[2 * TR_P] * s, p[3 * TR_P] * s); o.y = pg8::pk4_fp8(p[4 * TR_P] * s, p[5 * TR_P] * s, p[6 * TR_P] * s, p[7 * TR_P] * s);
            *(GAS u32x2*)((unsigned char*)d.dst + (size_t)(d.row0 + n) * d.Kd + d.k0 + 8 * c) = o; }
        else { v4u o; o.x = pg8::cvt_pk_bf16(p[0 * TR_P], p[1 * TR_P]); o.y = pg8::cvt_pk_bf16(p[2 * TR_P], p[3 * TR_P]); o.z = pg8::cvt_pk_bf16(p[4 * TR_P], p[5 * TR_P]); o.w = pg8::cvt_pk_bf16(p[6 * TR_P], p[7 * TR_P]);
            *(GAS v4u*)(d.dst + (size_t)(d.row0 + n) * d.Kd + d.k0 + 8 * c) = o; } }
    LDS_WAIT(); asm volatile("" ::: "memory");
}
struct In { const float *x, *mem, *attn_g, *w_in, *fbias, *fqg, *fkg, *mqg, *mkg, *memg, *wmemkv, *outg, *w_out, *ffn_g, *dwg, *dwu, *dwd, *router, *ewg, *ewu, *ewd; };

struct FfnMat { const float *g, *u, *d; };
__device__ __forceinline__ FfnMat ffn_mat(const In& I, int mi) { FfnMat f;
    f.g = mi < 2 ? I.dwg + (size_t)mi * D_MODEL * D_FF : I.ewg + (size_t)(mi - 2) * D_MODEL * D_FF; f.u = mi < 2 ? I.dwu + (size_t)mi * D_MODEL * D_FF : I.ewu + (size_t)(mi - 2) * D_MODEL * D_FF;
    f.d = mi < 2 ? I.dwd + (size_t)mi * D_FF * D_MODEL : I.ewd + (size_t)(mi - 2) * D_FF * D_MODEL; return f; }
constexpr int I_IN = (D_MODEL / 64) * (NINKV / 64), I_OUT = (D_MODEL / 64) * (D_MODEL / 64), I_GU = (D_MODEL / 64) * (NGU / 64), I_DN = (FFP / 64) * (D_MODEL / 64);
constexpr int T_IN = 4 * I_IN, T_OUT = 4 * I_OUT, T_GU = 18 * I_GU, T_DN = 18 * I_DN;
constexpr int DEF_M0 = 10, N_DEF = (18 - DEF_M0) * (I_GU + I_DN);
constexpr int N_DEF1 = (256 - 196) * 8 * 4 + (256 - 128) * 8 * 5, U_DEF1 = T_IN + T_OUT + 2 * I_GU;
constexpr int N_DEF_T = (17280 < N_DEF ? 17280 : N_DEF);
constexpr int N_DEF3 = 2 * I_IN + 2 * I_OUT + I_GU + I_DN, N_PRO = T_IN + T_OUT + DEF_M0 * (I_GU + I_DN) - N_DEF1 - N_DEF3;
__device__ __forceinline__ TrItem decode_item(const In& I, unsigned char* ws, int r) { TrItem d;
    if (r < T_IN) { const int l = r / I_IN, q = r % I_IN, kb = q / (NINKV / 64), nb = q % (NINKV / 64);
        d = TrItem{0, I.w_in + (size_t)l * D_MODEL * IN_COLS, I.wmemkv + (size_t)l * D_MODEL * 512, D_MODEL, (bf16*)(ws + WS_WIN + l * SZ_WIN), D_MODEL, 64 * nb, 64 * kb, nb < NIN / 64 ? I.attn_g + l * D_MODEL : nullptr, 0.f}; return d; }
    r -= T_IN;
    if (r < T_OUT) { const int l = r / I_OUT, q = r % I_OUT, kb = q / (D_MODEL / 64), nb = q % (D_MODEL / 64);
        d = TrItem{1, I.w_out + (size_t)l * D_MODEL * D_MODEL, nullptr, D_MODEL, (bf16*)(ws + WS_WOUT + l * SZ_WOUT), D_MODEL, 64 * nb, 64 * kb, nullptr, 0.f}; return d; }
    r -= T_OUT;
    if (r < T_GU) { const int mi = r / I_GU, q = r % I_GU, kb = q / (NGU / 64), nb = q % (NGU / 64); const FfnMat f = ffn_mat(I, mi);
        d = TrItem{2, f.g, f.u, D_MODEL, (bf16*)(mi < 2 ? (ws + WS_WGU + mi * SZ_WGU) : (ws + WS_EGU + (size_t)(mi - 2) * SZ_EGU)), D_MODEL, 64 * nb, 64 * kb, I.ffn_g + (mi < 2 ? 2 * mi : 2 * ((mi - 2) >> 3) + 1) * D_MODEL, (FP8_MOE_GU && mi >= 2) ? SW_GU : 0.f}; return d; }
    r -= T_GU;
    { const int mi = r / I_DN, q = r % I_DN, kb = q / (D_MODEL / 64), nb = q % (D_MODEL / 64); const FfnMat f = ffn_mat(I, mi);
        d = TrItem{3, f.d, nullptr, D_FF, (bf16*)(mi < 2 ? (ws + WS_WDN + mi * SZ_WDN) : (ws + WS_EDN + (size_t)(mi - 2) * SZ_WDN)), FFP, 64 * nb, 64 * kb, nullptr, FP8_DN ? SW_DN : 0.f}; return d; }
}
__device__ __forceinline__ int list_item(int list, int p) {
    if (list == 0 && p >= N_PRO) { list = 1; p = N_DEF_T + (p - N_PRO); }
    if (list == 0) {
        if (p < 2 * I_IN) return p;                                  p -= 2 * I_IN;
        if (p < 2 * I_OUT) return T_IN + p;                          p -= 2 * I_OUT;
        if (p < I_GU) return T_IN + T_OUT + p;                       p -= I_GU;
        if (p < 8 * I_GU - N_DEF1) return U_DEF1 + N_DEF1 + p;       p -= 8 * I_GU - N_DEF1;
        if (p < I_DN) return T_IN + T_OUT + T_GU + p;                p -= I_DN;
        return T_IN + T_OUT + T_GU + 2 * I_DN + p;
    }
    if (list == 3) {
        if (p < 2 * I_IN) return 2 * I_IN + p;                       p -= 2 * I_IN;
        if (p < 2 * I_OUT) return T_IN + 2 * I_OUT + p;              p -= 2 * I_OUT;
        if (p < I_GU) return T_IN + T_OUT + I_GU + p;                p -= I_GU;
        return T_IN + T_OUT + T_GU + I_DN + p;
    }
    if (list == 2) return U_DEF1 + p;
    return p < (18 - DEF_M0) * I_GU ? T_IN + T_OUT + DEF_M0 * I_GU + p : T_IN + T_OUT + T_GU + DEF_M0 * I_DN + (p - (18 - DEF_M0) * I_GU);
}
__device__ __forceinline__ void p_convert(Frame& F, const In& I, unsigned char* ws, int list, int first, int stride, int quota) {
    LAS float* scr = (LAS float*)(F.lds + RING_OFF + F.wave * (64 * TR_P * 4));
    const int nlist = list == 0 ? N_PRO + (N_DEF - N_DEF_T) : list == 1 ? N_DEF_T : list == 2 ? N_DEF1 : N_DEF3;
    f32x4 va[16], vb[16]; TrItem da, db; int it = first, left = quota; bool hasa = it < nlist && left > 0, hasb = false;
    if (hasa) { da = decode_item(I, ws, list_item(list, it)); tr_load(da, F.lane, va); --left; }
    while (hasa) {
        hasb = it + stride < nlist && left > 0; if (hasb) { db = decode_item(I, ws, list_item(list, it + stride)); tr_load(db, F.lane, vb); --left; }
        tr_store(da, F.lane, va, scr);
        if (!hasb) break;
        it += 2 * stride; hasa = it < nlist && left > 0; if (hasa) { da = decode_item(I, ws, list_item(list, it)); tr_load(da, F.lane, va); --left; }
        tr_store(db, F.lane, vb, scr);
    }
}
constexpr int DQ_IP = 4, DQ_F = 5, DQ_D1 = 3, DQ_M1 = 2, DQ_D1X = 3, DC_IP = 196, DC_F = 128, DC_D1 = 16, DC_M1 = 96;
static_assert((256 - DC_D1) * 8 * DQ_D1X >= N_DEF3, "list 3 fits its slot (the expert down phase of layer 1)");
constexpr int DS2_IP0 = 0, DS2_F0 = DS2_IP0 + (256 - DC_IP) * 8 * DQ_IP;
static_assert(DS2_F0 + (256 - DC_F) * 8 * DQ_F >= N_DEF1, "list 2 slots cover the list");
constexpr int DS_IP1 = 0, DS_M1 = DS_IP1 + (256 - DC_IP) * 8 * DQ_IP, DS_D1 = DS_M1 + (256 - DC_M1) * 8 * DQ_M1, DS_IP2 = DS_D1 + (256 - DC_D1) * 8 * DQ_D1, DS_F2 = DS_IP2 + (256 - DC_IP) * 8 * DQ_IP;
constexpr int N_DEF_T_ = DS_F2 + (256 - DC_F) * 8 * DQ_F;
static_assert(N_DEF_T_ >= N_DEF_T, "list 1 slots cover the deferred part of the list");
__device__ __forceinline__ void p_convert_tail(Frame& F, const In& I, unsigned char* ws, int list, int slot, int c0, int quota) {
    if ((int)blockIdx.x < c0 || F.G != 256) return;
    const int nw = (256 - c0) * NWAVES, r = ((int)blockIdx.x - c0) * NWAVES + F.wave;
    p_convert(F, I, ws, list, slot + r, nw, quota);
}

__device__ __forceinline__ void p_prologue(Frame& F, const In& I, unsigned char* ws) {
    const int gw = F.vcu * NWAVES + F.wave, NGW = F.G * NWAVES;
    if (F.vcu == 1) for (int i = F.tid; i < 2 * 16 * D_MODEL; i += NWAVES * 64) { const int j = i >> 14, e = (i >> 10) & 15, k = i & 1023;
        ((bf16*)(ws + WS_WRT))[i] = (bf16)f2bf(e < N_EXPERTS ? I.router[((size_t)j * D_MODEL + k) * N_EXPERTS + e] * I.ffn_g[(2 * j + 1) * D_MODEL + k] : 0.f); }
    if (F.vcu == 0) for (int i = F.tid; i < 1024; i += NWAVES * 64) { const int l = i >> 8, w = (i >> 6) & 3, d = i & 63; const float* src = w == 0 ? I.fqg : w == 1 ? I.fkg : w == 2 ? I.mqg : I.mkg; ((float*)(ws + WS_GAINS))[i] = src[l * 64 + d]; }
    constexpr int NROWS = M_TOK + 4 * M_MEM;
#define PR_LOAD(mr, HV) do { const int mr_ = (mr); if (mr_ < NROWS) { const bool im_ = mr_ >= M_TOK; const int rm_ = im_ ? (mr_ - M_TOK) % M_MEM : mr_; \
        const GAS f32x4* xr_ = (const GAS f32x4*)((im_ ? I.mem : I.x) + (size_t)rm_ * D_MODEL) + F.lane; _Pragma("unroll") for (int j = 0; j < 4; ++j) HV[j] = __builtin_nontemporal_load(xr_ + 64 * j); } } while (0)
#define PR_DO(mr, HV) do { const int mr_ = (mr); if (mr_ < NROWS) { const bool ismem = mr_ >= M_TOK; const int lm = ismem ? (mr_ - M_TOK) / M_MEM : 0, rm = ismem ? (mr_ - M_TOK) % M_MEM : mr_; float s = 0.f; \
        _Pragma("unroll") for (int j = 0; j < 4; ++j) s += (HV[j].x * HV[j].x + HV[j].y * HV[j].y) + (HV[j].z * HV[j].z + HV[j].w * HV[j].w); \
        s = wave_sum(s); \
        if (ismem) { const float rstd = __builtin_amdgcn_rsqf(s * (1.f / D_MODEL) + EPS); const GAS f32x4* gr = (const GAS f32x4*)(I.memg + lm * D_MODEL) + F.lane; \
            _Pragma("unroll") for (int j = 0; j < 4; ++j) HV[j] = HV[j] * rstd * gr[64 * j]; } \
        GAS unsigned long long* o8 = (GAS unsigned long long*)((ismem ? (bf16*)(ws + WS_MEMN) + (size_t)(lm * M_MEM + rm) * D_MODEL : (bf16*)(ws + WS_XB) + (size_t)rm * D_MODEL)) + F.lane; \
        _Pragma("unroll") for (int j = 0; j < 4; ++j) o8[64 * j] = (unsigned long long)pg8::cvt_pk_bf16(HV[j].x, HV[j].y) | ((unsigned long long)pg8::cvt_pk_bf16(HV[j].z, HV[j].w) << 32); \
        if (!ismem && F.lane == 0) *(GAS f32x4*)((float*)(ws + WS_SSA) + (size_t)rm * 4) = (f32x4){s, 0.f, 0.f, 0.f}; } } while (0)
    { f32x4 h0[4], h1[4], h2[4];
      for (int mr = gw; mr < NROWS; mr += 3 * NGW) { PR_LOAD(mr, h0); PR_LOAD(mr + NGW, h1); PR_LOAD(mr + 2 * NGW, h2); PR_DO(mr, h0); PR_DO(mr + NGW, h1); PR_DO(mr + 2 * NGW, h2); } }
#undef PR_LOAD
#undef PR_DO
    p_convert(F, I, ws, 0, gw, NGW, 1 << 30);
}

struct TokRoute { int e1, p1, e2, p2; float g1, g2; int pad0, pad1; };
__device__ __forceinline__ void load_xb_row(const bf16* XB, int m, int lane, f32x4 (&xv)[4]) {
    const GAS unsigned long long* xr = (const GAS unsigned long long*)(XB + (size_t)m * D_MODEL) + lane;
#pragma unroll
    for (int j = 0; j < 4; ++j) { const unsigned long long a = xr[64 * j]; xv[j].x = pg8::bf_lo((unsigned)a); xv[j].y = pg8::bf_hi((unsigned)a); xv[j].z = pg8::bf_lo((unsigned)(a >> 32)); xv[j].w = pg8::bf_hi((unsigned)(a >> 32)); }
}
__device__ __forceinline__ void build_tab(LAS int* tab, const gu32* counts) {
    __syncthreads();
    if (threadIdx.x == 0) { int t = 0; for (int e = 0; e < N_EXPERTS; ++e) { int n = (int)__hip_atomic_load(counts + e, RLX_AGENT); n = n > 16384 ? 16384 : n; tab[e] = t; t += (n + 255) / 256; } tab[N_EXPERTS] = t; }
    __syncthreads();
}
__device__ __forceinline__ void p_combine(Frame& F, bf16* XB, const bf16* YD, const TokRoute* R, const LAS int* tab, float* SSA, float* OUT, bool final_) {
    const int gw = F.vcu * NWAVES + F.wave, NGW = F.G * NWAVES; const int nrows = (M_TOK - gw + NGW - 1) / NGW;
    int s1_l = 0, s2_l = 0; float g1_l = 0.f, g2_l = 0.f;
    if (F.lane < nrows) { const GAS v4u* rr = (const GAS v4u*)(R + gw + F.lane * NGW); const v4u ra = rr[0], rb = rr[1]; s1_l = tab[ra[0]] * 256 + (int)ra[1]; s2_l = tab[ra[2]] * 256 + (int)ra[3]; g1_l = __uint_as_float(rb[0]); g2_l = __uint_as_float(rb[1]); }
    f32x4 xa[4], ya[4], za[4], xb[4], yb[4], zb[4];
#define CB_LOAD(i, X, Y, Z) do { load_xb_row(XB, gw + (i) * NGW, F.lane, X); load_xb_row(YD, __builtin_amdgcn_readlane(s1_l, (i)), F.lane, Y); load_xb_row(YD, __builtin_amdgcn_readlane(s2_l, (i)), F.lane, Z); } while (0)
#define CB_DO(i, X, Y, Z) do { const int m_ = gw + (i) * NGW; const float g1 = __int_as_float(__builtin_amdgcn_readlane(__float_as_int(g1_l), (i))), g2 = __int_as_float(__builtin_amdgcn_readlane(__float_as_int(g2_l), (i))); float s = 0.f; \
        _Pragma("unroll") for (int j = 0; j < 4; ++j) { X[j] = (X[j] + Y[j] * g1) + Z[j] * g2; s += (X[j].x * X[j].x + X[j].y * X[j].y) + (X[j].z * X[j].z + X[j].w * X[j].w); } \
        if (final_) { GAS f32x4* xo = (GAS f32x4*)(OUT + (size_t)m_ * D_MODEL) + F.lane; _Pragma("unroll") for (int j = 0; j < 4; ++j) xo[64 * j] = X[j]; } \
        else { s = wave_sum(s); GAS unsigned long long* o8 = (GAS unsigned long long*)(XB + (size_t)m_ * D_MODEL) + F.lane; \
            _Pragma("unroll") for (int j = 0; j < 4; ++j) o8[64 * j] = (unsigned long long)pg8::cvt_pk_bf16(X[j].x, X[j].y) | ((unsigned long long)pg8::cvt_pk_bf16(X[j].z, X[j].w) << 32); \
            if (F.lane == 0) *(GAS f32x4*)(SSA + (size_t)m_ * 4) = (f32x4){s, 0.f, 0.f, 0.f}; } } while (0)
    if (nrows > 0) CB_LOAD(0, xa, ya, za);
    for (int i = 0; i < nrows; i += 2) {
        if (i + 1 < nrows) CB_LOAD(i + 1, xb, yb, zb);
        CB_DO(i, xa, ya, za);
        if (i + 1 < nrows) { if (i + 2 < nrows) CB_LOAD(i + 2, xa, ya, za); CB_DO(i + 1, xb, yb, zb); }
    }
#undef CB_LOAD
#undef CB_DO
}
__device__ __forceinline__ void p_route2(Frame& F, const float* LOGP, const float* SSF, gu32* counts, int* list, TokRoute* R, float* RSS) {
    LAS unsigned* lcnt = (LAS unsigned*)(F.lds + RING_OFF);
    if (F.tid < 16) lcnt[F.tid] = 0u;
    __syncthreads();
    const int mm = F.vcu * 64 + F.tid; const bool act = F.tid < 64 && mm < M_TOK;
    unsigned e1 = 0, e2 = 1, r1 = 0, r2 = 0; float g1 = 0.f, g2 = 0.f, rstd = 0.f;
    if (act) {
        float lg[N_EXPERTS];
#pragma unroll
        for (int e = 0; e < N_EXPERTS; ++e) lg[e] = 0.f;
        const GAS f32x4* lp = (const GAS f32x4*)(LOGP + (size_t)mm * 128);
#pragma unroll
        for (int p = 0; p < 16; ++p) { const f32x4 a = lp[2 * p], b = lp[2 * p + 1]; lg[0] += a.x; lg[1] += a.y; lg[2] += a.z; lg[3] += a.w; lg[4] += b.x; lg[5] += b.y; lg[6] += b.z; lg[7] += b.w; }
        const f32x4 ps = *(const GAS f32x4*)(SSF + (size_t)mm * 4); rstd = __builtin_amdgcn_rsqf(((ps[0] + ps[1]) + (ps[2] + ps[3])) * (1.0f / D_MODEL) + EPS);
        float v1 = lg[0]; e1 = 0;
#pragma unroll
        for (int e = 1; e < N_EXPERTS; ++e) if (lg[e] > v1) { v1 = lg[e]; e1 = e; }
        float v2 = -INFINITY; e2 = 0;
#pragma unroll
        for (int e = 0; e < N_EXPERTS; ++e) if ((unsigned)e != e1 && lg[e] > v2) { v2 = lg[e]; e2 = e; }
        g2 = 1.0f / (1.0f + __expf((v1 - v2) * rstd)); g1 = 1.0f - g2;
        r1 = __hip_atomic_fetch_add((unsigned*)(lcnt + e1), 1u, __ATOMIC_RELAXED, __HIP_MEMORY_SCOPE_WORKGROUP); r2 = __hip_atomic_fetch_add((unsigned*)(lcnt + e2), 1u, __ATOMIC_RELAXED, __HIP_MEMORY_SCOPE_WORKGROUP);
    }
    __syncthreads();
    if (F.tid < N_EXPERTS) lcnt[8 + F.tid] = __hip_atomic_fetch_add(counts + F.tid, lcnt[F.tid], RLX_AGENT);
    __syncthreads();
    if (act) { unsigned p1 = lcnt[8 + e1] + r1, p2 = lcnt[8 + e2] + r2;
        if (p1 < 16384u) { list[e1 * 16384 + p1] = mm; RSS[e1 * 16384 + p1] = rstd; } else p1 = 16383u;
        if (p2 < 16384u) { list[e2 * 16384 + p2] = mm; RSS[e2 * 16384 + p2] = rstd; } else p2 = 16383u;
        GAS v4u* ro = (GAS v4u*)(R + mm); ro[0] = (v4u){e1, p1, e2, p2}; ro[1] = (v4u){__float_as_uint(g1), __float_as_uint(g2), 0u, 0u}; }
    __syncthreads();
}

__device__ __forceinline__ void p_cumsum(Frame& F, const float* LOGF, float* CB) {
    if (F.vcu >= 8) return;
    const float* src = LOGF + (size_t)F.vcu * SEQ + F.tid * 16; float* dst = CB + (size_t)F.vcu * SEQ + F.tid * 16;
    float v[16];
#pragma unroll
    for (int j = 0; j < 4; ++j) { const f32x4 t = *(const f32x4*)(src + 4 * j); v[4 * j] = t.x; v[4 * j + 1] = t.y; v[4 * j + 2] = t.z; v[4 * j + 3] = t.w; }
#pragma unroll
    for (int j = 1; j < 16; ++j) v[j] += v[j - 1];
    float incl = v[15];
#pragma unroll
    for (int o = 1; o < 64; o <<= 1) { const float t = __shfl_up(incl, o); if (F.lane >= o) incl += t; }
    LAS float* wt = (LAS float*)(F.lds + RING_OFF);
    if (F.lane == 63) wt[F.wave] = incl;
    __syncthreads();
    float base = incl - v[15];
    for (int w = 0; w < F.wave; ++w) base += wt[w];
#pragma unroll
    for (int j = 0; j < 4; ++j) { f32x4 t; t.x = (v[4 * j] + base) * 1.4426950408889634f; t.y = (v[4 * j + 1] + base) * 1.4426950408889634f; t.z = (v[4 * j + 2] + base) * 1.4426950408889634f; t.w = (v[4 * j + 3] + base) * 1.4426950408889634f; *(f32x4*)(dst + 4 * j) = t; }
    __syncthreads();
}

constexpr int RT_VP = 144, RT_KP = 72;
typedef short rt_v4i16 __attribute__((ext_vector_type(4)));
__device__ __forceinline__ float ret_log2g(int h) { return log2f(1.0f - exp2f(-5.0f - (float)h)); }
__device__ __forceinline__ bf16x8 ret_tr8(const LAS bf16* tile, int P, int tA, int tB, int c0, int lane) {
    const int q = (lane & 15) >> 2, p = lane & 3;
    const rt_v4i16 a = __builtin_amdgcn_ds_read_tr16_b64_v4i16((LAS rt_v4i16*)(tile + (tA + q) * P + c0 + 4 * p));
    const rt_v4i16 b = __builtin_amdgcn_ds_read_tr16_b64_v4i16((LAS rt_v4i16*)(tile + (tB + q) * P + c0 + 4 * p));
    return (bf16x8){a[0], a[1], a[2], a[3], b[0], b[1], b[2], b[3]};
}
__device__ __forceinline__ void ret_stage_v(Frame& F, const bf16* RV, int t0, int h, LAS bf16* Vr) {
#pragma unroll
    for (int q = 0; q < 4; ++q) { const int p = F.tid + 512 * q, j = p >> 4, ec = p & 15; *(LAS v4u*)(Vr + j * RT_VP + 8 * ec) = *(const GAS v4u*)(RV + (size_t)(t0 + j) * 512 + 128 * h + 8 * ec); }
}
__device__ __forceinline__ void p_ret_kv(Frame& F, const bf16* RK, const bf16* RV, float* KVT) {
    LAS bf16* Vr = (LAS bf16*)(F.lds + RING_OFF); LAS bf16* Kd = Vr + 128 * RT_VP;
    const int er = F.lane & 15, g = F.lane >> 4;
    for (int u = F.vcu; u < 512; u += F.G) {
        const int bh = u >> 6, n = u & 63, b = bh >> 2, h = bh & 3, t0 = b * SEQ + n * 128; const float l2g = ret_log2g(h);
        ret_stage_v(F, RV, t0, h, Vr);
#pragma unroll
        for (int q = 0; q < 2; ++q) { const int p = F.tid + 512 * q, j = p >> 3, dc = p & 7; const v4u raw = *(const GAS v4u*)(RK + (size_t)(t0 + j) * 256 + 64 * h + 8 * dc); const float dec = exp2f((float)(127 - j) * l2g);
            v4u o;
#pragma unroll
            for (int k = 0; k < 4; ++k) o[k] = pk2(__uint_as_float(raw[k] << 16) * dec, __uint_as_float(raw[k] & 0xffff0000u) * dec);
            *(LAS v4u*)(Kd + j * RT_KP + 8 * dc) = o; }
        __syncthreads();
        f32x4 acc[4];
#pragma unroll
        for (int dt = 0; dt < 4; ++dt) acc[dt] = (f32x4){0.f, 0.f, 0.f, 0.f};
#pragma unroll
        for (int ks = 0; ks < 4; ++ks) { const int tA = 32 * ks + 8 * g; const bf16x8 a = ret_tr8(Vr, RT_VP, tA, tA + 4, 16 * F.wave, F.lane);
#pragma unroll
            for (int dt = 0; dt < 4; ++dt) { const bf16x8 bb = ret_tr8(Kd, RT_KP, tA, tA + 4, 16 * dt, F.lane); acc[dt] = __builtin_amdgcn_mfma_f32_16x16x32_bf16(a, bb, acc[dt], 0, 0, 0); } }
        float* out = KVT + (size_t)u * 8192;
#pragma unroll
        for (int dt = 0; dt < 4; ++dt)
#pragma unroll
            for (int r = 0; r < 4; ++r) out[(16 * F.wave + 4 * g + r) * 64 + 16 * dt + er] = acc[dt][r];
        __syncthreads();
    }
}
__device__ __forceinline__ void p_ret_scan(Frame& F, const float* KVT, bf16* PREVT, int item) {
    { const int idx = item * 512 + F.tid;
        const int bh = idx >> 13, ed = idx & 8191, h = bh & 3; const float cd = exp2f(128.0f * ret_log2g(h));
        const float* src = KVT + (size_t)bh * 64 * 8192 + ed; bf16* dst = PREVT + (size_t)bh * 64 * 8192 + ed; float st = 0.f;
#pragma unroll 32
        for (int n = 0; n < 64; ++n) { dst[(size_t)n * 8192] = (bf16)f2bf(st); st = st * cd + src[(size_t)n * 8192]; }
    }
}
__device__ __forceinline__ void p_ret_out(Frame& F, const bf16* RQ, const bf16* RK, const bf16* RV, const bf16* RGs, const bf16* PREVT, const float* gret, bf16* Y) {
    const int lc = F.lane & 15, g = F.lane >> 4, uh = F.wave >> 2, wl = F.wave & 3;
    LAS bf16* Vr = (LAS bf16*)(F.lds + RING_OFF) + uh * (128 * RT_VP);
    for (int u0 = F.vcu; u0 < 256; u0 += F.G) {
        const int u = u0 + 256 * uh;
        const int bh = u >> 6, n = u & 63, b = bh >> 2, h = bh & 3, t0 = b * SEQ + n * 128; const float l2g = ret_log2g(h);
        { const int th = F.tid & 255;
#pragma unroll
            for (int q = 0; q < 8; ++q) { const int p = th + 256 * q, j = p >> 4, ec = p & 15; *(LAS v4u*)(Vr + j * RT_VP + 8 * ec) = *(const GAS v4u*)(RV + (size_t)(t0 + j) * 512 + 128 * h + 8 * ec); } }
        __syncthreads();
        const bf16* pv = PREVT + (size_t)u * 8192;
#pragma unroll 1
        for (int tbi = 0; tbi < 2; ++tbi) {
            const int w = 2 * wl + tbi;
            bf16x8 qf[2];
#pragma unroll
            for (int ks = 0; ks < 2; ++ks) qf[ks] = *(const GAS bf16x8*)(RQ + (size_t)(t0 + 16 * w + lc) * 256 + 64 * h + 32 * ks + 8 * g);
            bf16x8 kf[8][2];
#pragma unroll
            for (int jt = 0; jt < 8; ++jt)
#pragma unroll
                for (int ks = 0; ks < 2; ++ks) { kf[jt][ks] = (bf16x8){0, 0, 0, 0, 0, 0, 0, 0}; if (jt <= w) kf[jt][ks] = *(const GAS bf16x8*)(RK + (size_t)(t0 + 16 * jt + lc) * 256 + 64 * h + 32 * ks + 8 * g); }
            f32x4 accC[8], accI[8];
#pragma unroll
            for (int et = 0; et < 8; ++et) { accC[et] = (f32x4){0.f, 0.f, 0.f, 0.f}; accI[et] = (f32x4){0.f, 0.f, 0.f, 0.f};
#pragma unroll
                for (int ks = 0; ks < 2; ++ks) { const bf16x8 a = *(const GAS bf16x8*)(pv + (16 * et + lc) * 64 + 32 * ks + 8 * g); accC[et] = __builtin_amdgcn_mfma_f32_16x16x32_bf16(a, qf[ks], accC[et], 0, 0, 0); } }
            const int iloc = 16 * w + lc;
#pragma unroll
            for (int kp = 0; kp < 4; ++kp) if (kp <= (w >> 1)) {
                unsigned pk[4];
#pragma unroll
                for (int half = 0; half < 2; ++half) { const int jt = 2 * kp + half; f32x4 s = (f32x4){0.f, 0.f, 0.f, 0.f};
                    if (jt <= w) {
#pragma unroll
                        for (int ks = 0; ks < 2; ++ks) s = __builtin_amdgcn_mfma_f32_16x16x32_bf16(kf[jt][ks], qf[ks], s, 0, 0, 0);
#pragma unroll
                        for (int r = 0; r < 4; ++r) { const int jloc = 16 * jt + 4 * g + r; s[r] = (iloc >= jloc) ? s[r] * exp2f((float)(iloc - jloc) * l2g) : 0.f; }
                    }
                    pk[2 * half] = pg8::cvt_pk_bf16(s[0], s[1]); pk[2 * half + 1] = pg8::cvt_pk_bf16(s[2], s[3]); }
                const bf16x8 pb = __builtin_bit_cast(bf16x8, (v4u){pk[0], pk[1], pk[2], pk[3]});
#pragma unroll
                for (int et = 0; et < 8; ++et) { const bf16x8 a = ret_tr8(Vr, RT_VP, 32 * kp + 4 * g, 32 * kp + 16 + 4 * g, 16 * et, F.lane);
                    accI[et] = __builtin_amdgcn_mfma_f32_16x16x32_bf16(a, pb, accI[et], 0, 0, 0); }
            }
            const float qd = exp2f((float)(iloc + 1) * l2g); float ss = 0.f;
#pragma unroll
            for (int et = 0; et < 8; ++et) { accI[et] = accI[et] + accC[et] * qd; ss += (accI[et][0] * accI[et][0] + accI[et][1] * accI[et][1]) + (accI[et][2] * accI[et][2] + accI[et][3] * accI[et][3]); }
            ss += __shfl_xor(ss, 16); ss += __shfl_xor(ss, 32);
            const float rstd = __builtin_amdgcn_rsqf(ss * (1.0f / 128.0f) + EPS);
            const size_t rowo = (size_t)(t0 + iloc);
#pragma unroll
            for (int et = 0; et < 8; ++et) { const int e = 16 * et + 4 * g; const f32x4 gg = *(const f32x4*)(gret + 128 * h + e);
                const unsigned long long rg_ = *(const GAS unsigned long long*)(RGs + rowo * 512 + 128 * h + e);
                const float r0 = __uint_as_float((unsigned)rg_ << 16), r1 = __uint_as_float((unsigned)rg_ & 0xffff0000u), r2 = __uint_as_float((unsigned)(rg_ >> 32) << 16), r3 = __uint_as_float((unsigned)(rg_ >> 32) & 0xffff0000u);
                const unsigned long long o = (unsigned long long)pk2(accI[et][0] * rstd * gg.x * r0, accI[et][1] * rstd * gg.y * r1) | ((unsigned long long)pk2(accI[et][2] * rstd * gg.z * r2, accI[et][3] * rstd * gg.w * r3) << 32);
                *(GAS unsigned long long*)(Y + rowo * D_MODEL + 128 * h + e) = o; }
        }
        __syncthreads();
    }
}
struct Args { const float* in[21]; float* out; unsigned char* ws; int ph_lo, ph_hi; };
typedef const __attribute__((address_space(4))) Args* kargs_t;
#define KARGS() ({ unsigned long long p_ = (unsigned long long)__builtin_amdgcn_kernarg_segment_ptr(); asm volatile("" : "+s"(p_)); (kargs_t)p_; })
__global__ void __launch_bounds__(NWAVES * 64, 2) trunk_fwd(Args args_unused) {
    extern __shared__ __attribute__((aligned(16))) unsigned char lds[];
    Frame F;
    F.lds = (LAS unsigned char*)lds;
    F.MISC = (volatile LAS unsigned*)(F.lds + MISC_OFF);
    F.tid = threadIdx.x; F.lane = F.tid & 63; F.wave = __builtin_amdgcn_readfirstlane(F.tid >> 6);
    F.G = gridDim.x; { const int bx = blockIdx.x; F.vcu = (F.G % 8 == 0) ? (bx % 8) * (F.G / 8) + bx / 8 : bx; }
    F.ctl = nullptr;
    for (int u = F.tid; u < (LDS_BYTES - LDSCTL_OFF) / 4; u += NWAVES * 64) ((LAS unsigned*)(F.lds + LDSCTL_OFF))[u] = 0u;
    __syncthreads();
    { kargs_t A = KARGS(); (void)xcd_barrier_post((unsigned*)(A->ws + WS_CTL) + CW_BAR, F.MISC + 8); }
#define GRID_BAR() do { kargs_t A_ = KARGS(); XcdBarrier b_; b_.bar = (unsigned*)(A_->ws + WS_CTL) + CW_BAR; b_.x = xb_xcc_id(); b_.st = F.MISC + 8; xcd_barrier(b_); } while (0)
#define WSP(T, off) ((T*)(ws + (off)))
#define LAUNDER_F() do { asm volatile("" : "+v"(F.tid)); F.lane = F.tid & 63; F.wave = __builtin_amdgcn_readfirstlane(F.tid >> 6); } while (0)
#ifndef ALIGN_F1
#define ALIGN_F1 true
#endif
#ifndef ALIGN_IP
#define ALIGN_IP true
#endif
#define CONV_IN(A_) In Ic; Ic.attn_g = (A_)->in[2]; Ic.w_in = (A_)->in[3]; Ic.wmemkv = (A_)->in[10]; Ic.w_out = (A_)->in[12]; Ic.ffn_g = (A_)->in[13]; Ic.dwg = (A_)->in[14]; Ic.dwu = (A_)->in[15]; Ic.dwd = (A_)->in[16]; Ic.ewg = (A_)->in[18]; Ic.ewu = (A_)->in[19]; Ic.ewd = (A_)->in[20];
#define XLDS ((unsigned)(RING_OFF + 131072))
#ifdef PROBE_T
    unsigned long long tacc_ = 0ull, ts_ = 0ull;
#define TSTART(p) do { if (PROBE_T == (p)) ts_ = __builtin_amdgcn_s_memrealtime(); } while (0)
#define TEND(p) do { if (PROBE_T == (p)) tacc_ += __builtin_amdgcn_s_memrealtime() - ts_; } while (0)
#else
#define TSTART(p) do { } while (0)
#define TEND(p) do { } while (0)
#endif
#if defined(PROBE_T) && defined(PROBE_EPI)
#define EPIACC(p) const unsigned long long te_ =
#define EPIEND(p) if (PROBE_T == 100 + (p)) tacc_ += te_;
#else
#define EPIACC(p) (void)
#define EPIEND(p)
#endif

#ifndef SKIP_PRO
    TSTART(9);
    { LAUNDER_F(); kargs_t A = KARGS(); In I; I.x = A->in[0]; I.mem = A->in[1]; I.attn_g = A->in[2]; I.w_in = A->in[3]; I.fqg = A->in[5]; I.fkg = A->in[6]; I.mqg = A->in[7]; I.mkg = A->in[8]; I.memg = A->in[9];
        I.wmemkv = A->in[10]; I.w_out = A->in[12]; I.ffn_g = A->in[13]; I.router = A->in[17]; I.dwg = A->in[14]; I.dwu = A->in[15]; I.dwd = A->in[16]; I.ewg = A->in[18]; I.ewu = A->in[19]; I.ewd = A->in[20];
        p_prologue(F, I, A->ws); }
    GRID_BAR();
    TEND(9);

#endif
            for (int l = 0; l < DEPTH; ++l) {
#ifndef SKIP_P0
        if (l == 2) { TSTART(0); { LAUNDER_F(); kargs_t A = KARGS(); unsigned char* ws = A->ws;
            build_tab((LAS int*)(F.lds + GTAB_OFF), (const gu32*)(ws + WS_CTL) + CW_CNT + 64 * ((l - 1) >> 1));
            p_combine(F, WSP(bf16, WS_XB), WSP(const bf16, WS_YD), WSP(const TokRoute, WS_GATEW), (const LAS int*)(F.lds + GTAB_OFF), WSP(float, WS_SSA), nullptr, false); }
            GRID_BAR(); TEND(0); }
        #endif
#ifndef SKIP_P1
        TSTART(1);
        { LAUNDER_F(); kargs_t A = KARGS(); unsigned char* ws = A->ws;
            pg8::Gemm g{WSP(bf16, WS_XB), (const bf16*)(ws + WS_WIN + l * SZ_WIN), D_MODEL * 2, 0, (const bf16*)(ws + WS_MEMN) + (size_t)l * M_MEM * D_MODEL, M_TOK / 256};
            pg8::TileOrder S{M_TOK / 256, NIN / 256, F.G, (int)blockIdx.x, M_TOK / 256, NIN / 256, 2, 2};
            pg8::EpiInProj E{ws, A->in[4] + l * 4, WSP(float, WS_GAINS) + l * 256, WSP(float, WS_SSA)};
            EPIACC(1) pg8::gemm_phase<pg8::EpiInProj, pg8::TileOrder, ALIGN_IP, true, false, false>(F.lds + RING_OFF, g, S, E); EPIEND(1)
        }
        if (l < 3) { LAUNDER_F(); kargs_t A = KARGS(); CONV_IN(A); p_convert_tail(F, Ic, A->ws, l == 0 ? 2 : 1, l == 0 ? DS2_IP0 : l == 1 ? DS_IP1 : DS_IP2, DC_IP, DQ_IP); }
        GRID_BAR(); TEND(1);
        #endif
#ifndef SKIP_P2
        TSTART(2);
        { LAUNDER_F(); kargs_t A = KARGS(); unsigned char* ws = A->ws; p_cumsum(F, WSP(float, WS_LOGF), WSP(float, WS_CB)); p_ret_kv(F, WSP(bf16, WS_RK), WSP(bf16, WS_RV), WSP(float, WS_KVT)); }
        GRID_BAR(); TEND(2);
        #endif
#ifndef SKIP_P3
        TSTART(3);
        {
            for (int uu = F.vcu; uu < 256; uu += F.G) { const int bh = uu >> 5, qb = uu & 31;
                { LAUNDER_F(); kargs_t A = KARGS(); unsigned char* ws = A->ws;
                attn_body::attn_unit<8, true>(bh >> 2, bh & 3, qb, WSP(const attn_body::bf16, WS_FQ), WSP(const attn_body::bf16, WS_FK), WSP(const attn_body::bf16, WS_FV), WSP(attn_body::bf16, WS_Y), 512, A->in[11] + l * D_MODEL + 512, WSP(float, WS_CB) + (size_t)bh * SEQ, WSP(float, WS_GAINS) + l * 256, (char*)lds + RING_OFF); }
            }
            for (;;) {
                if (F.tid == 0) { kargs_t A = KARGS(); F.MISC[16] = __hip_atomic_fetch_add((unsigned*)(A->ws + WS_CTL) + CW_MEMQ + 64 * l, 1u, RLX_AGENT); }
                __syncthreads(); const int uu = (int)F.MISC[16]; __syncthreads();
                if (uu >= 256 + 128) break;
                if (uu < 128) { LAUNDER_F(); kargs_t A = KARGS(); unsigned char* ws = A->ws; p_ret_scan(F, WSP(float, WS_KVT), WSP(bf16, WS_PREVT), uu); continue; }
                const int bh = (uu - 128) >> 5, qb = (uu - 128) & 31;
                { LAUNDER_F(); kargs_t A = KARGS(); unsigned char* ws = A->ws;
                attn_body::attn_unit<8, false>(bh >> 2, bh & 3, qb, WSP(const attn_body::bf16, WS_MQ), WSP(const attn_body::bf16, WS_MK), WSP(const attn_body::bf16, WS_MV), WSP(attn_body::bf16, WS_Y), 768, A->in[11] + l * D_MODEL + 768, nullptr, nullptr, (char*)lds + RING_OFF); }
            }
        }
        GRID_BAR(); TEND(3);
        #endif
#ifndef SKIP_P4
        TSTART(4);
        { LAUNDER_F(); kargs_t A = KARGS(); unsigned char* ws = A->ws;
            p_ret_out(F, WSP(bf16, WS_RQ), WSP(bf16, WS_RK), WSP(bf16, WS_RV), WSP(bf16, WS_RG), WSP(bf16, WS_PREVT), A->in[11] + l * D_MODEL, WSP(bf16, WS_Y)); }
        GRID_BAR(); TEND(4);
        #endif
#ifndef SKIP_P5
        TSTART(5);
        { LAUNDER_F(); kargs_t A = KARGS(); unsigned char* ws = A->ws;
            pg8::Gemm g{WSP(bf16, WS_Y), (const bf16*)(ws + WS_WOUT + l * SZ_WOUT), D_MODEL * 2, 0, WSP(bf16, WS_Y), 1 << 30};
            pg8::TileOrder S{M_TOK / 256, D_MODEL / 256, F.G, (int)blockIdx.x, 0, 0, 0, 0};
            pg8::EpiDown E{WSP(bf16, WS_XB), WSP(float, WS_SSF), WSP(bf16, WS_YD), XLDS, false, 1.0f, (l & 1) != 0, ws + WS_X8, WSP(const bf16, WS_WRT) + (size_t)(l >> 1) * 16 * D_MODEL, WSP(float, WS_LOGP)};
            EPIACC(5) pg8::gemm_phase<pg8::EpiDown, pg8::TileOrder, true, true, false, false>(F.lds + RING_OFF, g, S, E); EPIEND(5)
        }
        GRID_BAR(); TEND(5);
        #endif
#ifndef SKIP_P6
        if (l & 1) { TSTART(6); { LAUNDER_F(); kargs_t A = KARGS(); unsigned char* ws = A->ws; const int j2 = l >> 1;
            p_route2(F, WSP(const float, WS_LOGP), WSP(const float, WS_SSF), (gu32*)(ws + WS_CTL) + CW_CNT + 64 * j2, WSP(int, WS_LIST), WSP(TokRoute, WS_GATEW), WSP(float, WS_RSS)); }
            GRID_BAR(); TEND(6); }
        #endif
#ifndef SKIP_P7
        TSTART(7);
        { LAUNDER_F(); kargs_t A = KARGS(); unsigned char* ws = A->ws; const int j2 = l >> 1; const bool moe = (l & 1) != 0;
            pg8::GroupedOrder S; S.init(F.G, (int)blockIdx.x, NGU / 256, (LAS int*)(F.lds + GTAB_OFF), moe ? (const unsigned*)(ws + WS_CTL) + CW_CNT + 64 * j2 : nullptr, WSP(int, WS_LIST));
            if (FP8_MOE_GU && moe) {
                pg8::Gemm g{ws + WS_X8, (const void*)(ws + WS_EGU + (size_t)j2 * 8 * SZ_EGU), D_MODEL, SZ_EGU, ws + WS_X8, 1 << 30};
                pg8::EpiSwiGLU<true> E{ws + WS_HF, WSP(const float, WS_SSF), WSP(const float, WS_RSS), false};
                EPIACC(7) pg8::gemm_phase<pg8::EpiSwiGLU<true>, pg8::GroupedOrder, ALIGN_F1, true, true, true>(F.lds + RING_OFF, g, S, E); EPIEND(7)
            } else {
                pg8::Gemm g{WSP(bf16, WS_XB), moe ? (const void*)(ws + WS_EGU + (size_t)j2 * 8 * SZ_EGU) : (const void*)(ws + WS_WGU + (size_t)j2 * SZ_WGU), D_MODEL * 2, moe ? SZ_EGU : 0, WSP(bf16, WS_XB), 1 << 30};
                pg8::EpiSwiGLU<false> E{ws + WS_HF, WSP(const float, WS_SSF), WSP(const float, WS_RSS), !moe};
                EPIACC(7) pg8::gemm_phase<pg8::EpiSwiGLU<false>, pg8::GroupedOrder, ALIGN_F1, true, true, false>(F.lds + RING_OFF, g, S, E); EPIEND(7)
            }
        }
        if (l == 0 || l == 2) { LAUNDER_F(); kargs_t A = KARGS(); CONV_IN(A); p_convert_tail(F, Ic, A->ws, l == 0 ? 2 : 1, l == 0 ? DS2_F0 : DS_F2, DC_F, DQ_F); }
        if (l == 1) { LAUNDER_F(); kargs_t A = KARGS(); CONV_IN(A); p_convert_tail(F, Ic, A->ws, 1, DS_M1, DC_M1, DQ_M1); }
        GRID_BAR(); TEND(7);
        #endif
#ifndef SKIP_P8
        TSTART(8);
        { LAUNDER_F(); kargs_t A = KARGS(); unsigned char* ws = A->ws; const int j2 = l >> 1; const bool moe = (l & 1) != 0;
            pg8::GroupedOrder S; S.init(F.G, (int)blockIdx.x, D_MODEL / 256, (LAS int*)(F.lds + GTAB_OFF), moe ? (const unsigned*)(ws + WS_CTL) + CW_CNT + 64 * j2 : nullptr, WSP(int, WS_LIST));
            pg8::Gemm g{WSP(bf16, WS_HF), moe ? (const void*)(ws + WS_EDN + (size_t)j2 * 8 * SZ_WDN) : (const void*)(ws + WS_WDN + (size_t)j2 * SZ_WDN), FFP * FES_DN, moe ? SZ_WDN : 0, WSP(bf16, WS_HF), 1 << 30};
            pg8::EpiDown E{WSP(bf16, WS_XB), WSP(float, WS_SSA), WSP(bf16, WS_YD), XLDS, moe, FP8_DN ? 1.0f / (SW_DN * SA_HF) : 1.0f, false, ws + WS_X8, WSP(const bf16, WS_WRT), WSP(float, WS_LOGP)};
            EPIACC(8) pg8::gemm_phase<pg8::EpiDown, pg8::GroupedOrder, true, true, false, FP8_DN != 0>(F.lds + RING_OFF, g, S, E); EPIEND(8)
        }
        if (l == 1) { LAUNDER_F(); kargs_t A = KARGS(); CONV_IN(A); p_convert_tail(F, Ic, A->ws, 3, 0, DC_D1, DQ_D1X); p_convert_tail(F, Ic, A->ws, 1, DS_D1, DC_D1, DQ_D1); }
        GRID_BAR(); TEND(8);
#endif
            }
#ifndef SKIP_FIN
    TSTART(10);
    { LAUNDER_F(); kargs_t A = KARGS(); unsigned char* ws = A->ws;
        build_tab((LAS int*)(F.lds + GTAB_OFF), (const gu32*)(ws + WS_CTL) + CW_CNT + 64 * ((DEPTH - 1) >> 1));
        p_combine(F, WSP(bf16, WS_XB), WSP(const bf16, WS_YD), WSP(const TokRoute, WS_GATEW), (const LAS int*)(F.lds + GTAB_OFF), nullptr, A->out, true); }
    TEND(10);
#endif
        #ifdef PROBE_T
    if (blockIdx.x == 0) { const unsigned long long t1_ = __builtin_amdgcn_s_memrealtime() + (unsigned long long)PROBE_K * tacc_; while (__builtin_amdgcn_s_memrealtime() < t1_) __builtin_amdgcn_s_sleep(32); }
#endif
#undef GRID_BAR
#undef WSP
}

extern "C" void kernel_launch(void* const* d_in, const int* in_sizes, int n_in, void* d_out, int out_size, void* d_ws, size_t ws_size, hipStream_t stream) {
    static int grid = 0;
    if (grid == 0) {
        if (n_in != 21 || in_sizes[0] != M_TOK * D_MODEL || out_size != M_TOK * D_MODEL || ws_size < WS_END) {
            fprintf(stderr, "kernel_launch: built for 21 inputs, x/out of %d floats, >= %zu bytes of workspace; got n_in %d, in0 %d, out %d, ws %zu; nothing launched\n", M_TOK * D_MODEL, (size_t)WS_END, n_in, n_in > 0 ? in_sizes[0] : -1, out_size, ws_size); grid = -1; return; }
        int dev = 0, cus = 0, per_cu = 0;
        if (hipGetDevice(&dev) != hipSuccess || hipDeviceGetAttribute(&cus, hipDeviceAttributeMultiprocessorCount, dev) != hipSuccess) { fprintf(stderr, "kernel_launch: device query failed\n"); grid = -1; return; }
        if (hipFuncSetAttribute((const void*)trunk_fwd, hipFuncAttributeMaxDynamicSharedMemorySize, LDS_BYTES) != hipSuccess) { fprintf(stderr, "kernel_launch: hipFuncSetAttribute failed\n"); grid = -1; return; }
        if (hipOccupancyMaxActiveBlocksPerMultiprocessor(&per_cu, (const void*)trunk_fwd, NWAVES * 64, LDS_BYTES) != hipSuccess || per_cu < 1)
            fprintf(stderr, "kernel_launch: note: occupancy query reports %d workgroups per CU\n", per_cu);
        (void)hipGetLastError();
        grid = cus;
        if (grid > 256) grid = 256;
    }
    if (grid < 0) return;
    if (hipMemsetAsync((char*)d_ws + WS_CTL, 0, CTL_ZERO_BYTES, stream) != hipSuccess) { fprintf(stderr, "kernel_launch: hipMemsetAsync failed\n"); return; }
    Args a{};
    for (int i = 0; i < 21; ++i) a.in[i] = (const float*)d_in[i];
    a.out = (float*)d_out; a.ws = (unsigned char*)d_ws;
    a.ph_lo = 0; a.ph_hi = 0;
    hipLaunchKernelGGL(trunk_fwd, dim3(grid), dim3(NWAVES * 64), LDS_BYTES, stream, a);
    const hipError_t le = hipPeekAtLastError();
    if (le != hipSuccess) fprintf(stderr, "kernel_launch: launch failed: %s\n", hipGetErrorName(le));
}
```

```cpp
#include <hip/hip_runtime.h>
#include <hip/hip_bf16.h>
#include <cstdio>
#include <cstdint>
#include <cmath>

constexpr int D_MODEL = 1024, BATCH = 2, SEQ = 8192, DEPTH = 4, M_TOK = BATCH * SEQ;
constexpr int MEM_LEN = 256, M_MEM = BATCH * MEM_LEN;
constexpr int D_FF = 2752, FFP = 2816  , NGU = 2 * FFP  ;
constexpr int N_EXPERTS = 8, IN_COLS = 2564, NIN = 2816  , NINKV = NIN + 512  ;
constexpr float EPS = 1e-6f;
constexpr int NWAVES = 8;

constexpr size_t MiB = 1u << 20;
#ifdef PROBE_T
constexpr size_t WS_CTL = 0, CTL_ZERO_BYTES = 1 * MiB;
#else
constexpr size_t WS_CTL = 0, CTL_ZERO_BYTES = 128 * 1024;
#endif
#ifndef FP8_GU
#define FP8_GU 0
#endif
#ifndef FP8_DN
#define FP8_DN 1
#endif
constexpr int FES_GU = FP8_GU ? 1 : 2, FES_DN = FP8_DN ? 1 : 2;
#ifndef FP8_MOE_GU
#define FP8_MOE_GU 1
#endif
static_assert(FP8_GU == 0, "dense fp8 gate|up: not wired");
constexpr float SW_GU = 64.0f;
#ifndef DENSE_FP8_MASK
#define DENSE_FP8_MASK 3
#endif
constexpr int FES_EGU = FP8_MOE_GU ? 1 : 2;
constexpr float SW_DN = 64.0f;
constexpr float SA_HB = 8.0f, SA_HF = 4.0f;
constexpr size_t SZ_WIN = (size_t)NINKV * D_MODEL * 2, SZ_WOUT = (size_t)D_MODEL * D_MODEL * 2, SZ_WGU = (size_t)NGU * D_MODEL * FES_GU, SZ_WDN = (size_t)D_MODEL * FFP * FES_DN;
constexpr size_t WS_WIN = 1 * MiB;
constexpr size_t WS_WOUT = WS_WIN + 4 * SZ_WIN;
constexpr size_t WS_WGU = WS_WOUT + 4 * SZ_WOUT;
constexpr size_t WS_WDN = WS_WGU + 2 * SZ_WGU;
constexpr size_t WS_EGU = WS_WDN + 2 * SZ_WDN;
constexpr size_t SZ_EGU = (size_t)NGU * D_MODEL * FES_EGU;
constexpr size_t WS_EDN = WS_EGU + 16 * SZ_EGU;
constexpr size_t WS_XB = WS_EDN + 16 * SZ_WDN;
constexpr size_t WS_X8 = WS_XB + (size_t)M_TOK * D_MODEL * 2;
constexpr size_t WS_MEMN = WS_X8 + (size_t)M_TOK * D_MODEL;
constexpr size_t WS_SSA = WS_MEMN + (size_t)4 * M_MEM * D_MODEL * 2;
constexpr size_t WS_SSF = WS_SSA + (size_t)M_TOK * 4 * 4;
constexpr size_t WS_LIST = WS_SSF + (size_t)M_TOK * 4 * 4;
constexpr size_t WS_GATEW = WS_LIST + (size_t)N_EXPERTS * 16384 * 4;
constexpr size_t WS_RSS = WS_GATEW + (size_t)N_EXPERTS * 16384 * 4;
constexpr size_t WS_WRT = WS_RSS + (size_t)N_EXPERTS * 16384 * 4;
constexpr size_t WS_LOGP = WS_WRT + (size_t)2 * 16 * D_MODEL * 2;
constexpr size_t WS_LOGF = WS_LOGP + (size_t)M_TOK * 16 * 8 * 4;
constexpr size_t WS_CB = WS_LOGF + (size_t)8 * SEQ * 4;
constexpr size_t WS_MK = WS_CB + (size_t)8 * SEQ * 4;
constexpr size_t WS_MV = WS_MK + (size_t)M_MEM * 256 * 2;
constexpr size_t WS_INVGU = WS_MV + (size_t)M_MEM * 256 * 2;
constexpr size_t WS_INVDN = WS_INVGU + (size_t)18 * NGU * 4;
constexpr size_t WS_GAINS = WS_INVDN + (size_t)18 * D_MODEL * 4;
constexpr size_t WS_U = WS_GAINS + 4096;
constexpr size_t WS_RQ = WS_U, WS_RK = WS_RQ + (size_t)M_TOK * 256 * 2, WS_RV = WS_RK + (size_t)M_TOK * 256 * 2, WS_RG = WS_RV + (size_t)M_TOK * 512 * 2;
constexpr size_t WS_FQ = WS_RG + (size_t)M_TOK * 512 * 2, WS_FK = WS_FQ + (size_t)M_TOK * 256 * 2, WS_FV = WS_FK + (size_t)M_TOK * 256 * 2, WS_MQ = WS_FV + (size_t)M_TOK * 256 * 2;
constexpr size_t WS_KVT = WS_MQ + (size_t)M_TOK * 256 * 2;
constexpr size_t WS_PREVT = WS_KVT + (size_t)512 * 128 * 64 * 4;
constexpr size_t WS_Y = WS_PREVT + (size_t)512 * 128 * 64 * 2;
constexpr size_t WS_UEND_MIX = WS_Y + (size_t)M_TOK * D_MODEL * 2;
constexpr int HF_ROWS = 2 * M_TOK + N_EXPERTS * 256;
constexpr size_t WS_HF = WS_U;
constexpr size_t WS_UEND_HF = WS_HF + (size_t)HF_ROWS * FFP * FES_DN;
constexpr size_t WS_YD = (WS_UEND_HF > WS_UEND_MIX ? WS_UEND_HF : WS_UEND_MIX);
constexpr size_t WS_END = WS_YD + (size_t)HF_ROWS * D_MODEL * 2;
constexpr int CW_BAR = 4096;
constexpr int CW_CMAX_GU = 16384, CW_CMAX_DN = CW_CMAX_GU + 18 * NGU;
constexpr int CW_MEMQ = 12288;
constexpr int CW_SCN = 14336;
static_assert((size_t)(CW_SCN + 2048) * 4 <= 128 * 1024, "CTL words inside the memset region");
constexpr int CW_CNT = 8192;
__device__ __forceinline__ int hw_lane() { int l; asm volatile("v_mbcnt_lo_u32_b32 %0, -1, 0\n\tv_mbcnt_hi_u32_b32 %0, -1, %0" : "=v"(l)); return l; }

namespace pg8 {
#define PG8_LAS __attribute__((address_space(3)))
typedef unsigned short bf16_t;
typedef short bf16x8 __attribute__((ext_vector_type(8)));
typedef float f32x4 __attribute__((ext_vector_type(4)));
typedef unsigned u32x4 __attribute__((ext_vector_type(4)));
typedef short bf16x16 __attribute__((ext_vector_type(16)));
constexpr int BM = 256, BK = 64, HALF = 128, HTB = HALF * BK * 2  , STAGE_BYTES = 8 * HTB, NXCD = 8, WGM = 8;

__host__ __device__ __forceinline__ int lds_byte(int r, int c) { const int st = (r >> 4) * 2 + (c >> 5), rr = r & 15, cc = c & 31, ob = rr * 64 + cc * 2; return st * 1024 + (ob ^ (((ob >> 9) & 1) << 5)); }
__host__ __device__ __forceinline__ void stage_rc(int b, int& R, int& C) { const int st = b / 1024, sb = b % 1024, swz = sb ^ (((sb >> 9) & 1) << 5); R = (st >> 1) * 16 + swz / 64; C = (st & 1) * 32 + (swz % 64) / 2; }
__host__ __device__ __forceinline__ int perm32(int rho) { const int n = rho >> 4, i = rho & 15; return 8 * (i >> 2) + 4 * n + (i & 3); }

struct Unit { int pm, pn, e, lt, cnt; };
struct Gemm { const void* A; const void* Bt; int KB; size_t bstride; const void* A2; int pm2; };
typedef int i32x8 __attribute__((ext_vector_type(8)));

__device__ __forceinline__ unsigned cvt_pk_bf16(float lo, float hi) { unsigned r; asm volatile("v_cvt_pk_bf16_f32 %0, %1, %2" : "=v"(r) : "v"(lo), "v"(hi)); return r; }

__device__ __forceinline__ bool static_tile(int i, int G, int c, int nM, int nN, int& pm, int& pn) {
    const int nwg = nM * nN; const long L = (long)i * G + c; if (L >= nwg) return false;
    int wgid = (int)L; { const int q = nwg / NXCD, r = nwg % NXCD, xcd = wgid % NXCD, off = wgid / NXCD; wgid = (xcd < r ? xcd * (q + 1) : r * (q + 1) + (xcd - r) * q) + off; }
    const int nig = WGM * nN, gid = wgid / nig, fm = gid * WGM, gsz = (nM - fm) < WGM ? (nM - fm) : WGM;
    pm = fm + ((wgid % nig) % gsz); pn = (wgid % nig) / gsz; return true;
}

__device__ __forceinline__ bool pg8_tab_next(const PG8_LAS int* p, Unit& u) {
    typedef int i32x4t __attribute__((ext_vector_type(4)));
    const i32x4t a = *(const PG8_LAS i32x4t*)p; const int c_ = p[4];
    const int pm = __builtin_amdgcn_readfirstlane(a[0]); if (pm < 0) return false;
    u.pm = pm; u.pn = __builtin_amdgcn_readfirstlane(a[1]); u.e = __builtin_amdgcn_readfirstlane(a[2]); u.lt = __builtin_amdgcn_readfirstlane(a[3]); u.cnt = __builtin_amdgcn_readfirstlane(c_); return true;
}
template <class Epi, class Sched, bool ALIGN_EPI, bool SP2, bool GATHER, bool FP8>
__device__ __forceinline__ unsigned long long gemm_phase(PG8_LAS unsigned char* lds, const Gemm g, const Sched& S, const Epi& E, int tid_in) {
    unsigned long long tepi_ = 0ull;
    int tid_ = tid_in; asm volatile("" : "+v"(tid_));
    const int tid = tid_, wid = __builtin_amdgcn_readfirstlane(tid >> 6), lane = tid & 63, wr = wid >> 2, wc = wid & 3, fr = lane & 15, fq = lane >> 4;
    const int K = g.KB / 2  , nt = g.KB / (BK * 2);
    unsigned voffB[2]; unsigned vA[2][2], vN[2][2]; int RA[2], CA[2];
#pragma unroll
    for (int i = 0; i < 2; ++i) { int R, C; stage_rc(tid * 16 + i * 8192, R, C); const int Rb = Epi::PERM ? ((R & ~31) + perm32(R & 31)) : R;
        RA[i] = R; CA[i] = C; voffB[i] = (unsigned)(Rb * K + C) * 2u;
#pragma unroll
        for (int h = 0; h < 2; ++h) { vA[h][i] = (unsigned)((R + h * HALF) * K + C) * 2u; vN[h][i] = vA[h][i]; } }
    const size_t kstep = (size_t)(BK * 2);
    const size_t hstep = (size_t)HALF * K * 2;
    const size_t tstep = 2 * hstep;
    const unsigned ldsw = (unsigned)wid * 1024u;
    const int aoff = lds_byte(wr * 64 + fr, fq * 8), boff = lds_byte(wc * 32 + fr, fq * 8);
#define PG8_SA(b, h) (((b) * 2 + (h)) * HTB)
#define PG8_SB(b, h) ((4 + (b) * 2 + (h)) * HTB)
#define PG8_STAGE(bufoff, gbase, voff) do { _Pragma("unroll") for (int _i = 0; _i < 2; ++_i) \
        __builtin_amdgcn_global_load_lds((const unsigned*)((const char*)(gbase) + (voff)[_i]), (PG8_LAS unsigned*)(lds + (bufoff) + ldsw + _i * 8192), 16, 0, 0); } while (0)
#define PG8_STAGEA(b, h, kptr, vv) PG8_STAGE(PG8_SA(b, h), (GATHER ? (kptr) : (kptr) + (h) * hstep), (vv)[GATHER ? (h) : 0])
#define PG8_LDA(dst, b, h) do { _Pragma("unroll") for (int m = 0; m < 4; ++m) _Pragma("unroll") for (int k = 0; k < 2; ++k) dst[m][k] = *(const PG8_LAS bf16x8*)(lds + PG8_SA(b, h) + aoff + m * 2048 + k * 1024); } while (0)
#define PG8_LDB(dst, b, h) do { _Pragma("unroll") for (int n = 0; n < 2; ++n) _Pragma("unroll") for (int k = 0; k < 2; ++k) dst[n][k] = *(const PG8_LAS bf16x8*)(lds + PG8_SB(b, h) + boff + n * 2048 + k * 1024); } while (0)
#define PG8_CAT(x) __builtin_bit_cast(i32x8, (bf16x16){x[0][0], x[0][1], x[0][2], x[0][3], x[0][4], x[0][5], x[0][6], x[0][7], x[1][0], x[1][1], x[1][2], x[1][3], x[1][4], x[1][5], x[1][6], x[1][7]})
#define PG8_MMA(ai, bj, At, Bt) do { __builtin_amdgcn_s_setprio(1); _Pragma("unroll") for (int m = 0; m < 4; ++m) _Pragma("unroll") for (int n = 0; n < 2; ++n) { \
        if constexpr (FP8) { const i32x8 a8_ = PG8_CAT(Bt[n]), b8_ = PG8_CAT(At[m]);   \
            asm volatile("v_mfma_scale_f32_16x16x128_f8f6f4 %0, %1, %2, %0, %3, %3 op_sel_hi:[0,0,0]" : "+v"(acc[ai][bj][m][n]) : "v"(a8_), "v"(b8_), "v"(sc1_)); } \
        else { _Pragma("unroll") for (int k = 0; k < 2; ++k) acc[ai][bj][m][n] = __builtin_amdgcn_mfma_f32_16x16x32_bf16(Bt[n][k], At[m][k], acc[ai][bj][m][n], 0, 0, 0); } } \
        __builtin_amdgcn_s_setprio(0); } while (0)
#define PG8_WAIT_V(n) asm volatile("s_waitcnt vmcnt(" #n ")" ::: "memory")
#define PG8_WAIT_L(n) asm volatile("s_waitcnt lgkmcnt(" #n ")" ::: "memory")
#define PG8_BAR __builtin_amdgcn_s_barrier()
#define PG8_SCHED __builtin_amdgcn_sched_barrier(0)
    Unit cur, nxt; int ui = 0;
    constexpr unsigned UT_LDS = 131072 + 4096 + 8192; constexpr int UT_N = 16;
#define PG8_NEXT(i_, u_) ((i_) < UT_N && pg8_tab_next((const PG8_LAS int*)(size_t)(UT_LDS + (i_) * 32), u_))
    if (!S.next(0, cur)) return 0ull;
    f32x4 acc[2][2][4][2];
#pragma unroll
    for (int a = 0; a < 2; ++a)
#pragma unroll
        for (int b = 0; b < 2; ++b)
#pragma unroll
            for (int m = 0; m < 4; ++m)
#pragma unroll
                for (int n = 0; n < 2; ++n) { typedef unsigned long long u64x2z __attribute__((ext_vector_type(2))); u64x2z z_; asm volatile("v_mov_b64 %0, 0" : "=v"(z_.x)); asm volatile("v_mov_b64 %0, 0" : "=v"(z_.y)); acc[a][b][m][n] = __builtin_bit_cast(f32x4, z_); }
    bf16x8 At[4][2], B0[2][2], B1[2][2];
    int sc1_ = 0x7F7F7F7F; asm volatile("" : "+v"(sc1_));
#define PG8_ATILE(pm_) (GATHER ? (const char*)g.A : ((pm_) >= g.pm2 ? (const char*)g.A2 + (size_t)((pm_) - g.pm2) * tstep : (const char*)g.A + (size_t)(pm_) * tstep))
    const char* cA = PG8_ATILE(cur.pm); const char* cB = (const char*)g.Bt + (size_t)cur.e * g.bstride + (size_t)cur.pn * tstep;
    if constexpr (GATHER) {
#pragma unroll
        for (int i = 0; i < 2; ++i)
#pragma unroll
            for (int h = 0; h < 2; ++h) { vA[h][i] = (unsigned)(S.row_token(cur, RA[i] + h * HALF) * K + CA[i]) * 2u; vN[h][i] = vA[h][i]; }
    }
    {
        PG8_STAGE(PG8_SB(0, 0), cB, voffB); PG8_STAGE(PG8_SB(0, 1), cB + hstep, voffB); PG8_STAGEA(0, 0, cA, vA); PG8_STAGEA(0, 1, cA, vA);
        { PG8_LAS int* ut = (PG8_LAS int*)(size_t)UT_LDS;
            if (tid < UT_N) { Unit u_; const bool ok_ = S.next_lane(tid, u_); ut[tid * 8] = ok_ ? u_.pm : -1; ut[tid * 8 + 1] = u_.pn; ut[tid * 8 + 2] = u_.e; ut[tid * 8 + 3] = u_.lt; ut[tid * 8 + 4] = u_.cnt; }
            asm volatile("s_waitcnt lgkmcnt(0)" ::: "memory"); }
        if (wr == 1) PG8_BAR;
        PG8_WAIT_V(2); PG8_BAR;
        PG8_STAGE(PG8_SB(1, 0), cB + kstep, voffB); PG8_STAGEA(1, 0, cA + kstep, vA); PG8_STAGE(PG8_SB(1, 1), cB + hstep + kstep, voffB);
        PG8_WAIT_V(6); PG8_BAR;
    }
    for (;;) {
        E.prefetch(cur, wid, lane, ui & 1);
        const bool has_next = PG8_NEXT(ui + 1, nxt);
        const char* nA = has_next ? PG8_ATILE(nxt.pm) : cA;
        const char* nB = has_next ? (const char*)g.Bt + (size_t)nxt.e * g.bstride + (size_t)nxt.pn * tstep : cB;
        if constexpr (GATHER) {
            if (has_next) {
#pragma unroll
                for (int i = 0; i < 2; ++i)
#pragma unroll
                    for (int h = 0; h < 2; ++h) vN[h][i] = (unsigned)(S.row_token(nxt, RA[i] + h * HALF) * K + CA[i]) * 2u;
            }
        }
#pragma nounroll
        for (int t = 0; t < nt; t += 2) {
            const bool last = (t == nt - 2);
            const char* a1 = cA + (size_t)(t + 1) * kstep;
            const char* a2 = last ? nA : cA + (size_t)(t + 2) * kstep; const char* b2 = last ? nB : cB + (size_t)(t + 2) * kstep;
            const char* a3 = a2 + kstep; const char* b3 = b2 + kstep;
            unsigned vS[2][2];
#pragma unroll
            for (int i = 0; i < 2; ++i)
#pragma unroll
                for (int h = 0; h < 2; ++h) vS[h][i] = (GATHER && last) ? vN[h][i] : vA[h][i];
            PG8_LDB(B0, 0, 0); PG8_LDB(B1, 0, 1); PG8_SCHED; PG8_LDA(At, 0, 0); PG8_STAGEA(1, 1, a1, vA);
            PG8_WAIT_V(8); PG8_WAIT_L(0); PG8_BAR; PG8_MMA(0, 0, At, B0); PG8_MMA(0, 1, At, B1); PG8_BAR; PG8_SCHED;
            PG8_LDA(At, 0, 1); PG8_STAGE(PG8_SB(0, 0), b2, voffB); PG8_STAGE(PG8_SB(0, 1), b2 + hstep, voffB); PG8_STAGEA(0, 0, a2, vS);
            PG8_WAIT_V(8); PG8_WAIT_L(0); PG8_BAR; PG8_MMA(1, 0, At, B0); PG8_MMA(1, 1, At, B1); PG8_BAR; PG8_SCHED;
            PG8_LDB(B0, 1, 0); PG8_LDB(B1, 1, 1); PG8_SCHED; PG8_LDA(At, 1, 0); PG8_STAGEA(0, 1, a2, vS);
            PG8_WAIT_V(8); PG8_WAIT_L(0); PG8_BAR; PG8_MMA(0, 0, At, B0); PG8_MMA(0, 1, At, B1); PG8_BAR; PG8_SCHED;
            PG8_LDA(At, 1, 1); PG8_STAGE(PG8_SB(1, 0), b3, voffB); PG8_STAGE(PG8_SB(1, 1), b3 + hstep, voffB); PG8_STAGEA(1, 0, a3, vS);
            PG8_WAIT_V(8); PG8_WAIT_L(0); PG8_BAR; PG8_MMA(1, 0, At, B0); PG8_MMA(1, 1, At, B1); PG8_BAR; PG8_SCHED;
        }
        if constexpr (ALIGN_EPI) { if (wr == 0) PG8_BAR; }
        if constexpr (FP8) asm volatile("s_nop 15\n\ts_nop 7" ::: "memory");
#ifdef PROBE_EPI
        const unsigned long long te0_ = __builtin_amdgcn_s_memrealtime();
#endif
        E(acc, cur, wr, wc, fr, fq, ui & 1);
#ifdef PROBE_EPI
        tepi_ += __builtin_amdgcn_s_memrealtime() - te0_;
#endif
        if (!has_next) break;
#pragma unroll
        for (int a = 0; a < 2; ++a)
#pragma unroll
            for (int b = 0; b < 2; ++b)
#pragma unroll
                for (int m = 0; m < 4; ++m)
#pragma unroll
                    for (int n = 0; n < 2; ++n) { typedef unsigned long long u64x2z __attribute__((ext_vector_type(2))); u64x2z z_; asm volatile("v_mov_b64 %0, 0" : "=v"(z_.x)); asm volatile("v_mov_b64 %0, 0" : "=v"(z_.y)); acc[a][b][m][n] = __builtin_bit_cast(f32x4, z_); }
        cur = nxt; cA = nA; cB = nB; ++ui;
#pragma unroll
        for (int i = 0; i < 2; ++i)
#pragma unroll
            for (int h = 0; h < 2; ++h) vA[h][i] = vN[h][i];
        if constexpr (ALIGN_EPI) { if (wr == 1) PG8_BAR; }
    }
    PG8_WAIT_V(0);
    if constexpr (!ALIGN_EPI) { if (wr == 0) PG8_BAR; }
    PG8_BAR;
    return tepi_;
#undef PG8_SA
#undef PG8_SB
#undef PG8_STAGE
#undef PG8_STAGEA
#undef PG8_LDA
#undef PG8_LDB
#undef PG8_MMA
#undef PG8_NEXT
#undef PG8_ATILE
#undef PG8_CAT
#undef PG8_WAIT_V
#undef PG8_WAIT_L
#undef PG8_BAR
#undef PG8_SCHED
}
}
namespace pg8 {
constexpr int LIST_CAP = 16384;

struct TileOrder {
    int nM, nN, G, c, xM0, xN0, xM, xN;
    __device__ __forceinline__ bool next(int i, Unit& u) const {
        int pm, pn; u.e = 0; u.lt = 0; u.cnt = 0;
        if (static_tile(i, G, c, nM, nN, pm, pn)) { u.pm = pm; u.pn = pn; return true; }
        const long L = (long)i * G + c - (long)nM * nN;
        if (L < (long)xM * xN) { u.pm = xM0 + (int)(L % xM); u.pn = xN0 + (int)(L / xM); return true; }
        return false;
    }
    __device__ __forceinline__ bool next_lane(int i, Unit& u) const { return next(i, u); }
    __device__ __forceinline__ int row_token(const Unit& u, int r) const { return u.pm * BM + r; }    __device__ __forceinline__ int row_token_raw(const Unit& u, int r) const { return u.pm * BM + r; }
    __device__ __forceinline__ int row_token_fix(const Unit&, int, int raw) const { return raw; }
};

struct GroupedOrder {
    int G, c, nN, ntiles; const PG8_LAS int* tab; const int* list; bool dense;
    __device__ __forceinline__ void init(int G_, int c_, int nN_, PG8_LAS int* tab_, const unsigned* counts, const int* list_, bool thread0) { G = G_; c = c_; nN = nN_; tab = tab_; list = list_; dense = (counts == nullptr);
        __syncthreads();
        if (thread0) { int t = 0;
            for (int e = 0; e < N_EXPERTS; ++e) { int n = dense ? (e == 0 ? M_TOK : 0) : (int)__hip_atomic_load(counts + e, __ATOMIC_RELAXED, __HIP_MEMORY_SCOPE_AGENT); n = n > LIST_CAP ? LIST_CAP : n; tab_[16 + e] = n; tab_[e] = t; t += (n + BM - 1) / BM; }
            tab_[N_EXPERTS] = t; }
        __syncthreads();
        ntiles = __builtin_amdgcn_readfirstlane(tab_[N_EXPERTS]); }
    template <bool RFL> __device__ __forceinline__ bool next_t(int i, Unit& u) const {
        int pm, pn; if (!static_tile(i, G, c, ntiles, nN, pm, pn)) return false;
        int e = 0;
#pragma unroll
        for (int j = 1; j < N_EXPERTS; ++j) e += (pm >= tab[j]) ? 1 : 0;
        if (RFL) e = __builtin_amdgcn_readfirstlane(e);
        const int tb_ = tab[e], cn_ = tab[16 + e];
        u.pm = pm; u.pn = pn; u.e = e; u.lt = pm - (RFL ? __builtin_amdgcn_readfirstlane(tb_) : tb_); u.cnt = RFL ? __builtin_amdgcn_readfirstlane(cn_) : cn_; return true;
    }
    __device__ __forceinline__ bool next(int i, Unit& u) const { return next_t<true>(i, u); }
    __device__ __forceinline__ bool next_lane(int i, Unit& u) const { return next_t<false>(i, u); }
    __device__ __forceinline__ int row_token(const Unit& u, int r) const { const int pos = u.lt * BM + r; if (dense) return pos; return pos < u.cnt ? list[u.e * LIST_CAP + pos] : 0; }    __device__ __forceinline__ int row_token_raw(const Unit& u, int r) const { const int pos = u.lt * BM + r; if (dense) return pos; return list[u.e * LIST_CAP + (pos < u.cnt ? pos : 0)]; }
    __device__ __forceinline__ int row_token_fix(const Unit& u, int r, int raw) const { const int pos = u.lt * BM + r; return (dense || pos < u.cnt) ? raw : 0; }
};

__device__ __forceinline__ float silu_f(float x) { return x * __builtin_amdgcn_rcpf(1.0f + __builtin_amdgcn_exp2f(x * -1.4426950408889634f)); }
__device__ __forceinline__ float logsigmoid_f(float z) { const float a = fabsf(z); return fminf(z, 0.f) - 0.6931471805599453f * __builtin_amdgcn_logf(1.0f + __builtin_amdgcn_exp2f(a * -1.4426950408889634f)); }


constexpr unsigned RS_LDS = 131072 + 4096;
__device__ __forceinline__ void rs_request16(const float* rows4, int wid, int lane, int par) { asm volatile("" : "+v"(lane));   if (wid < 4) __builtin_amdgcn_global_load_lds((const unsigned*)(rows4 + (size_t)(wid * 64 + lane) * 4), (PG8_LAS unsigned*)(size_t)(RS_LDS + par * 4096 + wid * 1024), 16, 0, 0); }
__device__ __forceinline__ void rs_request4(const float* p, int wid, int par) { if (wid < 4) __builtin_amdgcn_global_load_lds((const unsigned*)p, (PG8_LAS unsigned*)(size_t)(RS_LDS + par * 4096 + wid * 256), 4, 0, 0); }

struct EpiInProj {
    static constexpr bool PERM = true;
    unsigned char* ws; const float* fbias; const float* gains; const float* SSA;
    struct Pre {};
    __device__ __forceinline__ void prefetch(const Unit& u, int wid, int lane, int par) const { if (u.pm < M_TOK / BM) rs_request16(SSA + (size_t)u.pm * BM * 4, wid, lane, par); }
    __device__ __forceinline__ void operator()(const f32x4 (&acc)[2][2][4][2], const Unit& u, int wr, int wc, int fr, int fq, int par) const {
        const int pn = u.pn; const int row0 = u.pm * BM + wr * 64 + fr;
        float rs[2][4];
#pragma unroll
        for (int ai = 0; ai < 2; ++ai)
#pragma unroll
            for (int m = 0; m < 4; ++m) { rs[ai][m] = 1.0f; if (u.pm < M_TOK / BM) { const f32x4 p = *(const PG8_LAS f32x4*)(size_t)(RS_LDS + par * 4096 + (ai * HALF + wr * 64 + m * 16 + fr) * 16); rs[ai][m] = __builtin_amdgcn_rsqf(((p[0] + p[1]) + (p[2] + p[3])) * (1.0f / D_MODEL) + EPS); } }
        if (pn <= 1) {
            bf16_t* dst = (bf16_t*)(ws + (pn == 0 ? WS_RQ : WS_RK)); const float sc = pn == 0 ? 0.125f : 1.0f;
            typedef float f32x2 __attribute__((ext_vector_type(2)));
            f32x2 c16[4], s16[4];
#pragma unroll
            for (int p = 0; p < 4; ++p) {
#pragma unroll
                for (int q = 0; q < 2; ++q) { const float f_ = __builtin_amdgcn_exp2f(-(float)(8 * fq + 2 * p + q) * (13.287712379549449f / 32.0f)) * 0.15915494309189535f;
                    const float a16 = __builtin_amdgcn_fractf(16.0f * f_); c16[p][q] = __builtin_amdgcn_cosf(a16); s16[p][q] = __builtin_amdgcn_sinf(a16); } }
#pragma unroll
            for (int ai = 0; ai < 2; ++ai) {
                f32x2 cs[4], sn[4];
                { const float pos = (float)((row0 + ai * HALF) & (SEQ - 1)); int fq_ = fq; asm volatile("" : "+v"(fq_));
#pragma unroll
                    for (int p = 0; p < 4; ++p) { f32x2 invf_; invf_.x = __builtin_amdgcn_exp2f(-(float)(8 * fq_ + 2 * p) * (13.287712379549449f / 32.0f)) * 0.15915494309189535f; invf_.y = __builtin_amdgcn_exp2f(-(float)(8 * fq_ + 2 * p + 1) * (13.287712379549449f / 32.0f)) * 0.15915494309189535f;
                        const f32x2 pr = invf_ * pos; f32x2 rf;
                        rf.x = __builtin_amdgcn_fractf(pr.x) + __builtin_fmaf(pos, invf_.x, -pr.x); rf.y = __builtin_amdgcn_fractf(pr.y) + __builtin_fmaf(pos, invf_.y, -pr.y);
                        cs[p].x = __builtin_amdgcn_cosf(rf.x); cs[p].y = __builtin_amdgcn_cosf(rf.y); sn[p].x = __builtin_amdgcn_sinf(rf.x); sn[p].y = __builtin_amdgcn_sinf(rf.y); } }
#pragma unroll
                for (int m = 0; m < 4; ++m) { const int row = row0 + ai * HALF + m * 16; const float k_ = rs[ai][m] * sc;
                    f32x2 y1[4], y2[4];
#pragma unroll
                    for (int p = 0; p < 4; ++p) { const int n = p >> 1, j = 2 * (p & 1);
                        const f32x2 x1 = (f32x2){acc[ai][0][m][n][j], acc[ai][0][m][n][j + 1]} * k_, x2 = (f32x2){acc[ai][1][m][n][j], acc[ai][1][m][n][j + 1]} * k_;
                        y1[p] = x1 * cs[p] - x2 * sn[p]; y2[p] = x2 * cs[p] + x1 * sn[p]; }
                    bf16_t* rowp = dst + (size_t)row * 256 + 64 * wc + 8 * fq;
                    u32x4 w; w.x = cvt_pk_bf16(y1[0].x, y1[0].y); w.y = cvt_pk_bf16(y1[1].x, y1[1].y); w.z = cvt_pk_bf16(y1[2].x, y1[2].y); w.w = cvt_pk_bf16(y1[3].x, y1[3].y); *(u32x4*)rowp = w;
                    w.x = cvt_pk_bf16(y2[0].x, y2[0].y); w.y = cvt_pk_bf16(y2[1].x, y2[1].y); w.z = cvt_pk_bf16(y2[2].x, y2[2].y); w.w = cvt_pk_bf16(y2[3].x, y2[3].y); *(u32x4*)(rowp + 32) = w;
                    if (m < 3) {
#pragma unroll
                        for (int p = 0; p < 4; ++p) { const f32x2 c_ = cs[p] * c16[p] - sn[p] * s16[p]; sn[p] = sn[p] * c16[p] + cs[p] * s16[p]; cs[p] = c_; } } } }
        } else if (pn == 6 || pn == 7 || pn == 9 || pn == 11) {
            const size_t doff = pn == 6 ? WS_FQ : pn == 7 ? WS_FK : pn == 9 ? WS_MQ : WS_MK; const int gi = pn == 6 ? 0 : pn == 7 ? 1 : pn == 9 ? 2 : 3;
            bf16_t* dst = (bf16_t*)(ws + doff); const float* gp = gains + gi * 64;
            const float sc = (pn == 6 || pn == 9) ? (0.125f * 1.4426950408889634f) : 1.0f; const int rsub = pn == 11 ? M_TOK : 0;
            f32x4 gv[2][2];
#pragma unroll
            for (int bj = 0; bj < 2; ++bj)
#pragma unroll
                for (int n = 0; n < 2; ++n) gv[bj][n] = *(const f32x4*)(gp + 32 * bj + 8 * fq + 4 * n) * sc;
#pragma unroll
            for (int ai = 0; ai < 2; ++ai)
#pragma unroll
                for (int m = 0; m < 4; ++m) { const int row = row0 + ai * HALF + m * 16 - rsub; float ss = 0.f;
#pragma unroll
                    for (int bj = 0; bj < 2; ++bj)
#pragma unroll
                        for (int n = 0; n < 2; ++n) { const f32x4 x = acc[ai][bj][m][n] * rs[ai][m]; ss += (x[0] * x[0] + x[1] * x[1]) + (x[2] * x[2] + x[3] * x[3]); }
                    ss += __shfl_xor(ss, 16); ss += __shfl_xor(ss, 32);
                    const float rstd = rs[ai][m] * __builtin_amdgcn_rsqf(ss * (1.0f / 64.0f) + EPS);
                    bf16_t* rowp = dst + (size_t)row * 256 + 64 * wc + 8 * fq;
#pragma unroll
                    for (int bj = 0; bj < 2; ++bj) { const f32x4 v0 = acc[ai][bj][m][0] * rstd * gv[bj][0], v1 = acc[ai][bj][m][1] * rstd * gv[bj][1];
                        u32x4 w; w.x = cvt_pk_bf16(v0[0], v0[1]); w.y = cvt_pk_bf16(v0[2], v0[3]); w.z = cvt_pk_bf16(v1[0], v1[1]); w.w = cvt_pk_bf16(v1[2], v1[3]); *(u32x4*)(rowp + 32 * bj) = w; } }
        } else if (pn == 10) {
            if (wc == 0 && fq == 0) {
                const f32x4 bv = *(const f32x4*)fbias; float* LOGF = (float*)(ws + WS_LOGF);
#pragma unroll
                for (int ai = 0; ai < 2; ++ai)
#pragma unroll
                    for (int m = 0; m < 4; ++m) { const int row = row0 + ai * HALF + m * 16; const int b = row >> 13, t = row & (SEQ - 1);
#pragma unroll
                        for (int j = 0; j < 4; ++j) LOGF[(size_t)(b * 4 + j) * SEQ + t] = logsigmoid_f(acc[ai][0][m][0][j] * rs[ai][m] + bv[j]); }
            }
        } else {
            size_t doff; int ldc, ct, rsub = 0; bool act = false;
            if (pn <= 3) { doff = WS_RV; ldc = 512; ct = pn - 2; } else if (pn <= 5) { doff = WS_RG; ldc = 512; ct = pn - 4; act = true; } else if (pn == 8) { doff = WS_FV; ldc = 256; ct = 0; } else { doff = WS_MV; ldc = 256; ct = 0; rsub = M_TOK; }
            bf16_t* dst = (bf16_t*)(ws + doff);
#pragma unroll
            for (int ai = 0; ai < 2; ++ai)
#pragma unroll
                for (int m = 0; m < 4; ++m) { const int row = row0 + ai * HALF + m * 16 - rsub; bf16_t* rowp = dst + (size_t)row * ldc + ct * 256 + 32 * wc + 8 * fq;
#pragma unroll
                    for (int bj = 0; bj < 2; ++bj) { f32x4 v0 = acc[ai][bj][m][0] * rs[ai][m], v1 = acc[ai][bj][m][1] * rs[ai][m];
                        if (act) {
#pragma unroll
                            for (int j = 0; j < 4; ++j) { v0[j] = silu_f(v0[j]); v1[j] = silu_f(v1[j]); } }
                        u32x4 w; w.x = cvt_pk_bf16(v0[0], v0[1]); w.y = cvt_pk_bf16(v0[2], v0[3]); w.z = cvt_pk_bf16(v1[0], v1[1]); w.w = cvt_pk_bf16(v1[2], v1[3]); *(u32x4*)(rowp + bj * HALF) = w; } }
        }
    }
};

__device__ __forceinline__ float bf_lo(unsigned w) { return __uint_as_float(w << 16); }
__device__ __forceinline__ float bf_hi(unsigned w) { return __uint_as_float(w & 0xffff0000u); }
__device__ __forceinline__ unsigned pk4_fp8(float a, float b, float c, float d) {
    { float lim = 448.f; asm("" : "+s"(lim));
      asm("v_med3_f32 %0, %1, %2, -%2" : "=v"(a) : "v"(a), "s"(lim)); asm("v_med3_f32 %0, %1, %2, -%2" : "=v"(b) : "v"(b), "s"(lim));
      asm("v_med3_f32 %0, %1, %2, -%2" : "=v"(c) : "v"(c), "s"(lim)); asm("v_med3_f32 %0, %1, %2, -%2" : "=v"(d) : "v"(d), "s"(lim)); }
    int p = __builtin_amdgcn_cvt_pk_fp8_f32(a, b, 0, false); p = __builtin_amdgcn_cvt_pk_fp8_f32(c, d, p, true); return (unsigned)p; }

struct EpiDown {
    static constexpr bool PERM = true;
    bf16_t* XB; float* SS; bf16_t* YD; unsigned xl_off; bool moe; float dsc;
    bool route; unsigned char* X8; const bf16_t* WRT; float* LOGP; bool logits;
    struct Pre {};
    __device__ __forceinline__ void prefetch(const Unit&, int, int, int) const {}
    __device__ __forceinline__ void operator()(const f32x4 (&acc)[2][2][4][2], const Unit& u, int wr, int wc, int fr, int fq, int par) const {
        const int row0 = u.pm * BM + wr * 64 + fr, col0 = u.pn * BM + wc * 32 + 8 * fq;
        if (moe) {
#pragma unroll
            for (int ai = 0; ai < 2; ++ai)
#pragma unroll
                for (int m = 0; m < 4; ++m) { bf16_t* rowp = YD + (size_t)(row0 + ai * HALF + m * 16) * D_MODEL + col0;
#pragma unroll
                    for (int bj = 0; bj < 2; ++bj) { const f32x4 v0 = acc[ai][bj][m][0] * dsc, v1 = acc[ai][bj][m][1] * dsc;
                        u32x4 w; w.x = cvt_pk_bf16(v0[0], v0[1]); w.y = cvt_pk_bf16(v0[2], v0[3]); w.z = cvt_pk_bf16(v1[0], v1[1]); w.w = cvt_pk_bf16(v1[2], v1[3]); *(u32x4*)(rowp + bj * HALF) = w; } }
        } else {
        bf16x8 wa[2];
        if (logits) {
#pragma unroll
            for (int bj = 0; bj < 2; ++bj) wa[bj] = *(const bf16x8*)(WRT + (size_t)fr * D_MODEL + u.pn * BM + bj * HALF + wc * 32 + 8 * fq); }
#pragma unroll
        for (int ai = 0; ai < 2; ++ai) { u32x4 xbv[4][2];
#pragma unroll
            for (int m = 0; m < 4; ++m)
#pragma unroll
                for (int bj = 0; bj < 2; ++bj) xbv[m][bj] = *(const u32x4*)(XB + (size_t)(row0 + ai * HALF + m * 16) * D_MODEL + col0 + bj * HALF);
#pragma unroll
            for (int m = 0; m < 4; ++m) { bf16_t* rowp = XB + (size_t)(row0 + ai * HALF + m * 16) * D_MODEL + col0; float ss = 0.f; f32x4 lacc = (f32x4){0.f, 0.f, 0.f, 0.f};
#pragma unroll
                for (int bj = 0; bj < 2; ++bj) { const u32x4 xb = xbv[m][bj]; f32x4 v0 = acc[ai][bj][m][0] * dsc, v1 = acc[ai][bj][m][1] * dsc;
                    v0[0] += bf_lo(xb.x); v0[1] += bf_hi(xb.x); v0[2] += bf_lo(xb.y); v0[3] += bf_hi(xb.y); v1[0] += bf_lo(xb.z); v1[1] += bf_hi(xb.z); v1[2] += bf_lo(xb.w); v1[3] += bf_hi(xb.w);
                    ss += ((v0[0] * v0[0] + v0[1] * v0[1]) + (v0[2] * v0[2] + v0[3] * v0[3])) + ((v1[0] * v1[0] + v1[1] * v1[1]) + (v1[2] * v1[2] + v1[3] * v1[3]));
                    u32x4 w; w.x = cvt_pk_bf16(v0[0], v0[1]); w.y = cvt_pk_bf16(v0[2], v0[3]); w.z = cvt_pk_bf16(v1[0], v1[1]); w.w = cvt_pk_bf16(v1[2], v1[3]); *(u32x4*)(rowp + bj * HALF) = w;
                    if (route) { typedef unsigned u32x2r __attribute__((ext_vector_type(2))); u32x2r w8; w8.x = pk4_fp8(v0[0] * SA_HB, v0[1] * SA_HB, v0[2] * SA_HB, v0[3] * SA_HB); w8.y = pk4_fp8(v1[0] * SA_HB, v1[1] * SA_HB, v1[2] * SA_HB, v1[3] * SA_HB);
                        *(u32x2r*)(X8 + (size_t)(row0 + ai * HALF + m * 16) * D_MODEL + col0 + bj * HALF) = w8;
                        if (logits) lacc = __builtin_amdgcn_mfma_f32_16x16x32_bf16(wa[bj], __builtin_bit_cast(bf16x8, w), lacc, 0, 0, 0); } }
                if (logits && fq < 2) *(f32x4*)(LOGP + ((size_t)(row0 + ai * HALF + m * 16) * 16 + u.pn * 4 + wc) * 8 + 4 * fq) = lacc;
                ss += __shfl_xor(ss, 16); ss += __shfl_xor(ss, 32);
                if (fq == 0) ((PG8_LAS float*)(size_t)xl_off)[(ai * HALF + wr * 64 + m * 16 + fr) * 4 + wc] = ss;
                if (m & 1) asm volatile("" ::: "memory"); } }
#ifndef T_NOEXCH
        asm volatile("s_waitcnt lgkmcnt(0)" ::: "memory"); __builtin_amdgcn_s_barrier(); asm volatile("" ::: "memory");
        { int t = (wr * 4 + wc) * 64 + fq * 16 + fr; asm volatile("" : "+v"(t)); if (t < BM) { const f32x4 p = *(const PG8_LAS f32x4*)((PG8_LAS float*)(size_t)xl_off + t * 4); SS[(size_t)(u.pm * BM + t) * 4 + u.pn] = (p[0] + p[1]) + (p[2] + p[3]); } }
        asm volatile("s_waitcnt lgkmcnt(0)" ::: "memory"); __builtin_amdgcn_s_barrier(); asm volatile("" ::: "memory");
#endif
        }
    }
};

template <bool A8> struct EpiSwiGLU {
    static constexpr bool PERM = true;
    unsigned char* HF; const float* SSF; const float* RSS; bool dense;
    struct Pre {};
    __device__ __forceinline__ void prefetch(const Unit& u, int wid, int lane, int par) const {
        if (dense) rs_request16(SSF + (size_t)u.pm * BM * 4, wid, lane, par);
        else { int l_ = lane; asm volatile("" : "+v"(l_)); const int pos = u.lt * BM + (wid & 3) * 64 + l_; rs_request4(RSS + u.e * LIST_CAP + (pos < u.cnt ? pos : 0), wid, par); } }
    __device__ __forceinline__ void operator()(const f32x4 (&acc)[2][2][4][2], const Unit& u, int wr, int wc, int fr, int fq, int par) const {
        const int row0 = u.pm * BM + wr * 64 + fr, col0 = u.pn * HALF + wc * 32 + 8 * fq;
        float rs[2][4];
        if constexpr (A8) {
#pragma unroll
            for (int ai = 0; ai < 2; ++ai)
#pragma unroll
                for (int m = 0; m < 4; ++m) { const int rl = ai * HALF + wr * 64 + m * 16 + fr; float r_;
                    if (dense) { const f32x4 p = *(const PG8_LAS f32x4*)(size_t)(RS_LDS + par * 4096 + rl * 16); r_ = __builtin_amdgcn_rsqf(((p[0] + p[1]) + (p[2] + p[3])) * (1.0f / D_MODEL) + EPS); }
                    else r_ = *(const PG8_LAS float*)(size_t)(RS_LDS + par * 4096 + rl * 4);
                    rs[ai][m] = r_ * (1.0f / (SA_HB * SW_GU)); }
        } else if (dense) {
#pragma unroll
            for (int ai = 0; ai < 2; ++ai)
#pragma unroll
                for (int m = 0; m < 4; ++m) { const f32x4 p = *(const PG8_LAS f32x4*)(size_t)(RS_LDS + par * 4096 + (ai * HALF + wr * 64 + m * 16 + fr) * 16); rs[ai][m] = __builtin_amdgcn_rsqf(((p[0] + p[1]) + (p[2] + p[3])) * (1.0f / D_MODEL) + EPS); }
        } else {
#pragma unroll
            for (int ai = 0; ai < 2; ++ai)
#pragma unroll
                for (int m = 0; m < 4; ++m) rs[ai][m] = *(const PG8_LAS float*)(size_t)(RS_LDS + par * 4096 + (ai * HALF + wr * 64 + m * 16 + fr) * 4);
        }
#pragma unroll
        for (int ai = 0; ai < 2; ++ai)
#pragma unroll
            for (int m = 0; m < 4; ++m) { const float r = rs[ai][m]; float h[8];
                typedef float f32x2 __attribute__((ext_vector_type(2)));
                const float k1 = r * -1.4426950408889634f, c2 = (r * r) * (FP8_DN ? SA_HF : 1.0f);
#pragma unroll
                for (int n = 0; n < 2; ++n)
#pragma unroll
                    for (int jp = 0; jp < 2; ++jp) { const f32x2 g = {acc[ai][0][m][n][2 * jp], acc[ai][0][m][n][2 * jp + 1]}, uu = {acc[ai][1][m][n][2 * jp], acc[ai][1][m][n][2 * jp + 1]};
                        const f32x2 t = g * k1; f32x2 d; d.x = __builtin_amdgcn_exp2f(t.x); d.y = __builtin_amdgcn_exp2f(t.y); d = d + 1.0f;
                        f32x2 s; s.x = __builtin_amdgcn_rcpf(d.x); s.y = __builtin_amdgcn_rcpf(d.y);
                        const f32x2 hh = ((g * uu) * c2) * s; h[n * 4 + 2 * jp] = hh.x; h[n * 4 + 2 * jp + 1] = hh.y; }
                const size_t ro = (size_t)(row0 + ai * HALF + m * 16) * FFP + col0;
                if constexpr (FP8_DN) { typedef unsigned u32x2 __attribute__((ext_vector_type(2))); u32x2 w; w.x = pk4_fp8(h[0], h[1], h[2], h[3]); w.y = pk4_fp8(h[4], h[5], h[6], h[7]); *(u32x2*)(HF + ro) = w; }
                else { u32x4 w; w.x = cvt_pk_bf16(h[0], h[1]); w.y = cvt_pk_bf16(h[2], h[3]); w.z = cvt_pk_bf16(h[4], h[5]); w.w = cvt_pk_bf16(h[6], h[7]); *(u32x4*)((bf16_t*)HF + ro) = w; } }
    }
};
}
namespace attn_body {
#ifdef T_NOMASK
constexpr bool defined_nomask=true;
#else
constexpr bool defined_nomask=false;
#endif
#ifdef T_NOBIAS
constexpr bool defined_nobias=true;
#else
constexpr bool defined_nobias=false;
#endif
using bf16=__hip_bfloat16;
using bf16x8=__attribute__((ext_vector_type(8)))short;
using s16x4=__attribute__((ext_vector_type(4)))short;
using f32x16=__attribute__((ext_vector_type(16)))float;
using u32x4=__attribute__((ext_vector_type(4)))unsigned;
using f32x4v=__attribute__((ext_vector_type(4)))float;
constexpr int BATCH=2,NHEAD=4,SEQ=8192,D=64,DM=NHEAD*D,KVMEM=256,YP=1024;
constexpr int NW=8,QBLK=32,QB=QBLK*NW,KVBLK=64,NQB=SEQ/QB;
constexpr int ATTN_PITCH=DM, ATTN_UNIT_ROWS=QB;
__device__ __forceinline__ int crow(int r,int hi){return (r&3)+8*(r>>2)+4*hi;}
__device__ __forceinline__ unsigned f2bf_a(float f){ unsigned u=__builtin_bit_cast(unsigned,f); return (u+0x7fffu+((u>>16)&1u))>>16; }
#define SBAR() __builtin_amdgcn_sched_barrier(0)
__device__ __forceinline__ void cmask(f32x16&p0,f32x16&p1,int jb,int qrel,int hi){
  int dd=qrel-(64*jb+4*hi); asm volatile("":"+v"(dd));
  #pragma unroll
  for(int r=0;r<16;++r){const int c=(r&3)+8*(r>>2);
    const unsigned t0=(((unsigned)(dd-c))&0x80000000u)|0x7F800000u, t1=(((unsigned)(dd-c-32))&0x80000000u)|0x7F800000u;
    p0[r]=__builtin_fminf(p0[r],__uint_as_float(t0)); p1[r]=__builtin_fminf(p1[r],__uint_as_float(t1));}
}

constexpr int NSLOT=3, SLOTB=8192;
constexpr int LDS_K=0, LDS_V=NSLOT*SLOTB, LDS_WS=2*NSLOT*SLOTB, LDS_OST=LDS_WS+NW*64*4, LDS_CB=LDS_OST+NW*4096, LDS_CBZ=LDS_CB+SEQ*8, LDS_G=LDS_CBZ+16  , LDS_BYTES=LDS_G+256;
constexpr float C2=0.125f*1.4426950408889634f;
__device__ __forceinline__ void glds16(const void*gsrc,unsigned lds_dst){unsigned keep;
  asm volatile("s_mov_b32 %0, m0\n\ts_mov_b32 m0, %2\n\ts_nop 0\n\tglobal_load_lds_dwordx4 %1, off\n\ts_mov_b32 m0, %0":"=&s"(keep):"v"(gsrc),"s"(lds_dst):"memory");}
__device__ __forceinline__ void glds4(const void*gsrc,unsigned lds_dst){unsigned keep;
  asm volatile("s_mov_b32 %0, m0\n\ts_mov_b32 m0, %2\n\ts_nop 0\n\tglobal_load_lds_dword %1, off\n\ts_mov_b32 m0, %0":"=&s"(keep):"v"(gsrc),"s"(lds_dst):"memory");}
__device__ __forceinline__ float max3f(float a,float b,float c){float r;asm("v_max3_f32 %0, %1, %2, %3":"=v"(r):"v"(a),"v"(b),"v"(c));return r;}
__device__ __forceinline__ float max2f(float a,float b){float r;asm("v_max_f32_e32 %0, %1, %2":"=v"(r):"v"(a),"v"(b));return r;}
__device__ __forceinline__ float fadd_s(float a,float b){float r;asm("v_add_f32_e32 %0, %1, %2":"=v"(r):"v"(a),"v"(b));return r;}
__device__ __forceinline__ float fsub_s(float a,float b){float r;asm("v_sub_f32_e32 %0, %1, %2":"=v"(r):"v"(a),"v"(b));return r;}
typedef float f32x2_t __attribute__((ext_vector_type(2))); typedef __bf16 bf16x2_t __attribute__((ext_vector_type(2)));
__device__ __forceinline__ unsigned cvtpk_s(float lo,float hi){f32x2_t v={lo,hi};bf16x2_t b=__builtin_convertvector(v,bf16x2_t);return __builtin_bit_cast(unsigned,b);}
#define WAIT_BAR(N) asm volatile("s_waitcnt vmcnt(" #N ") lgkmcnt(0)\n\ts_barrier":::"memory")

__device__ __forceinline__ void qkt(f32x16&p0,f32x16&p1,const char*Kslot,const bf16x8*qr,const f32x16&c0,const f32x16&c1,int r32,int hi){
  const char*kb=Kslot+hi*1024+r32*16;
  #pragma unroll
  for(int d0=0;d0<4;++d0){
    const bf16x8 b0=*reinterpret_cast<const bf16x8*>(kb+d0*2048);
    const bf16x8 b1=*reinterpret_cast<const bf16x8*>(kb+d0*2048+512);
    if(d0==0){p0=__builtin_amdgcn_mfma_f32_32x32x16_bf16(b0,qr[0],c0,0,0,0);p1=__builtin_amdgcn_mfma_f32_32x32x16_bf16(b1,qr[0],c1,0,0,0);}
    else{p0=__builtin_amdgcn_mfma_f32_32x32x16_bf16(b0,qr[d0],p0,0,0,0);p1=__builtin_amdgcn_mfma_f32_32x32x16_bf16(b1,qr[d0],p1,0,0,0);}}
}
typedef __attribute__((address_space(3))) const char* lds_cptr;
typedef short v4i16_t __attribute__((ext_vector_type(4)));
__device__ __forceinline__ void kload8(bf16x8*kf,lds_cptr kp){
  kf[0]=*(const __attribute__((address_space(3))) bf16x8*)(kp);      kf[1]=*(const __attribute__((address_space(3))) bf16x8*)(kp+512);
  kf[2]=*(const __attribute__((address_space(3))) bf16x8*)(kp+2048); kf[3]=*(const __attribute__((address_space(3))) bf16x8*)(kp+2560);
  kf[4]=*(const __attribute__((address_space(3))) bf16x8*)(kp+4096); kf[5]=*(const __attribute__((address_space(3))) bf16x8*)(kp+4608);
  kf[6]=*(const __attribute__((address_space(3))) bf16x8*)(kp+6144); kf[7]=*(const __attribute__((address_space(3))) bf16x8*)(kp+6656);
}
__device__ __forceinline__ void kload2(bf16x8*kf,lds_cptr kp,int j){ kf[2*j]=*(const __attribute__((address_space(3))) bf16x8*)(kp+j*2048); kf[2*j+1]=*(const __attribute__((address_space(3))) bf16x8*)(kp+j*2048+512); }
__device__ __forceinline__ s16x4 vtr(lds_cptr p){ return __builtin_bit_cast(s16x4,__builtin_amdgcn_ds_read_tr16_b64_v4i16((__attribute__((address_space(3))) v4i16_t*)p)); }
__device__ __forceinline__ float rowmax(const f32x16&p0,const f32x16&p1){
  float a=max3f(p0[0],p0[1],p1[0]),b=max3f(p0[2],p0[3],p1[1]);a=max3f(a,p1[2],p1[3]);
  #pragma unroll
  for(int r=4;r<16;r+=4){a=max3f(a,p0[r],p0[r+1]);b=max3f(b,p0[r+2],p0[r+3]);a=max3f(a,p1[r],p1[r+1]);b=max3f(b,p1[r+2],p1[r+3]);}
  const float m=max2f(a,b);
  auto rr=__builtin_amdgcn_permlane32_swap(__float_as_uint(m),__float_as_uint(m),false,false);
  return max2f(__uint_as_float(rr[0]),__uint_as_float(rr[1]));
}
__device__ __forceinline__ void pv(f32x16*o,int vb,bf16x8 pa0,bf16x8 pa1,bf16x8 pa2,bf16x8 pa3){
  #pragma unroll
  for(int d0=0;d0<2;++d0){s16x4 lo[4],hi[4];
    #pragma unroll
    for(int ks=0;ks<4;++ks){
      asm volatile("ds_read_b64_tr_b16 %0,%1 offset:%c2":"=&v"(lo[ks]):"v"(vb),"i"(d0*4096+ks*1024):"memory");
      asm volatile("ds_read_b64_tr_b16 %0,%1 offset:%c2":"=&v"(hi[ks]):"v"(vb),"i"(d0*4096+ks*1024+512):"memory");}
    asm volatile("s_waitcnt lgkmcnt(0)":::"memory");SBAR();
    #define PK(k) (bf16x8){lo[k][0],lo[k][1],lo[k][2],lo[k][3],hi[k][0],hi[k][1],hi[k][2],hi[k][3]}
    o[d0]=__builtin_amdgcn_mfma_f32_32x32x16_bf16(pa0,PK(0),o[d0],0,0,0);
    o[d0]=__builtin_amdgcn_mfma_f32_32x32x16_bf16(pa1,PK(1),o[d0],0,0,0);
    o[d0]=__builtin_amdgcn_mfma_f32_32x32x16_bf16(pa2,PK(2),o[d0],0,0,0);
    o[d0]=__builtin_amdgcn_mfma_f32_32x32x16_bf16(pa3,PK(3),o[d0],0,0,0);
    #undef PK
  }
}

#ifndef ATTN_STORE16
#define ATTN_STORE16(p,v) (*(u32x4*)(p)=(v))
#endif
template<int THRL,bool FOX> __device__ __forceinline__ void attn_unit(int b,int h,int qb,const bf16*Q,const bf16*__restrict__ K,const bf16*__restrict__ V,bf16*Y,int ycol0,const float*__restrict__ gout,const float*__restrict__ cbg,const float*__restrict__ gqk,char*shm,int tid_in){
  int tid_=tid_in; asm volatile("":"+v"(tid_));
  const int tid=tid_,lane=tid&63,r32=lane&31,hi=lane>>5; const int wid=__builtin_amdgcn_readfirstlane(tid>>6);
  const long rowbase=(long)b*SEQ; const long kvbase=FOX?rowbase:(long)b*KVMEM; const int q0=qb*QB;
  const bf16*Qw=Q+(rowbase+q0+wid*QBLK)*DM+h*D;
  int t0=0;
  if(FOX){ float gq=fabsf(gqk[lane]),gk=fabsf(gqk[64+lane]);
    #pragma unroll
    for(int o=1;o<64;o<<=1){ gq=fmaxf(gq,__shfl_xor(gq,o)); gk=fmaxf(gk,__shfl_xor(gk,o)); }
    const int ntf=(q0+QB)/KVBLK-4;
    const bool ha=lane<ntf, hb=lane+64<ntf; const float cb0=cbg[q0], ca=cbg[64*(ha?lane:0)+63], cb1=cbg[64*(hb?lane+64:0)+63];
    const float margin=2.04f*(8.0f*1.4426950408889634f)*gq*gk+38.0f;     const float thr=cb0+margin; int cnt=((ha&&ca>=thr)?1:0)+((hb&&cb1>=thr)?1:0);
    #pragma unroll
    for(int o=1;o<64;o<<=1) cnt+=__shfl_xor(cnt,o);
    t0=__builtin_amdgcn_readfirstlane(cnt)&~1; }
  const bf16*Kh=K+(kvbase+64*t0)*DM+h*D,*Vh=V+(kvbase+64*t0)*DM+h*D;
  const unsigned lds0=(unsigned)(uintptr_t)shm;
  float*wsf=(float*)(shm+LDS_WS)+wid*64;
  const bf16*ksrc=Kh+(long)lane*DM+wid*8;
  const bf16*vsrc=Vh+(long)(16*(wid&3)+(lane>>2))*DM+(wid>>2)*32+(lane&3)*8;
  const unsigned kdst=lds0+LDS_K+wid*1024, vdst=lds0+LDS_V+wid*1024;
  #define DMA_K(t,slot) glds16(ksrc+(long)(t)*KVBLK*DM,(unsigned)__builtin_amdgcn_readfirstlane(kdst+(slot)))
  #define DMA_V(t,slot) glds16(vsrc+(long)(t)*KVBLK*DM,(unsigned)__builtin_amdgcn_readfirstlane(vdst+(slot)))
  const int vb0=(int)(lds0+LDS_V)+((lane>>4)&1)*32+(lane&3)*8+(4*hi+((lane&15)>>2))*64;
  const char*Kbase=shm+LDS_K; bf16x8 kf[8];
  const lds_cptr shm3=(lds_cptr)shm; const lds_cptr kp0=shm3+LDS_K+hi*1024+r32*16; const lds_cptr vp0=shm3+LDS_V+((lane>>4)&1)*32+(lane&3)*8+(4*hi+((lane&15)>>2))*64;
  const int NT=FOX?(q0+QB)/KVBLK-t0:KVMEM/KVBLK;
  const int qrel=wid*QBLK+r32;
  typedef __attribute__((address_space(3))) unsigned long long lds_u64;
  if(wid==0) glds4(gout+h*D+lane,(unsigned)__builtin_amdgcn_readfirstlane(lds0+LDS_G));
  DMA_K(0,0);DMA_V(0,0);DMA_K(1,SLOTB);
  bf16x8 qr[4];
  #pragma unroll
  for(int d0=0;d0<4;++d0)qr[d0]=*reinterpret_cast<const bf16x8*>(&Qw[(long)r32*DM+d0*16+hi*8]);
  DMA_K(2,2*SLOTB);
  float cbq=0.f; unsigned bkbase=0u, bkstep=0u;
  if(FOX){ lds_u64*tb=(lds_u64*)((__attribute__((address_space(3))) char*)shm+LDS_CB); const int ncb=q0+QB-64*t0; const float*cbt=cbg+64*t0;
    for(int i=tid;i<ncb;i+=NW*64){ const float x=-cbt[i]; const unsigned h_=f2bf_a(x); const float r1=x-__uint_as_float(h_<<16); const unsigned m_=f2bf_a(r1); const float r2=r1-__uint_as_float(m_<<16); const unsigned l_=f2bf_a(r2);
      tb[i]=(unsigned long long)(h_|(m_<<16))|((unsigned long long)l_<<32); }
    if(tid==0){ unsigned long long z_=0ull; asm volatile("":"+v"(z_)); tb[SEQ]=z_; tb[SEQ+1]=z_; }
    cbq=cbg[q0+qrel];
    asm volatile("s_waitcnt vmcnt(0) lgkmcnt(0)\n\ts_barrier":::"memory");
    bkbase=hi?(unsigned)(LDS_CBZ):(unsigned)(LDS_CB+r32*8); bkstep=hi?0u:512u; }
  const bf16x8 qone=(bf16x8){(short)0x3F80,(short)0x3F80,(short)0x3F80,(short)0x3F80,(short)0x3F80,(short)0x3F80,(short)0x3F80,(short)0x3F80};
  #define LOADBK(B0,B1,t) do{ const lds_cptr bp_=(lds_cptr)shm+bkbase+(unsigned)(t)*bkstep; const unsigned long long x0_=*(const __attribute__((address_space(3))) unsigned long long*)bp_, x1_=*(const __attribute__((address_space(3))) unsigned long long*)(bp_+(hi?0:256)); \
    B0=__builtin_bit_cast(bf16x8,(u32x4){(unsigned)x0_,(unsigned)(x0_>>32),0u,0u}); B1=__builtin_bit_cast(bf16x8,(u32x4){(unsigned)x1_,(unsigned)(x1_>>32),0u,0u}); }while(0)
  typedef __attribute__((address_space(3))) bf16x8 lds_bf8; lds_bf8*qst=(lds_bf8*)((__attribute__((address_space(3))) char*)shm+LDS_OST+wid*4096)+lane;
  if(FOX){
  #pragma unroll
  for(int d0=0;d0<4;++d0)qst[d0*64]=qr[d0]; }
  #define QL(i) (*(qst+(i)*64))
  float mhat=-cbq,l_reg=0.f;f32x16 o[2];o[0]=f32x16{};o[1]=f32x16{};f32x16 negm;
  #pragma unroll
  for(int r=0;r<16;++r)negm[r]=cbq;
  asm volatile("":"+v"(negm));
  #define CMASK(P0,P1,t) do{ if(FOX && !defined_nomask){int jb_=(t)-(NT-4); if(jb_>=0)cmask(P0,P1,jb_,qrel,hi);} }while(0)
  bool resc=false;
  #define START(P0,P1) do{ const float rm=rowmax(P0,P1); resc=false; \
    { const float dl=rm; mhat=fadd_s(mhat,dl); \
      _Pragma("unroll") for(int r=0;r<16;++r){P0[r]=fsub_s(P0[r],dl);P1[r]=fsub_s(P1[r],dl);} \
      _Pragma("unroll") for(int r=0;r<16;++r)negm[r]=-mhat; asm volatile("":"+v"(negm)); } \
    _Pragma("unroll") for(int r=0;r<16;++r)P0[r]=__builtin_amdgcn_exp2f(P0[r]); }while(0)
  #define RESC() do{ if(resc){ asm volatile("s_waitcnt lgkmcnt(0)":::"memory"); \
      _Pragma("unroll") for(int d_=0;d_<2;++d_) _Pragma("unroll") for(int r=0;r<16;++r)o[d_][r]*=wsf[crow(r,hi)]; } }while(0)
  f32x16 pA0,pA1,pB0,pB1;
  int sl_prev=0,sl_cur=0,sl_next=SLOTB;
  #define ROT() do{sl_prev=sl_cur;sl_cur=sl_next;sl_next=(sl_next==(NSLOT-1)*SLOTB)?0:sl_next+SLOTB;}while(0)
  WAIT_BAR(3);
  if(FOX){ bf16x8 bk0_,bk1_; LOADBK(bk0_,bk1_,0); pA0=__builtin_amdgcn_mfma_f32_32x32x16_bf16(bk0_,qone,negm,0,0,0); pA1=__builtin_amdgcn_mfma_f32_32x32x16_bf16(bk1_,qone,negm,0,0,0); qkt(pA0,pA1,Kbase,qr,pA0,pA1,r32,hi); }
  else qkt(pA0,pA1,Kbase,qr,negm,negm,r32,hi);
  asm volatile("s_nop 15\n\ts_nop 7":"+v"(pA0),"+v"(pA1));CMASK(pA0,pA1,0);
  START(pA0,pA1);
  _Pragma("unroll") for(int r=0;r<16;++r)pA1[r]=__builtin_amdgcn_exp2f(pA1[r]);
  WAIT_BAR(0);
  DMA_K(3,0);DMA_V(1,SLOTB);
  ROT();
  kload8(kf,kp0+sl_cur);
  WAIT_BAR(2);
  s16x4 vlo[8],vhi[8]; u32x4 pw0,pw1,pw2,pw3;
  #define PKW(P,B) cvtpk_s(P[B],P[B+1])
  #define PAF(k) __builtin_bit_cast(bf16x8,pw##k)
  #define VFR(i) (bf16x8){vlo[i][0],vlo[i][1],vlo[i][2],vlo[i][3],vhi[i][0],vhi[i][1],vhi[i][2],vhi[i][3]}
  #define PIN(x) asm volatile("":"+v"(x))
  #define MX3(a,b,c) __builtin_fmaxf(__builtin_fmaxf((a),(b)),(c))
  #define GAPA(MF,A0,A1,A2,A3,W0,W1,PW) do{ MF; sacc+=A0; sacc+=A1; sacc+=A2; sacc+=A3; PIN(sacc); W0; W1; PIN(PW); SBAR(); }while(0)
  #define EX(v) __builtin_amdgcn_exp2f(v)
  #define GAPB(MF,X,B) do{ MF; X[B]=EX(X[B]); X[B+1]=EX(X[B+1]); X[B+2]=EX(X[B+2]); X[B+3]=EX(X[B+3]); PIN(X); SBAR(); }while(0)
  #define VRD(i) do{ vlo[i]=vtr(vp_+(((i)>>2)*4096+((i)&3)*1024)); vhi[i]=vtr(vp_+(((i)>>2)*4096+((i)&3)*1024+512)); }while(0)
  #define KRD(G,j) do{ if(G){ kload2(kf,kp0+sl_next,j); SBAR(); } }while(0)
  #define STEP(C0,C1,P0,P1,t,GK,GV,GL) do{ SBAR(); \
    if(FOX){ bf16x8 bk0_,bk1_; LOADBK(bk0_,bk1_,t); C0=__builtin_amdgcn_mfma_f32_32x32x16_bf16(bk0_,qone,negm,0,0,0); C1=__builtin_amdgcn_mfma_f32_32x32x16_bf16(bk1_,qone,negm,0,0,0); SBAR(); } \
    const lds_cptr vp_=vp0+sl_prev; \
    bf16x8 qa_,qb_; if(FOX){qa_=QL(0);}else{qa_=qr[0];} \
    VRD(0); SBAR(); float sacc=(P0[0]+P0[1]); \
    GAPA(C0=__builtin_amdgcn_mfma_f32_32x32x16_bf16(kf[0],qa_,FOX?C0:negm,0,0,0), P0[2],P0[3],P0[4],P0[5],     pw0[0]=PKW(P0,0), pw0[1]=PKW(P0,2), pw0); \
    VRD(4); if(FOX){qb_=QL(1);}else{qb_=qr[1];} SBAR(); GAPA(C1=__builtin_amdgcn_mfma_f32_32x32x16_bf16(kf[1],qa_,FOX?C1:negm,0,0,0), P0[6],P0[7],P0[8],P0[9],     pw0[2]=PKW(P0,4), pw0[3]=PKW(P0,6), pw0); \
    VRD(1); SBAR(); GAPA(C0=__builtin_amdgcn_mfma_f32_32x32x16_bf16(kf[2],qb_,C0,0,0,0),   P0[10],P0[11],P0[12],P0[13], pw1[0]=PKW(P0,8), pw1[1]=PKW(P0,10), pw1); \
    VRD(5); if(FOX){qa_=QL(2);}else{qa_=qr[2];} SBAR(); GAPA(C1=__builtin_amdgcn_mfma_f32_32x32x16_bf16(kf[3],qb_,C1,0,0,0),   P0[14],P0[15],P1[0],P1[1],   pw1[2]=PKW(P0,12),pw1[3]=PKW(P0,14), pw1); \
    VRD(2); SBAR(); GAPA(C0=__builtin_amdgcn_mfma_f32_32x32x16_bf16(kf[4],qa_,C0,0,0,0),   P1[2],P1[3],P1[4],P1[5],     pw2[0]=PKW(P1,0), pw2[1]=PKW(P1,2), pw2); \
    VRD(6); if(FOX){qb_=QL(3);}else{qb_=qr[3];} SBAR(); GAPA(C1=__builtin_amdgcn_mfma_f32_32x32x16_bf16(kf[5],qa_,C1,0,0,0),   P1[6],P1[7],P1[8],P1[9],     pw2[2]=PKW(P1,4), pw2[3]=PKW(P1,6), pw2); \
    VRD(3); SBAR(); GAPA(C0=__builtin_amdgcn_mfma_f32_32x32x16_bf16(kf[6],qb_,C0,0,0,0),   P1[10],P1[11],P1[12],P1[13], pw3[0]=PKW(P1,8), pw3[1]=PKW(P1,10), pw3); \
    VRD(7); SBAR(); GAPA(C1=__builtin_amdgcn_mfma_f32_32x32x16_bf16(kf[7],qb_,C1,0,0,0),   P1[14],P1[15],0.f,0.f,       pw3[2]=PKW(P1,12),pw3[3]=PKW(P1,14), pw3); \
    l_reg+=sacc; \
    if(GK){DMA_K((t)+3,sl_cur);} if(GV){DMA_V((t)+1,sl_next);} \
    CMASK(C0,C1,t); \
    { float a=MX3(C0[0],C0[1],C1[0]),b=MX3(C0[2],C0[3],C1[1]); a=MX3(a,C1[2],C1[3]); \
      _Pragma("unroll") for(int r=4;r<16;r+=4){a=MX3(a,C0[r],C0[r+1]);b=MX3(b,C0[r+2],C0[r+3]);a=MX3(a,C1[r],C1[r+1]);b=MX3(b,C1[r+2],C1[r+3]);} \
      float rm=__builtin_fmaxf(a,b); { auto rr=__builtin_amdgcn_permlane32_swap(__float_as_uint(rm),__float_as_uint(rm),false,false); rm=__builtin_fmaxf(__uint_as_float(rr[0]),__uint_as_float(rr[1])); } \
      resc=false; \
      if(__builtin_expect(__any(rm>(float)THRL),0)){ const float dl=__builtin_fmaxf(rm,0.f); mhat+=dl; \
        _Pragma("unroll") for(int r=0;r<16;++r){C0[r]-=dl;C1[r]-=dl;} \
        _Pragma("unroll") for(int r=0;r<16;++r)negm[r]=-mhat; asm volatile("":"+v"(negm)); \
        const float f=__builtin_amdgcn_exp2f(-dl); l_reg*=f; if(hi==0)wsf[r32]=f; resc=true; } } \
    SBAR(); \
    GAPB(o[0]=__builtin_amdgcn_mfma_f32_32x32x16_bf16(PAF(0),VFR(0),o[0],0,0,0), C0,0); \
    GAPB(o[1]=__builtin_amdgcn_mfma_f32_32x32x16_bf16(PAF(0),VFR(4),o[1],0,0,0), C0,4); \
    KRD(GL,0); GAPB(o[0]=__builtin_amdgcn_mfma_f32_32x32x16_bf16(PAF(1),VFR(1),o[0],0,0,0), C0,8); \
    KRD(GL,1); GAPB(o[1]=__builtin_amdgcn_mfma_f32_32x32x16_bf16(PAF(1),VFR(5),o[1],0,0,0), C0,12); \
    KRD(GL,2); GAPB(o[0]=__builtin_amdgcn_mfma_f32_32x32x16_bf16(PAF(2),VFR(2),o[0],0,0,0), C1,0); \
    KRD(GL,3); GAPB(o[1]=__builtin_amdgcn_mfma_f32_32x32x16_bf16(PAF(2),VFR(6),o[1],0,0,0), C1,4); \
    GAPB(o[0]=__builtin_amdgcn_mfma_f32_32x32x16_bf16(PAF(3),VFR(3),o[0],0,0,0), C1,8); \
    GAPB(o[1]=__builtin_amdgcn_mfma_f32_32x32x16_bf16(PAF(3),VFR(7),o[1],0,0,0), C1,12); \
    }while(0)
  int t=1;
  #undef CMASK
  #define CMASK(P0,P1,t) do{}while(0)
  for(;t+5<NT;t+=2){
    STEP(pB0,pB1,pA0,pA1,t,true,true,true);     WAIT_BAR(2); RESC(); ROT();
    STEP(pA0,pA1,pB0,pB1,t+1,true,true,true);   WAIT_BAR(2); RESC(); ROT();
  }
  #undef CMASK
  #define CMASK(P0,P1,t) do{ if(FOX && !defined_nomask){int jb_=(t)-(NT-4); if(jb_>=0)cmask(P0,P1,jb_,qrel,hi);} }while(0)
  #define ENDW(tt) do{ if((tt)+3<NT){WAIT_BAR(2);} else if((tt)+2<NT){WAIT_BAR(1);} else {WAIT_BAR(0);} }while(0)
  for(;t+1<NT;t+=2){
    STEP(pB0,pB1,pA0,pA1,t,(t+3<NT),(t+1<NT),(t+1<NT));       ENDW(t);   RESC(); ROT();
    STEP(pA0,pA1,pB0,pB1,t+1,(t+4<NT),(t+2<NT),(t+2<NT));     ENDW(t+1); RESC(); ROT();
  }
  STEP(pB0,pB1,pA0,pA1,NT-1,false,false,false); RESC();
  { float sacc=pB0[0]+pB0[1]; _Pragma("unroll") for(int r=2;r<16;++r)sacc+=pB0[r]; _Pragma("unroll") for(int r=0;r<16;++r)sacc+=pB1[r]; l_reg+=sacc;
    pw0=(u32x4){PKW(pB0,0),PKW(pB0,2),PKW(pB0,4),PKW(pB0,6)};pw1=(u32x4){PKW(pB0,8),PKW(pB0,10),PKW(pB0,12),PKW(pB0,14)};pw2=(u32x4){PKW(pB1,0),PKW(pB1,2),PKW(pB1,4),PKW(pB1,6)};pw3=(u32x4){PKW(pB1,8),PKW(pB1,10),PKW(pB1,12),PKW(pB1,14)};
    SBAR(); pv(o,vb0+sl_cur,PAF(0),PAF(1),PAF(2),PAF(3)); }
  #undef PKW
  #undef PAF
  #undef VFR
  #undef PIN
  #undef MX3
  #undef GAPA
  #undef GAPB
  #undef EX
  #undef VRD
  #undef KRD
  #undef STEP
  #undef ENDW
  {auto rr=__builtin_amdgcn_permlane32_swap(__float_as_uint(l_reg),__float_as_uint(l_reg),false,false);l_reg=__uint_as_float(rr[0])+__uint_as_float(rr[1]);}
  if(hi==0)wsf[32+r32]=l_reg;asm volatile("s_waitcnt lgkmcnt(0)":::"memory");
  float rli[16];
  #pragma unroll
  for(int r=0;r<16;++r)rli[r]=__builtin_amdgcn_rcpf(wsf[32+crow(r,hi)]);
  bf16*Yw=Y+(rowbase+q0+wid*QBLK)*YP+ycol0+h*D;
  { bf16*stg=(bf16*)(shm+LDS_OST)+wid*2048;
    #pragma unroll
    for(int r=0;r<16;++r){const int orow=crow(r,hi);
      #pragma unroll
      for(int d0=0;d0<2;++d0)stg[orow*64+d0*32+r32]=__float2bfloat16(o[d0][r]*rli[r]);}
    asm volatile("s_waitcnt lgkmcnt(0)":::"memory");
    const int ch=lane&7; typedef __attribute__((address_space(3))) const f32x4v lds_f4; const f32x4v g0=*(lds_f4*)((lds_cptr)shm+LDS_G+ch*32), g1=*(lds_f4*)((lds_cptr)shm+LDS_G+ch*32+16);
    #pragma unroll
    for(int i=0;i<4;++i){const int row=i*8+(lane>>3); const u32x4 v=*(const u32x4*)(stg+row*64+ch*8);
      float f[8];
      #pragma unroll
      for(int k=0;k<4;++k){ f[2*k]=__uint_as_float(v[k]<<16); f[2*k+1]=__uint_as_float(v[k]&0xffff0000u); }
      float ss=0.f;
      #pragma unroll
      for(int k=0;k<8;++k)ss+=f[k]*f[k];
      ss+=__shfl_xor(ss,1); ss+=__shfl_xor(ss,2); ss+=__shfl_xor(ss,4);
      const float rstd=1.0f/sqrtf(ss*(1.0f/64.0f)+1e-6f);
      u32x4 w; w.x=cvtpk_s(f[0]*rstd*g0[0],f[1]*rstd*g0[1]); w.y=cvtpk_s(f[2]*rstd*g0[2],f[3]*rstd*g0[3]); w.z=cvtpk_s(f[4]*rstd*g1[0],f[5]*rstd*g1[1]); w.w=cvtpk_s(f[6]*rstd*g1[2],f[7]*rstd*g1[3]);
      ATTN_STORE16(Yw+(long)row*YP+ch*8,w);} }
  asm volatile("s_waitcnt lgkmcnt(0)\n\ts_barrier":::"memory");
  #undef LOADBK
  #undef QL
  #undef DMA_K
  #undef DMA_V
  #undef CMASK
  #undef START
  #undef RESC
  #undef ROT
}
constexpr int ATTN_LDS_BYTES=LDS_BYTES;
struct AttnUnit { int bh; int qb; };
#undef SBAR
#undef WAIT_BAR
}
#define GAS __attribute__((address_space(1)))
#define LAS __attribute__((address_space(3)))
typedef unsigned short bf16;
typedef unsigned v4u __attribute__((ext_vector_type(4)));
typedef float f32x4 __attribute__((ext_vector_type(4)));
typedef short bf16x8 __attribute__((ext_vector_type(8)));
typedef GAS unsigned gu32;
typedef GAS unsigned long long gu64;
#define RLX_AGENT __ATOMIC_RELAXED, __HIP_MEMORY_SCOPE_AGENT
#define LDS_WAIT() asm volatile("s_waitcnt lgkmcnt(0)" ::: "memory")
#define VM_WAIT() asm volatile("s_waitcnt vmcnt(0)" ::: "memory")
__device__ __forceinline__ unsigned long long rt() { return __builtin_amdgcn_s_memrealtime(); }
__device__ __forceinline__ unsigned f2bf(float f) { unsigned u = __builtin_bit_cast(unsigned, f); return (u + 0x7fffu + ((u >> 16) & 1u)) >> 16; }
__device__ __forceinline__ unsigned pk2(float lo, float hi) { return f2bf(lo) | (f2bf(hi) << 16); }

#define XB_TMO      128
#define XB_XCNT(j)  (256  + 64 * (j))
#define XB_XSUB(j)  (1280 + 64 * (j))
#define XB_XGEN(j)  (2304 + 64 * (j))
#define XB_TOP      3328
#define XB_TOPGEN   3392
#define XCD_BAR_WORDS 3456
#define XB_SPIN_CAP (1u << 18)

__device__ __forceinline__ unsigned xb_ld(unsigned* p)              { return __hip_atomic_load(p, __ATOMIC_RELAXED, __HIP_MEMORY_SCOPE_AGENT); }
__device__ __forceinline__ unsigned xb_add(unsigned* p, unsigned v) { return __hip_atomic_fetch_add(p, v, __ATOMIC_RELAXED, __HIP_MEMORY_SCOPE_AGENT); }
__device__ __forceinline__ unsigned xb_xcc_id() { return (unsigned)__builtin_amdgcn_s_getreg((3 << 11) | 20) & 0xFu; }
#define XB_SPIN(cond, bar) do { unsigned _sp = 0; while (cond) { __builtin_amdgcn_s_sleep(1); \
    if ((++_sp & 255u) == 0u) { if (xb_ld(&(bar)[XB_TMO])) break; if (_sp > XB_SPIN_CAP) { atomicAdd(&(bar)[XB_TMO], 1u); break; } } } } while (0)

struct XcdBarrier {
    unsigned* bar; unsigned x;
    volatile LAS unsigned* st;
};

__device__ __forceinline__ XcdBarrier xcd_barrier_post(unsigned* bar, volatile LAS unsigned* st, bool thread0) {
    XcdBarrier b; b.bar = bar; b.x = xb_xcc_id(); b.st = st;
    if (thread0) (void)xb_add(&bar[XB_XCNT(b.x)], 1u);
    return b;
}
__device__ __forceinline__ void xcd_barrier_complete(unsigned* bar, unsigned x, unsigned& nloc, unsigned& nx) {
    const unsigned G = gridDim.x * gridDim.y * gridDim.z;
    unsigned sum, cnt, mine, sp = 0u;
    for (;;) {
        sum = 0u; cnt = 0u; mine = 0u;
#pragma unroll
        for (unsigned j = 0; j < 16; ++j) { const unsigned c = xb_ld(&bar[XB_XCNT(j)]); sum += c; cnt += (c > 0u) ? 1u : 0u; mine = (j == x) ? c : mine; }
        if (sum == G) break;
        __builtin_amdgcn_s_sleep(1);
        if ((++sp & 255u) == 0u) { if (xb_ld(&bar[XB_TMO])) break; if (sp > XB_SPIN_CAP) { atomicAdd(&bar[XB_TMO], 1u); break; } }
    }
    nloc = mine > 0u ? mine : 1u; nx = cnt > 0u ? cnt : 1u;
}

__device__ __forceinline__ void xcd_barrier(const XcdBarrier& b, bool thread0) {
    asm volatile("s_waitcnt vmcnt(0)" ::: "memory");
    __syncthreads();
    if (thread0) {
        unsigned* bar = b.bar;
        __builtin_amdgcn_s_waitcnt(0);
        unsigned nloc = b.st[0], nx = b.st[1];
        if (nloc == 0u) { xcd_barrier_complete(bar, b.x, nloc, nx); b.st[0] = nloc; b.st[1] = nx; }
        const unsigned old = xb_add(&bar[XB_XSUB(b.x)], 1u);
        const unsigned gen = old / nloc;
        if (old + 1u == (gen + 1u) * nloc) {
            __builtin_amdgcn_fence(__ATOMIC_RELEASE, "agent");
            asm volatile("s_waitcnt vmcnt(0)" ::: "memory");
            const unsigned og = xb_add(&bar[XB_TOP], 1u);
            const unsigned tg = og / nx;
            if (og + 1u == (tg + 1u) * nx) xb_add(&bar[XB_TOPGEN], 1u);
            else XB_SPIN(xb_ld(&bar[XB_TOPGEN]) == tg, bar);
            __builtin_amdgcn_fence(__ATOMIC_ACQUIRE, "agent");
            asm volatile("s_waitcnt vmcnt(0)" ::: "memory");
        } else {
            XB_SPIN(xb_ld(&bar[XB_TOPGEN]) == gen, bar);
            __builtin_amdgcn_fence(__ATOMIC_ACQUIRE, "agent");
            asm volatile("s_waitcnt vmcnt(0)" ::: "memory");
        }
    }
    __syncthreads();
}
constexpr int RING_OFF = 0, RING_BYTES = 153600;
constexpr int LDSCTL_OFF = RING_BYTES, GTAB_OFF = LDSCTL_OFF  , MISC_OFF = LDSCTL_OFF + 320;
constexpr int LDS_BYTES = 154624;
static_assert(MISC_OFF + 128 <= LDS_BYTES && attn_body::LDS_BYTES <= RING_BYTES, "LDS map");

struct Frame {
    LAS unsigned char* lds;
    volatile LAS unsigned* MISC;
    gu32* ctl;
    int tid, lane, wave, vcu, G;
};
__device__ __forceinline__ float wave_sum(float v) {
#pragma unroll
    for (int o = 1; o < 64; o <<= 1) v += __shfl_xor(v, o);
    return v;
}

struct WSrc { const float* p; int col; int N; };
__device__ __forceinline__ WSrc wsrc(int kind, int d, const float* w0, const float* w1) {
    WSrc s; s.p = w0; s.col = -1; s.N = 1;
    if (kind == 0) {
        const int pn = d >> 8, c = d & 255, bj = c >> 7, wc = (c >> 5) & 3, dlo = c & 31, hd = 64 * wc + 32 * bj + dlo;
        s.N = IN_COLS;
        if (pn == 0) s.col = hd; else if (pn == 1) s.col = 256 + hd; else if (pn <= 3) s.col = 512 + 256 * (pn - 2) + c; else if (pn <= 5) s.col = 1024 + 256 * (pn - 4) + c;
        else if (pn == 6) s.col = 1536 + hd; else if (pn == 7) s.col = 1792 + hd; else if (pn == 8) s.col = 2048 + c; else if (pn == 9) s.col = 2308 + hd;
        else if (pn == 10) s.col = c < 4 ? 2304 + c : -1;
        else { s.p = w1; s.N = 512; s.col = pn == 11 ? hd : 256 + c; }
    } else if (kind == 1) { s.N = D_MODEL; s.col = d; }
    else if (kind == 2) { const int pn = d >> 8, c = d & 255, f = 128 * pn + (c & 127); s.N = D_FF; s.p = c < 128 ? w0 : w1; s.col = f < D_FF ? f : -1; }
    else { s.N = D_MODEL; s.col = d; }
    return s;
}
constexpr int TR_P = 68;
struct TrItem { int kind; const float* w0; const float* w1; int Ksrc; bf16* dst; int Kd; int row0, k0; const float* gk; float s8; };
__device__ __forceinline__ void tr_load(const TrItem& d, int lane, f32x4 (&v)[16]) {
    const int q = lane & 15, kr = lane >> 4;
    const WSrc s = wsrc(d.kind, d.row0 + 4 * q, d.w0, d.w1);
#pragma unroll
    for (int i = 0; i < 16; ++i) { const int k = d.k0 + 4 * i + kr; v[i] = (f32x4){0.f, 0.f, 0.f, 0.f}; if (s.col >= 0 && k < d.Ksrc) v[i] = __builtin_nontemporal_load((const GAS f32x4*)(s.p + (size_t)k * s.N + s.col)); }
}
__device__ __forceinline__ void tr_store(const TrItem& d, int lane, const f32x4 (&v)[16], LAS float* scr) {
    const int q = lane & 15, kr = lane >> 4;
#pragma unroll
    for (int i = 0; i < 16; ++i) { const int kk = 4 * i + kr; f32x4 x = v[i]; if (d.gk) x = x * d.gk[(d.k0 + kk) < d.Ksrc ? d.k0 + kk : 0];
        *(LAS f32x4*)(scr + kk * TR_P + ((4 * q + 4 * (kk >> 3)) & 63)) = x; }
    LDS_WAIT(); asm volatile("" ::: "memory");
    const int c = lane & 7;
#pragma unroll
    for (int j = 0; j < 8; ++j) { const int n = (lane >> 3) + 8 * j; const LAS float* p = scr + (8 * c) * TR_P + ((n + 4 * c) & 63);
        if (d.s8 > 0.f) { typedef unsigned u32x2 __attribute__((ext_vector_type(2))); u32x2 o; const float s = d.s8;
            o.x = pg8::pk4_fp8(p[0 * TR_P] * s, p[1 * TR_P] * s, p[2 * TR_P] * s, p[3 * TR_P] * s); o.y = pg8::pk4_fp8(p[4 * TR_P] * s, p[5 * TR_P] * s, p[6 * TR_P] * s, p[7 * TR_P] * s);
            *(GAS u32x2*)((unsigned char*)d.dst + (size_t)(d.row0 + n) * d.Kd + d.k0 + 8 * c) = o; }
        else { v4u o; o.x = pg8::cvt_pk_bf16(p[0 * TR_P], p[1 * TR_P]); o.y = pg8::cvt_pk_bf16(p[2 * TR_P], p[3 * TR_P]); o.z = pg8::cvt_pk_bf16(p[4 * TR_P], p[5 * TR_P]); o.w = pg8::cvt_pk_bf16(p[6 * TR_P], p[7 * TR_P]);
            *(GAS v4u*)(d.dst + (size_t)(d.row0 + n) * d.Kd + d.k0 + 8 * c) = o; } }
    LDS_WAIT(); asm volatile("" ::: "memory");
}
struct In { const float *x, *mem, *attn_g, *w_in, *fbias, *fqg, *fkg, *mqg, *mkg, *memg, *wmemkv, *outg, *w_out, *ffn_g, *dwg, *dwu, *dwd, *router, *ewg, *ewu, *ewd; };

struct FfnMat { const float *g, *u, *d; };
__device__ __forceinline__ FfnMat ffn_mat(const In& I, int mi) { FfnMat f;
    f.g = mi < 2 ? I.dwg + (size_t)mi * D_MODEL * D_FF : I.ewg + (size_t)(mi - 2) * D_MODEL * D_FF; f.u = mi < 2 ? I.dwu + (size_t)mi * D_MODEL * D_FF : I.ewu + (size_t)(mi - 2) * D_MODEL * D_FF;
    f.d = mi < 2 ? I.dwd + (size_t)mi * D_FF * D_MODEL : I.ewd + (size_t)(mi - 2) * D_FF * D_MODEL; return f; }
constexpr int I_IN = (D_MODEL / 64) * (NINKV / 64), I_OUT = (D_MODEL / 64) * (D_MODEL / 64), I_GU = (D_MODEL / 64) * (NGU / 64), I_DN = (FFP / 64) * (D_MODEL / 64);
constexpr int T_IN = 4 * I_IN, T_OUT = 4 * I_OUT, T_GU = 18 * I_GU, T_DN = 18 * I_DN;
constexpr int DEF_M0 = 10, N_DEF = (18 - DEF_M0) * (I_GU + I_DN);
constexpr int N_DEF1 = (256 - 196) * 8 * 4 + (256 - 128) * 8 * 3, U_DEF1 = T_IN + T_OUT + 2 * I_GU;
constexpr int N_DEF_T = (16832 < N_DEF ? 16832 : N_DEF);
constexpr int N_DEF3 = 2 * I_IN + 2 * I_OUT + I_GU + I_DN, N_PRO = T_IN + T_OUT + DEF_M0 * (I_GU + I_DN) - N_DEF1 - N_DEF3;
__device__ __forceinline__ TrItem decode_item(const In& I, unsigned char* ws, int r) { TrItem d;
    if (r < T_IN) { const int l = r / I_IN, q = r % I_IN, kb = q / (NINKV / 64), nb = q % (NINKV / 64);
        d = TrItem{0, I.w_in + (size_t)l * D_MODEL * IN_COLS, I.wmemkv + (size_t)l * D_MODEL * 512, D_MODEL, (bf16*)(ws + WS_WIN + l * SZ_WIN), D_MODEL, 64 * nb, 64 * kb, nb < NIN / 64 ? I.attn_g + l * D_MODEL : nullptr, 0.f}; return d; }
    r -= T_IN;
    if (r < T_OUT) { const int l = r / I_OUT, q = r % I_OUT, kb = q / (D_MODEL / 64), nb = q % (D_MODEL / 64);
        d = TrItem{1, I.w_out + (size_t)l * D_MODEL * D_MODEL, nullptr, D_MODEL, (bf16*)(ws + WS_WOUT + l * SZ_WOUT), D_MODEL, 64 * nb, 64 * kb, nullptr, 0.f}; return d; }
    r -= T_OUT;
    if (r < T_GU) { const int mi = r / I_GU, q = r % I_GU, kb = q / (NGU / 64), nb = q % (NGU / 64); const FfnMat f = ffn_mat(I, mi);
        d = TrItem{2, f.g, f.u, D_MODEL, (bf16*)(mi < 2 ? (ws + WS_WGU + mi * SZ_WGU) : (ws + WS_EGU + (size_t)(mi - 2) * SZ_EGU)), D_MODEL, 64 * nb, 64 * kb, I.ffn_g + (mi < 2 ? 2 * mi : 2 * ((mi - 2) >> 3) + 1) * D_MODEL, ((FP8_MOE_GU && mi >= 2) || (mi < 2 && ((DENSE_FP8_MASK >> mi) & 1))) ? SW_GU : 0.f}; return d; }
    r -= T_GU;
    { const int mi = r / I_DN, q = r % I_DN, kb = q / (D_MODEL / 64), nb = q % (D_MODEL / 64); const FfnMat f = ffn_mat(I, mi);
        d = TrItem{3, f.d, nullptr, D_FF, (bf16*)(mi < 2 ? (ws + WS_WDN + mi * SZ_WDN) : (ws + WS_EDN + (size_t)(mi - 2) * SZ_WDN)), FFP, 64 * nb, 64 * kb, nullptr, FP8_DN ? SW_DN : 0.f}; return d; }
}
__device__ __forceinline__ int list_item(int list, int p) {
    if (list == 0 && p >= N_PRO) { list = 1; p = N_DEF_T + (p - N_PRO); }
    if (list == 0) {
        if (p < 2 * I_IN) return p;                                  p -= 2 * I_IN;
        if (p < 2 * I_OUT) return T_IN + p;                          p -= 2 * I_OUT;
        if (p < I_GU) return T_IN + T_OUT + p;                       p -= I_GU;
        if (p < 8 * I_GU - N_DEF1) return U_DEF1 + N_DEF1 + p;       p -= 8 * I_GU - N_DEF1;
        if (p < I_DN) return T_IN + T_OUT + T_GU + p;                p -= I_DN;
        return T_IN + T_OUT + T_GU + 2 * I_DN + p;
    }
    if (list == 3) {
        if (p < 2 * I_IN) return 2 * I_IN + p;                       p -= 2 * I_IN;
        if (p < 2 * I_OUT) return T_IN + 2 * I_OUT + p;              p -= 2 * I_OUT;
        if (p < I_GU) return T_IN + T_OUT + I_GU + p;                p -= I_GU;
        return T_IN + T_OUT + T_GU + I_DN + p;
    }
    if (list == 2) return U_DEF1 + p;
    return p < (18 - DEF_M0) * I_GU ? T_IN + T_OUT + DEF_M0 * I_GU + p : T_IN + T_OUT + T_GU + DEF_M0 * I_DN + (p - (18 - DEF_M0) * I_GU);
}
__device__ __forceinline__ void p_convert(Frame& F, const In& I, unsigned char* ws, int list, int first, int stride, int quota) {
    LAS float* scr = (LAS float*)(F.lds + RING_OFF + F.wave * (64 * TR_P * 4));
    const int nlist = list == 0 ? N_PRO + (N_DEF - N_DEF_T) : list == 1 ? N_DEF_T : list == 2 ? N_DEF1 : N_DEF3;
    f32x4 va[16], vb[16]; TrItem da, db; int it = first, left = quota; bool hasa = it < nlist && left > 0, hasb = false;
    if (hasa) { da = decode_item(I, ws, list_item(list, it)); tr_load(da, F.lane, va); --left; }
    while (hasa) {
        hasb = it + stride < nlist && left > 0; if (hasb) { db = decode_item(I, ws, list_item(list, it + stride)); tr_load(db, F.lane, vb); --left; }
        tr_store(da, F.lane, va, scr);
        if (!hasb) break;
        it += 2 * stride; hasa = it < nlist && left > 0; if (hasa) { da = decode_item(I, ws, list_item(list, it)); tr_load(da, F.lane, va); --left; }
        tr_store(db, F.lane, vb, scr);
    }
}
constexpr int DQ_F2 = 3  ; constexpr int DQ_IP = 4, DQ_F = 3  , DQ_D1 = 3, DQ_M1 = 2, DQ_D1X = 3, DC_IP = 196, DC_F = 128, DC_D1 = 20, DC_M1 = 110;
static_assert((256 - DC_D1) * 8 * DQ_D1X >= N_DEF3, "list 3 fits its slot (the expert down phase of layer 1)");
constexpr int DS2_IP0 = 0, DS2_F0 = DS2_IP0 + (256 - DC_IP) * 8 * DQ_IP;
static_assert(DS2_F0 + (256 - DC_F) * 8 * DQ_F >= N_DEF1, "list 2 slots cover the list");
constexpr int DS_IP1 = 0, DS_M1 = DS_IP1 + (256 - DC_IP) * 8 * DQ_IP, DS_D1 = DS_M1 + (256 - DC_M1) * 8 * DQ_M1, DS_IP2 = DS_D1 + (256 - DC_D1) * 8 * DQ_D1, DS_F2 = DS_IP2 + (256 - DC_IP) * 8 * DQ_IP;
constexpr int DS_IP3 = DS_F2 + (256 - DC_F) * 8 * DQ_F2;
static_assert(DS_IP3 >= (18 - DEF_M0) * I_GU, "the last MoE layer's gate|up items are all converted before layer 3 starts");
constexpr int N_DEF_T_ = DS_IP3 + (256 - DC_IP) * 8 * DQ_IP;
static_assert(N_DEF_T_ >= N_DEF_T, "list 1 slots cover the deferred part of the list");
__device__ __forceinline__ void p_convert_tail(Frame& F, const In& I, unsigned char* ws, int list, int slot, int c0, int quota) {
    if ((int)blockIdx.x < c0 || F.G != 256) return;
    const int nw = (256 - c0) * NWAVES, r = ((int)blockIdx.x - c0) * NWAVES + F.wave;
    p_convert(F, I, ws, list, slot + r, nw, quota);
}

__device__ __forceinline__ void p_prologue(Frame& F, const In& I, unsigned char* ws) {
    const int gw = F.vcu * NWAVES + F.wave, NGW = F.G * NWAVES;
    if (F.vcu == 1) for (int i = F.tid; i < 2 * 16 * D_MODEL; i += NWAVES * 64) { const int j = i >> 14, e = (i >> 10) & 15, k = i & 1023;
        ((bf16*)(ws + WS_WRT))[i] = (bf16)f2bf(e < N_EXPERTS ? I.router[((size_t)j * D_MODEL + k) * N_EXPERTS + e] * I.ffn_g[(2 * j + 1) * D_MODEL + k] : 0.f); }
    if (F.vcu == 0) for (int i = F.tid; i < 1024; i += NWAVES * 64) { const int l = i >> 8, w = (i >> 6) & 3, d = i & 63; const float* src = w == 0 ? I.fqg : w == 1 ? I.fkg : w == 2 ? I.mqg : I.mkg; ((float*)(ws + WS_GAINS))[i] = src[l * 64 + d]; }
    constexpr int NROWS = M_TOK + 4 * M_MEM;
#define PR_LOAD(mr, HV) do { const int mr_ = (mr); if (mr_ < NROWS) { const bool im_ = mr_ >= M_TOK; const int rm_ = im_ ? (mr_ - M_TOK) % M_MEM : mr_; \
        const GAS f32x4* xr_ = (const GAS f32x4*)((im_ ? I.mem : I.x) + (size_t)rm_ * D_MODEL) + F.lane; _Pragma("unroll") for (int j = 0; j < 4; ++j) HV[j] = __builtin_nontemporal_load(xr_ + 64 * j); } } while (0)
#define PR_DO(mr, HV) do { const int mr_ = (mr); if (mr_ < NROWS) { const bool ismem = mr_ >= M_TOK; const int lm = ismem ? (mr_ - M_TOK) / M_MEM : 0, rm = ismem ? (mr_ - M_TOK) % M_MEM : mr_; float s = 0.f; \
        _Pragma("unroll") for (int j = 0; j < 4; ++j) s += (HV[j].x * HV[j].x + HV[j].y * HV[j].y) + (HV[j].z * HV[j].z + HV[j].w * HV[j].w); \
        s = wave_sum(s); \
        if (ismem) { const float rstd = __builtin_amdgcn_rsqf(s * (1.f / D_MODEL) + EPS); const GAS f32x4* gr = (const GAS f32x4*)(I.memg + lm * D_MODEL) + F.lane; \
            _Pragma("unroll") for (int j = 0; j < 4; ++j) HV[j] = HV[j] * rstd * gr[64 * j]; } \
        GAS unsigned long long* o8 = (GAS unsigned long long*)((ismem ? (bf16*)(ws + WS_MEMN) + (size_t)(lm * M_MEM + rm) * D_MODEL : (bf16*)(ws + WS_XB) + (size_t)rm * D_MODEL)) + F.lane; \
        _Pragma("unroll") for (int j = 0; j < 4; ++j) o8[64 * j] = (unsigned long long)pg8::cvt_pk_bf16(HV[j].x, HV[j].y) | ((unsigned long long)pg8::cvt_pk_bf16(HV[j].z, HV[j].w) << 32); \
        if (!ismem && F.lane == 0) *(GAS f32x4*)((float*)(ws + WS_SSA) + (size_t)rm * 4) = (f32x4){s, 0.f, 0.f, 0.f}; } } while (0)
    { f32x4 h0[4], h1[4], h2[4];
      for (int mr = gw; mr < NROWS; mr += 3 * NGW) { PR_LOAD(mr, h0); PR_LOAD(mr + NGW, h1); PR_LOAD(mr + 2 * NGW, h2); PR_DO(mr, h0); PR_DO(mr + NGW, h1); PR_DO(mr + 2 * NGW, h2); } }
#undef PR_LOAD
#undef PR_DO
    p_convert(F, I, ws, 0, gw, NGW, 1 << 30);
}

struct TokRoute { int e1, p1, e2, p2; float g1, g2; int pad0, pad1; };
__device__ __forceinline__ void load_xb_row(const bf16* XB, int m, int lane, f32x4 (&xv)[4]) {
    const GAS unsigned long long* xr = (const GAS unsigned long long*)(XB + (size_t)m * D_MODEL) + lane;
#pragma unroll
    for (int j = 0; j < 4; ++j) { const unsigned long long a = xr[64 * j]; xv[j].x = pg8::bf_lo((unsigned)a); xv[j].y = pg8::bf_hi((unsigned)a); xv[j].z = pg8::bf_lo((unsigned)(a >> 32)); xv[j].w = pg8::bf_hi((unsigned)(a >> 32)); }
}
__device__ __forceinline__ void build_tab(LAS int* tab, const gu32* counts, bool thread0) {
    __syncthreads();
    if (thread0) { int t = 0; for (int e = 0; e < N_EXPERTS; ++e) { int n = (int)__hip_atomic_load(counts + e, RLX_AGENT); n = n > 16384 ? 16384 : n; tab[e] = t; t += (n + 255) / 256; } tab[N_EXPERTS] = t; }
    __syncthreads();
}
__device__ __forceinline__ void p_combine(Frame& F, bf16* XB, const bf16* YD, const TokRoute* R, const LAS int* tab, float* SSA, float* OUT, bool final_) {
    const int gw = F.vcu * NWAVES + F.wave, NGW = F.G * NWAVES; const int nrows = (M_TOK - gw + NGW - 1) / NGW;
    int s1_l = 0, s2_l = 0; float g1_l = 0.f, g2_l = 0.f;
    if (F.lane < nrows) { const GAS v4u* rr = (const GAS v4u*)(R + gw + F.lane * NGW); const v4u ra = rr[0], rb = rr[1]; s1_l = tab[ra[0]] * 256 + (int)ra[1]; s2_l = tab[ra[2]] * 256 + (int)ra[3]; g1_l = __uint_as_float(rb[0]); g2_l = __uint_as_float(rb[1]); }
    f32x4 xa[4], ya[4], za[4], xb[4], yb[4], zb[4];
#define CB_LOAD(i, X, Y, Z) do { load_xb_row(XB, gw + (i) * NGW, F.lane, X); load_xb_row(YD, __builtin_amdgcn_readlane(s1_l, (i)), F.lane, Y); load_xb_row(YD, __builtin_amdgcn_readlane(s2_l, (i)), F.lane, Z); } while (0)
#define CB_DO(i, X, Y, Z) do { const int m_ = gw + (i) * NGW; const float g1 = __int_as_float(__builtin_amdgcn_readlane(__float_as_int(g1_l), (i))), g2 = __int_as_float(__builtin_amdgcn_readlane(__float_as_int(g2_l), (i))); float s = 0.f; \
        _Pragma("unroll") for (int j = 0; j < 4; ++j) { X[j] = (X[j] + Y[j] * g1) + Z[j] * g2; s += (X[j].x * X[j].x + X[j].y * X[j].y) + (X[j].z * X[j].z + X[j].w * X[j].w); } \
        if (final_) { GAS f32x4* xo = (GAS f32x4*)(OUT + (size_t)m_ * D_MODEL) + F.lane; _Pragma("unroll") for (int j = 0; j < 4; ++j) xo[64 * j] = X[j]; } \
        else { s = wave_sum(s); GAS unsigned long long* o8 = (GAS unsigned long long*)(XB + (size_t)m_ * D_MODEL) + F.lane; \
            _Pragma("unroll") for (int j = 0; j < 4; ++j) o8[64 * j] = (unsigned long long)pg8::cvt_pk_bf16(X[j].x, X[j].y) | ((unsigned long long)pg8::cvt_pk_bf16(X[j].z, X[j].w) << 32); \
            if (F.lane == 0) *(GAS f32x4*)(SSA + (size_t)m_ * 4) = (f32x4){s, 0.f, 0.f, 0.f}; } } while (0)
    if (nrows > 0) CB_LOAD(0, xa, ya, za);
    for (int i = 0; i < nrows; i += 2) {
        if (i + 1 < nrows) CB_LOAD(i + 1, xb, yb, zb);
        CB_DO(i, xa, ya, za);
        if (i + 1 < nrows) { if (i + 2 < nrows) CB_LOAD(i + 2, xa, ya, za); CB_DO(i + 1, xb, yb, zb); }
    }
#undef CB_LOAD
#undef CB_DO
}
__device__ __forceinline__ void p_route2(Frame& F, const float* LOGP, const float* SSF, gu32* counts, int* list, TokRoute* R, float* RSS) {
    LAS unsigned* lcnt = (LAS unsigned*)(F.lds + RING_OFF);
    if (F.tid < 16) lcnt[F.tid] = 0u;
    __syncthreads();
    const int mm = F.vcu * 64 + F.tid; const bool act = F.tid < 64 && mm < M_TOK;
    unsigned e1 = 0, e2 = 1, r1 = 0, r2 = 0; float g1 = 0.f, g2 = 0.f, rstd = 0.f;
    if (act) {
        float lg[N_EXPERTS];
#pragma unroll
        for (int e = 0; e < N_EXPERTS; ++e) lg[e] = 0.f;
        const GAS f32x4* lp = (const GAS f32x4*)(LOGP + (size_t)mm * 128);
#pragma unroll
        for (int p = 0; p < 16; ++p) { const f32x4 a = lp[2 * p], b = lp[2 * p + 1]; lg[0] += a.x; lg[1] += a.y; lg[2] += a.z; lg[3] += a.w; lg[4] += b.x; lg[5] += b.y; lg[6] += b.z; lg[7] += b.w; }
        const f32x4 ps = *(const GAS f32x4*)(SSF + (size_t)mm * 4); rstd = __builtin_amdgcn_rsqf(((ps[0] + ps[1]) + (ps[2] + ps[3])) * (1.0f / D_MODEL) + EPS);
        float v1 = lg[0]; e1 = 0;
#pragma unroll
        for (int e = 1; e < N_EXPERTS; ++e) if (lg[e] > v1) { v1 = lg[e]; e1 = e; }
        float v2 = -INFINITY; e2 = 0;
#pragma unroll
        for (int e = 0; e < N_EXPERTS; ++e) if ((unsigned)e != e1 && lg[e] > v2) { v2 = lg[e]; e2 = e; }
        g2 = 1.0f / (1.0f + __expf((v1 - v2) * rstd)); g1 = 1.0f - g2;
        r1 = __hip_atomic_fetch_add((unsigned*)(lcnt + e1), 1u, __ATOMIC_RELAXED, __HIP_MEMORY_SCOPE_WORKGROUP); r2 = __hip_atomic_fetch_add((unsigned*)(lcnt + e2), 1u, __ATOMIC_RELAXED, __HIP_MEMORY_SCOPE_WORKGROUP);
    }
    __syncthreads();
    if (F.tid < N_EXPERTS) lcnt[8 + F.tid] = __hip_atomic_fetch_add(counts + F.tid, lcnt[F.tid], RLX_AGENT);
    __syncthreads();
    if (act) { unsigned p1 = lcnt[8 + e1] + r1, p2 = lcnt[8 + e2] + r2;
        if (p1 < 16384u) { list[e1 * 16384 + p1] = mm; RSS[e1 * 16384 + p1] = rstd; } else p1 = 16383u;
        if (p2 < 16384u) { list[e2 * 16384 + p2] = mm; RSS[e2 * 16384 + p2] = rstd; } else p2 = 16383u;
        GAS v4u* ro = (GAS v4u*)(R + mm); ro[0] = (v4u){e1, p1, e2, p2}; ro[1] = (v4u){__float_as_uint(g1), __float_as_uint(g2), 0u, 0u}; }
    __syncthreads();
}

__device__ __forceinline__ void p_cumsum(Frame& F, const float* LOGF, float* CB) {
    if (F.vcu >= 8) return;
    const float* src = LOGF + (size_t)F.vcu * SEQ + F.tid * 16; float* dst = CB + (size_t)F.vcu * SEQ + F.tid * 16;
    float v[16];
#pragma unroll
    for (int j = 0; j < 4; ++j) { const f32x4 t = *(const f32x4*)(src + 4 * j); v[4 * j] = t.x; v[4 * j + 1] = t.y; v[4 * j + 2] = t.z; v[4 * j + 3] = t.w; }
#pragma unroll
    for (int j = 1; j < 16; ++j) v[j] += v[j - 1];
    float incl = v[15];
#pragma unroll
    for (int o = 1; o < 64; o <<= 1) { const float t = __shfl_up(incl, o); if (F.lane >= o) incl += t; }
    LAS float* wt = (LAS float*)(F.lds + RING_OFF);
    if (F.lane == 63) wt[F.wave] = incl;
    __syncthreads();
    float base = incl - v[15];
    for (int w = 0; w < F.wave; ++w) base += wt[w];
#pragma unroll
    for (int j = 0; j < 4; ++j) { f32x4 t; t.x = (v[4 * j] + base) * 1.4426950408889634f; t.y = (v[4 * j + 1] + base) * 1.4426950408889634f; t.z = (v[4 * j + 2] + base) * 1.4426950408889634f; t.w = (v[4 * j + 3] + base) * 1.4426950408889634f; *(f32x4*)(dst + 4 * j) = t; }
    __syncthreads();
}

constexpr int RT_VP = 144, RT_KP = 72;
typedef short rt_v4i16 __attribute__((ext_vector_type(4)));
__device__ __forceinline__ float ret_log2g(int h) { return log2f(1.0f - exp2f(-5.0f - (float)h)); }
__device__ __forceinline__ bf16x8 ret_tr8(const LAS bf16* tile, int P, int tA, int tB, int c0, int lane) {
    const int q = (lane & 15) >> 2, p = lane & 3;
    const rt_v4i16 a = __builtin_amdgcn_ds_read_tr16_b64_v4i16((LAS rt_v4i16*)(tile + (tA + q) * P + c0 + 4 * p));
    const rt_v4i16 b = __builtin_amdgcn_ds_read_tr16_b64_v4i16((LAS rt_v4i16*)(tile + (tB + q) * P + c0 + 4 * p));
    return (bf16x8){a[0], a[1], a[2], a[3], b[0], b[1], b[2], b[3]};
}
__device__ __forceinline__ void ret_stage_v(Frame& F, const bf16* RV, int t0, int h, LAS bf16* Vr) {
#pragma unroll
    for (int q = 0; q < 4; ++q) { const int p = F.tid + 512 * q, j = p >> 4, ec = p & 15; *(LAS v4u*)(Vr + j * RT_VP + 8 * ec) = *(const GAS v4u*)(RV + (size_t)(t0 + j) * 512 + 128 * h + 8 * ec); }
}
__device__ __forceinline__ void p_ret_kv(Frame& F, const bf16* RK, const bf16* RV, float* KVT) {
    LAS bf16* Vr = (LAS bf16*)(F.lds + RING_OFF); LAS bf16* Kd = Vr + 128 * RT_VP;
    const int er = F.lane & 15, g = F.lane >> 4;
    for (int u = F.vcu; u < 512; u += F.G) {
        const int bh = u >> 6, n = u & 63, b = bh >> 2, h = bh & 3, t0 = b * SEQ + n * 128; const float l2g = ret_log2g(h);
        ret_stage_v(F, RV, t0, h, Vr);
#pragma unroll
        for (int q = 0; q < 2; ++q) { const int p = F.tid + 512 * q, j = p >> 3, dc = p & 7; const v4u raw = *(const GAS v4u*)(RK + (size_t)(t0 + j) * 256 + 64 * h + 8 * dc); const float dec = exp2f((float)(127 - j) * l2g);
            v4u o;
#pragma unroll
            for (int k = 0; k < 4; ++k) o[k] = pk2(__uint_as_float(raw[k] << 16) * dec, __uint_as_float(raw[k] & 0xffff0000u) * dec);
            *(LAS v4u*)(Kd + j * RT_KP + 8 * dc) = o; }
        __syncthreads();
        f32x4 acc[4];
#pragma unroll
        for (int dt = 0; dt < 4; ++dt) acc[dt] = (f32x4){0.f, 0.f, 0.f, 0.f};
#pragma unroll
        for (int ks = 0; ks < 4; ++ks) { const int tA = 32 * ks + 8 * g; const bf16x8 a = ret_tr8(Vr, RT_VP, tA, tA + 4, 16 * F.wave, F.lane);
#pragma unroll
            for (int dt = 0; dt < 4; ++dt) { const bf16x8 bb = ret_tr8(Kd, RT_KP, tA, tA + 4, 16 * dt, F.lane); acc[dt] = __builtin_amdgcn_mfma_f32_16x16x32_bf16(a, bb, acc[dt], 0, 0, 0); } }
        float* out = KVT + (size_t)u * 8192;
#pragma unroll
        for (int dt = 0; dt < 4; ++dt)
#pragma unroll
            for (int r = 0; r < 4; ++r) out[(16 * F.wave + 4 * g + r) * 64 + 16 * dt + er] = acc[dt][r];
        __syncthreads();
    }
}
__device__ __forceinline__ void p_ret_scan(Frame& F, const float* KVT, bf16* PREVT, int item, gu32* done) {
    { const int idx = item * 512 + F.tid;
        const int bh = idx >> 13, ed = idx & 8191, h = bh & 3; const float cd = exp2f(128.0f * ret_log2g(h));
        const GAS float* src = (const GAS float*)(KVT + (size_t)bh * 64 * 8192 + ed); GAS unsigned short* dst = (GAS unsigned short*)(PREVT + (size_t)bh * 64 * 8192 + ed);
        float v[64];
#pragma unroll
        for (int n = 0; n < 64; ++n) v[n] = src[(size_t)n * 8192];
        float st = 0.f;
#pragma unroll
        for (int n = 0; n < 64; ++n) { __hip_atomic_store(dst + (size_t)n * 8192, (unsigned short)f2bf(st), RLX_AGENT); st = st * cd + v[n]; }
    }
    asm volatile("s_waitcnt vmcnt(0)" ::: "memory");
    __syncthreads();
    if (F.tid == 0) (void)__hip_atomic_fetch_add(done + 64 * (item >> 4), 1u, RLX_AGENT);
}
__device__ __forceinline__ void ret_scan_wait(Frame& F, gu32* done, int bh0, int bh1) {
    if (F.tid == 0) { unsigned sp = 0;
        while (__hip_atomic_load(done + 64 * bh0, RLX_AGENT) < 16u || __hip_atomic_load(done + 64 * bh1, RLX_AGENT) < 16u) { __builtin_amdgcn_s_sleep(2); if (++sp > (1u << 22)) break; }
        __builtin_amdgcn_fence(__ATOMIC_ACQUIRE, "agent"); }
    asm volatile("s_waitcnt vmcnt(0)" ::: "memory");
    __syncthreads();
}
__device__ __forceinline__ void p_ret_out(Frame& F, const bf16* RQ, const bf16* RK, const bf16* RV, const bf16* RGs, const bf16* PREVT, const float* gret, bf16* Y, int u0, gu32* done) {
    constexpr int UNIT_E = 128 * RT_VP + 128 * RT_KP + 128 * RT_KP;
    const int lc = F.lane & 15, g = F.lane >> 4, uh = F.wave >> 2, wl = F.wave & 3;
    LAS bf16* Vr = (LAS bf16*)(F.lds + RING_OFF) + uh * UNIT_E; LAS bf16* Kr = Vr + 128 * RT_VP; LAS bf16* Pr = Kr + 128 * RT_KP;
    ret_scan_wait(F, done, u0 >> 6, 4 + (u0 >> 6));
    {
        const int u = u0 + 256 * uh;
        const int bh = u >> 6, n = u & 63, b = bh >> 2, h = bh & 3, t0 = b * SEQ + n * 128; const float l2g = ret_log2g(h);
        const bf16* pv = PREVT + (size_t)u * 8192;
        { const int th = F.tid & 255;
            v4u tv[8], tk[4], tp[4];
#pragma unroll
            for (int q = 0; q < 8; ++q) { const int p = th + 256 * q, j = p >> 4, ec = p & 15; tv[q] = *(const GAS v4u*)(RV + (size_t)(t0 + j) * 512 + 128 * h + 8 * ec); }
#pragma unroll
            for (int q = 0; q < 4; ++q) { const int p = th + 256 * q, j = p >> 3, dc = p & 7; tk[q] = *(const GAS v4u*)(RK + (size_t)(t0 + j) * 256 + 64 * h + 8 * dc); tp[q] = *(const GAS v4u*)(pv + j * 64 + 8 * dc); }
#pragma unroll
            for (int q = 0; q < 8; ++q) { const int p = th + 256 * q, j = p >> 4, ec = p & 15; *(LAS v4u*)(Vr + j * RT_VP + 8 * ec) = tv[q]; }
#pragma unroll
            for (int q = 0; q < 4; ++q) { const int p = th + 256 * q, j = p >> 3, dc = p & 7; *(LAS v4u*)(Kr + j * RT_KP + 8 * dc) = tk[q]; *(LAS v4u*)(Pr + j * RT_KP + 8 * dc) = tp[q]; } }
        bf16x8 qf[2][2]; unsigned long long rgw[2][8];
#pragma unroll
        for (int tbi = 0; tbi < 2; ++tbi) { const size_t row = (size_t)(t0 + 16 * (tbi == 0 ? wl : 7 - wl) + lc);
#pragma unroll
            for (int ks = 0; ks < 2; ++ks) qf[tbi][ks] = *(const GAS bf16x8*)(RQ + row * 256 + 64 * h + 32 * ks + 8 * g);
#pragma unroll
            for (int et = 0; et < 8; ++et) rgw[tbi][et] = *(const GAS unsigned long long*)(RGs + row * 512 + 128 * h + 16 * et + 4 * g); }
        LAS float* Gl = (LAS float*)(F.lds + RING_OFF + 2 * UNIT_E * 2) + uh * 128;
        { const int th = F.tid & 255; if (th < 32) *(LAS f32x4*)(Gl + 4 * th) = *(const f32x4*)(gret + 128 * h + 4 * th); }
        __syncthreads();
#pragma unroll
        for (int tbi = 0; tbi < 2; ++tbi) {
            const int w = tbi == 0 ? wl : 7 - wl;
            f32x4 accC[8], accI[8];
#pragma unroll
            for (int et = 0; et < 8; ++et) { accC[et] = (f32x4){0.f, 0.f, 0.f, 0.f}; accI[et] = (f32x4){0.f, 0.f, 0.f, 0.f};
#pragma unroll
                for (int ks = 0; ks < 2; ++ks) { const bf16x8 a = *(const LAS bf16x8*)(Pr + (16 * et + lc) * RT_KP + 32 * ks + 8 * g); accC[et] = __builtin_amdgcn_mfma_f32_16x16x32_bf16(a, qf[tbi][ks], accC[et], 0, 0, 0); } }
            const int iloc = 16 * w + lc;
#pragma unroll
            for (int kp = 0; kp < 4; ++kp) if (kp <= (w >> 1)) {
                unsigned pk[4];
#pragma unroll
                for (int half = 0; half < 2; ++half) { const int jt = 2 * kp + half; f32x4 s = (f32x4){0.f, 0.f, 0.f, 0.f};
                    if (jt <= w) {
#pragma unroll
                        for (int ks = 0; ks < 2; ++ks) { const bf16x8 kf = *(const LAS bf16x8*)(Kr + (16 * jt + lc) * RT_KP + 32 * ks + 8 * g); s = __builtin_amdgcn_mfma_f32_16x16x32_bf16(kf, qf[tbi][ks], s, 0, 0, 0); }
#pragma unroll
                        for (int r = 0; r < 4; ++r) { const int jloc = 16 * jt + 4 * g + r; s[r] = (iloc >= jloc) ? s[r] * exp2f((float)(iloc - jloc) * l2g) : 0.f; }
                    }
                    pk[2 * half] = pg8::cvt_pk_bf16(s[0], s[1]); pk[2 * half + 1] = pg8::cvt_pk_bf16(s[2], s[3]); }
                const bf16x8 pb = __builtin_bit_cast(bf16x8, (v4u){pk[0], pk[1], pk[2], pk[3]});
#pragma unroll
                for (int et = 0; et < 8; ++et) { const bf16x8 a = ret_tr8(Vr, RT_VP, 32 * kp + 4 * g, 32 * kp + 16 + 4 * g, 16 * et, F.lane);
                    accI[et] = __builtin_amdgcn_mfma_f32_16x16x32_bf16(a, pb, accI[et], 0, 0, 0); }
            }
            const float qd = exp2f((float)(iloc + 1) * l2g); float ss = 0.f;
#pragma unroll
            for (int et = 0; et < 8; ++et) { accI[et] = accI[et] + accC[et] * qd; ss += (accI[et][0] * accI[et][0] + accI[et][1] * accI[et][1]) + (accI[et][2] * accI[et][2] + accI[et][3] * accI[et][3]); }
            ss += __shfl_xor(ss, 16); ss += __shfl_xor(ss, 32);
            const float rstd = __builtin_amdgcn_rsqf(ss * (1.0f / 128.0f) + EPS);
            const size_t rowo = (size_t)(t0 + iloc);
#pragma unroll
            for (int et = 0; et < 8; ++et) { const int e = 16 * et + 4 * g; const f32x4 gg = *(const LAS f32x4*)(Gl + e);
                const unsigned long long rg_ = rgw[tbi][et];
                const float r0 = __uint_as_float((unsigned)rg_ << 16), r1 = __uint_as_float((unsigned)rg_ & 0xffff0000u), r2 = __uint_as_float((unsigned)(rg_ >> 32) << 16), r3 = __uint_as_float((unsigned)(rg_ >> 32) & 0xffff0000u);
                const unsigned long long o = (unsigned long long)pk2(accI[et][0] * rstd * gg.x * r0, accI[et][1] * rstd * gg.y * r1) | ((unsigned long long)pk2(accI[et][2] * rstd * gg.z * r2, accI[et][3] * rstd * gg.w * r3) << 32);
                *(GAS unsigned long long*)(Y + rowo * D_MODEL + 128 * h + e) = o; }
        }
        __syncthreads();
    }
}
struct Args { const float* in[21]; float* out; unsigned char* ws; int ph_lo, ph_hi; };
typedef const __attribute__((address_space(4))) Args* kargs_t;
#define KARGS() ({ unsigned long long p_ = (unsigned long long)__builtin_amdgcn_kernarg_segment_ptr(); asm volatile("" : "+s"(p_)); (kargs_t)p_; })
__global__ void __launch_bounds__(NWAVES * 64, 2) trunk_fwd(Args args_unused) {
    extern __shared__ __attribute__((aligned(16))) unsigned char lds[];
    Frame F;
    F.lds = (LAS unsigned char*)lds;
    F.MISC = (volatile LAS unsigned*)(F.lds + MISC_OFF);
    F.wave = __builtin_amdgcn_readfirstlane((int)threadIdx.x >> 6); F.lane = hw_lane(); F.tid = F.wave * 64 + F.lane;
    F.G = gridDim.x; { const int bx = blockIdx.x; F.vcu = (F.G % 8 == 0) ? (bx % 8) * (F.G / 8) + bx / 8 : bx; }
    F.ctl = nullptr;
    for (int u = F.tid; u < (LDS_BYTES - LDSCTL_OFF) / 4; u += NWAVES * 64) ((LAS unsigned*)(F.lds + LDSCTL_OFF))[u] = 0u;
    __syncthreads();
    { kargs_t A = KARGS(); (void)xcd_barrier_post((unsigned*)(A->ws + WS_CTL) + CW_BAR, F.MISC + 8, F.tid == 0); }
#define GRID_BAR() do { kargs_t A_ = KARGS(); XcdBarrier b_; b_.bar = (unsigned*)(A_->ws + WS_CTL) + CW_BAR; b_.x = xb_xcc_id(); b_.st = F.MISC + 8; xcd_barrier(b_, F.wave == 0 && hw_lane() == 0); } while (0)
#define WSP(T, off) ((T*)(ws + (off)))
#define LAUNDER_F() do { asm volatile("" : "+s"(F.wave)); F.lane = hw_lane(); F.tid = F.wave * 64 + F.lane; } while (0)
#ifndef ALIGN_F1
#define ALIGN_F1 true
#endif
#ifndef ALIGN_IP
#define ALIGN_IP true
#endif
#define CONV_IN(A_) In Ic; Ic.attn_g = (A_)->in[2]; Ic.w_in = (A_)->in[3]; Ic.wmemkv = (A_)->in[10]; Ic.w_out = (A_)->in[12]; Ic.ffn_g = (A_)->in[13]; Ic.dwg = (A_)->in[14]; Ic.dwu = (A_)->in[15]; Ic.dwd = (A_)->in[16]; Ic.ewg = (A_)->in[18]; Ic.ewu = (A_)->in[19]; Ic.ewd = (A_)->in[20];
#define XLDS ((unsigned)(RING_OFF + 131072))
#ifdef PROBE_T
#define PRB_T0 (F.wave == 0 && hw_lane() == 0)
#define TACC_ADD(v) do { const unsigned long long a_ = ((unsigned long long)F.MISC[23] << 32 | F.MISC[22]) + (unsigned long long)(v); F.MISC[22] = (unsigned)a_; F.MISC[23] = (unsigned)(a_ >> 32); } while (0)
#define TSTART(p) do { if (PROBE_T == (p) && PRB_T0) F.MISC[24] = (unsigned)__builtin_amdgcn_s_memrealtime(); } while (0)
#define TEND(p) do { if (PROBE_T == (p) && PRB_T0) TACC_ADD((unsigned)__builtin_amdgcn_s_memrealtime() - F.MISC[24]); } while (0)
#else
#define TSTART(p) do { } while (0)
#define TEND(p) do { } while (0)
#endif
#if defined(PROBE_T) && defined(PROBE_EPI)
#define EPIACC(p) const unsigned long long te_ =
#define EPIEND(p) if (PROBE_T == 100 + (p) && PRB_T0) TACC_ADD(te_);
#else
#define EPIACC(p) (void)
#define EPIEND(p)
#endif

#if defined(PROBE_T) && PROBE_T >= 31 && PROBE_T <= 39
#define PRB_MAX(slot, val) do { if (F.wave == 0 && hw_lane() == 0) { kargs_t A_ = KARGS(); atomicMax((unsigned*)(A_->ws + WS_CTL) + 200000 + (slot), (unsigned)(val)); } } while (0)
#define PRB_READ(slot, inv) do { if (blockIdx.x == 0) { kargs_t A_ = KARGS(); const unsigned v_ = __hip_atomic_load((unsigned*)(A_->ws + WS_CTL) + 200000 + (slot), RLX_AGENT); if (PRB_T0) TACC_ADD((inv) ? (0xFFFFFFu - v_) : v_); } } while (0)
#define PRB_NOW() __builtin_amdgcn_s_memrealtime()
#else
#define PRB_MAX(slot, val) do { } while (0)
#define PRB_READ(slot, inv) do { } while (0)
#define PRB_NOW() 0ull
#endif
#ifndef PROBE_T
#define PROBE_T_ 0
#else
#define PROBE_T_ PROBE_T
#endif

#ifndef SKIP_PRO
    TSTART(9);
    { LAUNDER_F(); kargs_t A = KARGS(); In I; I.x = A->in[0]; I.mem = A->in[1]; I.attn_g = A->in[2]; I.w_in = A->in[3]; I.fqg = A->in[5]; I.fkg = A->in[6]; I.mqg = A->in[7]; I.mkg = A->in[8]; I.memg = A->in[9];
        I.wmemkv = A->in[10]; I.w_out = A->in[12]; I.ffn_g = A->in[13]; I.router = A->in[17]; I.dwg = A->in[14]; I.dwu = A->in[15]; I.dwd = A->in[16]; I.ewg = A->in[18]; I.ewu = A->in[19]; I.ewd = A->in[20];
        p_prologue(F, I, A->ws); }
    GRID_BAR();
    TEND(9);

#endif
            for (int l = 0; l < DEPTH; ++l) {
#ifndef SKIP_P0
        if (l == 2) { TSTART(0); { LAUNDER_F(); kargs_t A = KARGS(); unsigned char* ws = A->ws;
            build_tab((LAS int*)(F.lds + GTAB_OFF), (const gu32*)(ws + WS_CTL) + CW_CNT + 64 * ((l - 1) >> 1), F.tid == 0);
            p_combine(F, WSP(bf16, WS_XB), WSP(const bf16, WS_YD), WSP(const TokRoute, WS_GATEW), (const LAS int*)(F.lds + GTAB_OFF), WSP(float, WS_SSA), nullptr, false); }
            GRID_BAR(); TEND(0); }
        #endif
#ifndef SKIP_P1
        TSTART(1);
        { LAUNDER_F(); kargs_t A = KARGS(); unsigned char* ws = A->ws;
            pg8::Gemm g{WSP(bf16, WS_XB), (const bf16*)(ws + WS_WIN + l * SZ_WIN), D_MODEL * 2, 0, (const bf16*)(ws + WS_MEMN) + (size_t)l * M_MEM * D_MODEL, M_TOK / 256};
            pg8::TileOrder S{M_TOK / 256, NIN / 256, F.G, (int)blockIdx.x, M_TOK / 256, NIN / 256, 2, 2};
            pg8::EpiInProj E{ws, A->in[4] + l * 4, WSP(float, WS_GAINS) + l * 256, WSP(float, WS_SSA)};
            EPIACC(1) pg8::gemm_phase<pg8::EpiInProj, pg8::TileOrder, ALIGN_IP, true, false, false>(F.lds + RING_OFF, g, S, E, F.tid); EPIEND(1)
        }
        { LAUNDER_F(); kargs_t A = KARGS(); CONV_IN(A); p_convert_tail(F, Ic, A->ws, l == 0 ? 2 : 1, l == 0 ? DS2_IP0 : l == 1 ? DS_IP1 : l == 2 ? DS_IP2 : DS_IP3, DC_IP, DQ_IP); }
        GRID_BAR(); TEND(1);
        #endif
#ifndef SKIP_P2
        TSTART(2);
        { LAUNDER_F(); kargs_t A = KARGS(); unsigned char* ws = A->ws; p_cumsum(F, WSP(float, WS_LOGF), WSP(float, WS_CB)); p_ret_kv(F, WSP(bf16, WS_RK), WSP(bf16, WS_RV), WSP(float, WS_KVT)); }
        GRID_BAR(); TEND(2);
        #endif
#ifndef SKIP_P3
        TSTART(3);
        {
            if (PROBE_T_ >= 31 && F.wave == 0 && hw_lane() == 0) F.MISC[20] = (unsigned)PRB_NOW();
            for (int uu = F.vcu; uu < 256; uu += F.G) { const int bh = uu >> 5, qb = uu & 31;
                { LAUNDER_F(); kargs_t A = KARGS(); unsigned char* ws = A->ws;
                attn_body::attn_unit<8, true>(bh >> 2, bh & 3, qb, WSP(const attn_body::bf16, WS_FQ), WSP(const attn_body::bf16, WS_FK), WSP(const attn_body::bf16, WS_FV), WSP(attn_body::bf16, WS_Y), 512, A->in[11] + l * D_MODEL + 512, WSP(float, WS_CB) + (size_t)bh * SEQ, WSP(float, WS_GAINS) + l * 256, (char*)lds + RING_OFF, F.tid); }
            }
            if (PROBE_T_ == 31) PRB_MAX(l, (unsigned)PRB_NOW() - F.MISC[20]);
            for (;;) {
                if (F.tid == 0) { kargs_t A = KARGS(); F.MISC[16] = __hip_atomic_fetch_add((unsigned*)(A->ws + WS_CTL) + CW_MEMQ + 64 * l, 1u, RLX_AGENT); }
                __syncthreads(); const int uu = (int)F.MISC[16]; __syncthreads();
                if (uu >= 128 + 256 + 256) break;
                if (PROBE_T_ >= 31 && F.wave == 0 && hw_lane() == 0) F.MISC[21] = (unsigned)PRB_NOW();
                if (uu < 128) { LAUNDER_F(); kargs_t A = KARGS(); unsigned char* ws = A->ws; p_ret_scan(F, WSP(float, WS_KVT), WSP(bf16, WS_PREVT), uu, (gu32*)(ws + WS_CTL) + CW_SCN + 512 * l); if (PROBE_T_ == 32) PRB_MAX(l, (unsigned)PRB_NOW() - F.MISC[21]); continue; }
                if (uu < 128 + 256) { LAUNDER_F(); kargs_t A = KARGS(); unsigned char* ws = A->ws;
                    p_ret_out(F, WSP(bf16, WS_RQ), WSP(bf16, WS_RK), WSP(bf16, WS_RV), WSP(bf16, WS_RG), WSP(bf16, WS_PREVT), A->in[11] + l * D_MODEL, WSP(bf16, WS_Y), uu - 128, (gu32*)(ws + WS_CTL) + CW_SCN + 512 * l);
                    if (PROBE_T_ == 36) PRB_MAX(l, (unsigned)PRB_NOW() - F.MISC[21]); continue; }
                const int bh = (uu - 384) >> 5, qb = (uu - 384) & 31;
                { LAUNDER_F(); kargs_t A = KARGS(); unsigned char* ws = A->ws;
                attn_body::attn_unit<8, false>(bh >> 2, bh & 3, qb, WSP(const attn_body::bf16, WS_MQ), WSP(const attn_body::bf16, WS_MK), WSP(const attn_body::bf16, WS_MV), WSP(attn_body::bf16, WS_Y), 768, A->in[11] + l * D_MODEL + 768, nullptr, nullptr, (char*)lds + RING_OFF, F.tid); }
                if (PROBE_T_ == 33) PRB_MAX(l, (unsigned)PRB_NOW() - F.MISC[21]);
            }
            if (PROBE_T_ == 34) PRB_MAX(l, (unsigned)PRB_NOW() - F.MISC[20]);
            if (PROBE_T_ == 35) PRB_MAX(l, 0xFFFFFFu - ((unsigned)PRB_NOW() - F.MISC[20]));
        }
        GRID_BAR(); TEND(3);
        PRB_READ(l, PROBE_T_ == 35);
        #endif
#ifndef SKIP_P5
        TSTART(5);
        { LAUNDER_F(); kargs_t A = KARGS(); unsigned char* ws = A->ws;
            pg8::Gemm g{WSP(bf16, WS_Y), (const bf16*)(ws + WS_WOUT + l * SZ_WOUT), D_MODEL * 2, 0, WSP(bf16, WS_Y), 1 << 30};
            pg8::TileOrder S{M_TOK / 256, D_MODEL / 256, F.G, (int)blockIdx.x, 0, 0, 0, 0};
            pg8::EpiDown E{WSP(bf16, WS_XB), WSP(float, WS_SSF), WSP(bf16, WS_YD), XLDS, false, 1.0f, (l & 1) != 0 || ((DENSE_FP8_MASK >> (l >> 1)) & 1), ws + WS_X8, WSP(const bf16, WS_WRT) + (size_t)(l >> 1) * 16 * D_MODEL, WSP(float, WS_LOGP), (l & 1) != 0};
            EPIACC(5) pg8::gemm_phase<pg8::EpiDown, pg8::TileOrder, true, true, false, false>(F.lds + RING_OFF, g, S, E, F.tid); EPIEND(5)
        }
        GRID_BAR(); TEND(5);
        #endif
#ifndef SKIP_P6
        if (l & 1) { TSTART(6); { LAUNDER_F(); kargs_t A = KARGS(); unsigned char* ws = A->ws; const int j2 = l >> 1;
            p_route2(F, WSP(const float, WS_LOGP), WSP(const float, WS_SSF), (gu32*)(ws + WS_CTL) + CW_CNT + 64 * j2, WSP(int, WS_LIST), WSP(TokRoute, WS_GATEW), WSP(float, WS_RSS)); }
            GRID_BAR(); TEND(6); }
        #endif
#ifndef SKIP_P7
        TSTART(7);
        { LAUNDER_F(); kargs_t A = KARGS(); unsigned char* ws = A->ws; const int j2 = l >> 1; const bool moe = (l & 1) != 0;
            pg8::GroupedOrder S; S.init(F.G, (int)blockIdx.x, NGU / 256, (LAS int*)(F.lds + GTAB_OFF), moe ? (const unsigned*)(ws + WS_CTL) + CW_CNT + 64 * j2 : nullptr, WSP(int, WS_LIST), F.tid == 0);
            if ((FP8_MOE_GU && moe) || (!moe && ((DENSE_FP8_MASK >> j2) & 1))) {
                pg8::Gemm g{ws + WS_X8, moe ? (const void*)(ws + WS_EGU + (size_t)j2 * 8 * SZ_EGU) : (const void*)(ws + WS_WGU + (size_t)j2 * SZ_WGU), D_MODEL, moe ? SZ_EGU : 0, ws + WS_X8, 1 << 30};
                pg8::EpiSwiGLU<true> E{ws + WS_HF, WSP(const float, WS_SSF), WSP(const float, WS_RSS), !moe};
                EPIACC(7) pg8::gemm_phase<pg8::EpiSwiGLU<true>, pg8::GroupedOrder, ALIGN_F1, true, true, true>(F.lds + RING_OFF, g, S, E, F.tid); EPIEND(7)
            } else {
                pg8::Gemm g{WSP(bf16, WS_XB), moe ? (const void*)(ws + WS_EGU + (size_t)j2 * 8 * SZ_EGU) : (const void*)(ws + WS_WGU + (size_t)j2 * SZ_WGU), D_MODEL * 2, moe ? SZ_EGU : 0, WSP(bf16, WS_XB), 1 << 30};
                pg8::EpiSwiGLU<false> E{ws + WS_HF, WSP(const float, WS_SSF), WSP(const float, WS_RSS), !moe};
                EPIACC(7) pg8::gemm_phase<pg8::EpiSwiGLU<false>, pg8::GroupedOrder, ALIGN_F1, true, true, false>(F.lds + RING_OFF, g, S, E, F.tid); EPIEND(7)
            }
        }
        if (l == 0 || l == 2) { LAUNDER_F(); kargs_t A = KARGS(); CONV_IN(A); p_convert_tail(F, Ic, A->ws, l == 0 ? 2 : 1, l == 0 ? DS2_F0 : DS_F2, DC_F, l == 0 ? DQ_F : DQ_F2); }
        if (l == 1) { LAUNDER_F(); kargs_t A = KARGS(); CONV_IN(A); p_convert_tail(F, Ic, A->ws, 1, DS_M1, DC_M1, DQ_M1); }
        GRID_BAR(); TEND(7);
        #endif
#ifndef SKIP_P8
        TSTART(8);
        { LAUNDER_F(); kargs_t A = KARGS(); unsigned char* ws = A->ws; const int j2 = l >> 1; const bool moe = (l & 1) != 0;
            pg8::GroupedOrder S; S.init(F.G, (int)blockIdx.x, D_MODEL / 256, (LAS int*)(F.lds + GTAB_OFF), moe ? (const unsigned*)(ws + WS_CTL) + CW_CNT + 64 * j2 : nullptr, WSP(int, WS_LIST), F.tid == 0);
            pg8::Gemm g{WSP(bf16, WS_HF), moe ? (const void*)(ws + WS_EDN + (size_t)j2 * 8 * SZ_WDN) : (const void*)(ws + WS_WDN + (size_t)j2 * SZ_WDN), FFP * FES_DN, moe ? SZ_WDN : 0, WSP(bf16, WS_HF), 1 << 30};
            pg8::EpiDown E{WSP(bf16, WS_XB), WSP(float, WS_SSA), WSP(bf16, WS_YD), XLDS, moe, FP8_DN ? 1.0f / (SW_DN * SA_HF) : 1.0f, false, ws + WS_X8, WSP(const bf16, WS_WRT), WSP(float, WS_LOGP), false};
            EPIACC(8) pg8::gemm_phase<pg8::EpiDown, pg8::GroupedOrder, true, true, false, FP8_DN != 0>(F.lds + RING_OFF, g, S, E, F.tid); EPIEND(8)
        }
        if (l == 1) { LAUNDER_F(); kargs_t A = KARGS(); CONV_IN(A); p_convert_tail(F, Ic, A->ws, 3, 0, DC_D1, DQ_D1X); p_convert_tail(F, Ic, A->ws, 1, DS_D1, DC_D1, DQ_D1); }
        GRID_BAR(); TEND(8);
#endif
            }
#ifndef SKIP_FIN
    TSTART(10);
    { LAUNDER_F(); kargs_t A = KARGS(); unsigned char* ws = A->ws;
        build_tab((LAS int*)(F.lds + GTAB_OFF), (const gu32*)(ws + WS_CTL) + CW_CNT + 64 * ((DEPTH - 1) >> 1), F.tid == 0);
        p_combine(F, WSP(bf16, WS_XB), WSP(const bf16, WS_YD), WSP(const TokRoute, WS_GATEW), (const LAS int*)(F.lds + GTAB_OFF), nullptr, A->out, true); }
    TEND(10);
#endif
        #ifdef PROBE_T
    if (blockIdx.x == 0 && PRB_T0) { const unsigned long long t1_ = __builtin_amdgcn_s_memrealtime() + (unsigned long long)PROBE_K * ((unsigned long long)F.MISC[23] << 32 | F.MISC[22]); while (__builtin_amdgcn_s_memrealtime() < t1_) __builtin_amdgcn_s_sleep(32); }
#endif
#undef GRID_BAR
#undef WSP
}

extern "C" void kernel_launch(void* const* d_in, const int* in_sizes, int n_in, void* d_out, int out_size, void* d_ws, size_t ws_size, hipStream_t stream) {
    static int grid = 0;
    if (grid == 0) {
        if (n_in != 21 || in_sizes[0] != M_TOK * D_MODEL || out_size != M_TOK * D_MODEL || ws_size < WS_END) {
            fprintf(stderr, "kernel_launch: built for 21 inputs, x/out of %d floats, >= %zu bytes of workspace; got n_in %d, in0 %d, out %d, ws %zu; nothing launched\n", M_TOK * D_MODEL, (size_t)WS_END, n_in, n_in > 0 ? in_sizes[0] : -1, out_size, ws_size); grid = -1; return; }
        int dev = 0, cus = 0, per_cu = 0;
        if (hipGetDevice(&dev) != hipSuccess || hipDeviceGetAttribute(&cus, hipDeviceAttributeMultiprocessorCount, dev) != hipSuccess) { fprintf(stderr, "kernel_launch: device query failed\n"); grid = -1; return; }
        if (hipFuncSetAttribute((const void*)trunk_fwd, hipFuncAttributeMaxDynamicSharedMemorySize, LDS_BYTES) != hipSuccess) { fprintf(stderr, "kernel_launch: hipFuncSetAttribute failed\n"); grid = -1; return; }
        if (hipOccupancyMaxActiveBlocksPerMultiprocessor(&per_cu, (const void*)trunk_fwd, NWAVES * 64, LDS_BYTES) != hipSuccess || per_cu < 1)
            fprintf(stderr, "kernel_launch: note: occupancy query reports %d workgroups per CU\n", per_cu);
        (void)hipGetLastError();
        grid = cus;
        if (grid > 256) grid = 256;
    }
    if (grid < 0) return;
    if (hipMemsetAsync((char*)d_ws + WS_CTL, 0, CTL_ZERO_BYTES, stream) != hipSuccess) { fprintf(stderr, "kernel_launch: hipMemsetAsync failed\n"); return; }
    Args a{};
    for (int i = 0; i < 21; ++i) a.in[i] = (const float*)d_in[i];
    a.out = (float*)d_out; a.ws = (unsigned char*)d_ws;
    a.ph_lo = 0; a.ph_hi = 0;
    hipLaunchKernelGGL(trunk_fwd, dim3(grid), dim3(NWAVES * 64), LDS_BYTES, stream, a);
    const hipError_t le = hipPeekAtLastError();
    if (le != hipSuccess) fprintf(stderr, "kernel_launch: launch failed: %s\n", hipGetErrorName(le));
}
```
